# Optimizing an MI355X kernel written in HIP

```python
import math
import jax, jax.numpy as jnp
from jax import lax
import numpy as np

D_MODEL = 1024
BATCH = 4
SEQ = 8192
DEPTH = 1

PLE_DIM = 256
MIX_WIDTH = D_MODEL
ATTN_WIDTH = MIX_WIDTH // 2
SGU_WIDTH = MIX_WIDTH - ATTN_WIDTH
HEAD_DIM = 64
N_ATTN_HEADS = ATTN_WIDTH // HEAD_DIM
N_SGU_GROUPS = 4
SGU_GROUP_DIM = SGU_WIDTH // N_SGU_GROUPS
SGU_CHUNK = 128
DILATION_PAIRS = ((128, 1), (512, 4), (2048, 16))
QBLK = 128
D_FF = ((8 * D_MODEL + 3 * 256 - 1) // (3 * 256)) * 256
PROJ_COLS = 3 * ATTN_WIDTH + 2 * SGU_WIDTH
EPS = 1e-6
NEG = -1e30

kernel_name = "hybrid_dilated_attn_gmlp_block"


def rmsnorm(x, g):
    xf = x.astype(jnp.float32)
    y = xf * lax.rsqrt(jnp.mean(xf * xf, axis=-1, keepdims=True) + EPS)
    return (y * g.astype(jnp.float32)).astype(x.dtype)


def layernorm(x, g, b):
    xf = x.astype(jnp.float32)
    mu = jnp.mean(xf, axis=-1, keepdims=True)
    xc = xf - mu
    y = xc * lax.rsqrt(jnp.mean(xc * xc, axis=-1, keepdims=True) + EPS)
    return (y * g.astype(jnp.float32) + b.astype(jnp.float32)).astype(x.dtype)


def dilated_branch(q, k, v, slopes, window, dilation):
    B, H, S, hd = q.shape
    span = dilation * QBLK
    s_pad = -(-S // span) * span
    M = s_pad // dilation
    nb = M // QBLK
    n_steps = window // dilation
    pad = ((0, 0), (0, 0), (0, s_pad - S), (0, 0))

    def to_blocks(t):
        t = jnp.pad(t, pad).reshape(B, H, M, dilation, hd).transpose(0, 1, 3, 2, 4)
        return t.reshape(B, H, dilation, nb, QBLK, hd)

    def with_prev(t):
        prev = jnp.pad(t, ((0, 0), (0, 0), (0, 0), (1, 0), (0, 0), (0, 0)))[:, :, :, :-1]
        return jnp.concatenate([prev, t], axis=-2)

    qb = to_blocks(q)
    kc = with_prev(to_blocks(k))
    vc = with_prev(to_blocks(v))
    s = jnp.einsum('bhrnqc,bhrnkc->bhrnqk', qb, kc)

    qi = jnp.arange(QBLK)[:, None]
    ki = jnp.arange(2 * QBLK)[None, :]
    steps = QBLK + qi - ki
    blk = jnp.arange(nb)[:, None, None]
    valid = (steps >= 0) & (steps <= n_steps) & (blk * QBLK - QBLK + ki >= 0)
    dist = (jnp.clip(steps, 0, None) * dilation).astype(jnp.float32)
    bias = -slopes[:, None, None] * dist[None]
    s = s + bias[None, :, None, None]
    s = jnp.where(valid[None, None, None], s, NEG)
    mx = jnp.max(s, axis=-1, keepdims=True)
    e = jnp.exp(s - mx)
    den = jnp.sum(e, axis=-1)
    o = jnp.einsum('bhrnqk,bhrnkc->bhrnqc', e, vc) / den[..., None]
    lse = mx[..., 0] + jnp.log(den)
    o = o.reshape(B, H, dilation, M, hd).transpose(0, 1, 3, 2, 4).reshape(B, H, s_pad, hd)[:, :, :S]
    lse = lse.reshape(B, H, dilation, M).transpose(0, 1, 3, 2).reshape(B, H, s_pad)[:, :, :S]
    return o, lse


def dilated_attention(q, k, v):
    B, S, _ = q.shape
    dtype = q.dtype

    def heads(t):
        return t.reshape(B, S, N_ATTN_HEADS, HEAD_DIM).transpose(0, 2, 1, 3).astype(jnp.float32)

    qh = heads(q) * (HEAD_DIM ** -0.5)
    kh, vh = heads(k), heads(v)
    slopes = 2.0 ** (-8.0 * (jnp.arange(N_ATTN_HEADS, dtype=jnp.float32) + 1.0) / N_ATTN_HEADS)
    outs, lses = [], []
    for window, dilation in DILATION_PAIRS:
        o, l = dilated_branch(qh, kh, vh, slopes, window, dilation)
        outs.append(o)
        lses.append(l)
    w = jax.nn.softmax(jnp.stack(lses, axis=0), axis=0)
    out = jnp.sum(w[..., None] * jnp.stack(outs, axis=0), axis=0)
    return out.transpose(0, 2, 1, 3).reshape(B, S, ATTN_WIDTH).astype(dtype)


def spatial_gating(u, z, ln_g, ln_b, w_s, b_s):
    B, S, _ = u.shape
    nc = S // SGU_CHUNK
    u = jax.nn.gelu(u).reshape(B, S, N_SGU_GROUPS, SGU_GROUP_DIM)
    z = jax.nn.gelu(z).reshape(B, S, N_SGU_GROUPS, SGU_GROUP_DIM)
    z = layernorm(z, ln_g, ln_b)
    zc = z.reshape(B, nc, SGU_CHUNK, N_SGU_GROUPS, SGU_GROUP_DIM)
    causal = jnp.tril(jnp.ones((SGU_CHUNK, SGU_CHUNK), dtype=w_s.dtype))
    wm = w_s * causal[None]
    mixed = jnp.einsum('gij,bnjgc->bnigc', wm, zc) + b_s.T[None, None, :, :, None]
    out = u * mixed.reshape(B, S, N_SGU_GROUPS, SGU_GROUP_DIM)
    return out.reshape(B, S, SGU_WIDTH)


def setup_inputs(seed: int = 0) -> dict:
    key = jax.random.key(seed)
    ks = jax.random.split(key, 20)
    f32 = jnp.float32

    def nrm(k, shape, scale):
        return jax.random.normal(k, shape, f32) * scale

    def gain(k, shape):
        return 1.0 + 0.05 * jax.random.normal(k, shape, f32)

    L = DEPTH
    return {
        "x": jax.random.normal(ks[0], (BATCH, SEQ, D_MODEL), f32),
        "p": jax.random.normal(ks[1], (DEPTH, BATCH, SEQ, PLE_DIM), f32),
        "ln_pre_mix": gain(ks[2], (L, D_MODEL)),
        "w_in": nrm(ks[3], (L, D_MODEL, PROJ_COLS), D_MODEL ** -0.5),
        "sgu_ln_g": gain(ks[4], (L, SGU_GROUP_DIM)),
        "sgu_ln_b": nrm(ks[5], (L, SGU_GROUP_DIM), 0.02),
        "w_spatial": nrm(ks[6], (L, N_SGU_GROUPS, SGU_CHUNK, SGU_CHUNK), SGU_CHUNK ** -0.5),
        "b_spatial": gain(ks[7], (L, N_SGU_GROUPS, SGU_CHUNK)),
        "attn_out_norm": gain(ks[8], (L, ATTN_WIDTH)),
        "sgu_out_norm": gain(ks[9], (L, SGU_WIDTH)),
        "w_out": nrm(ks[10], (L, MIX_WIDTH, D_MODEL), MIX_WIDTH ** -0.5),
        "ln_post_mix": gain(ks[11], (L, D_MODEL)),
        "ln_pre_ffn": gain(ks[12], (L, D_MODEL)),
        "w_gate_up": nrm(ks[13], (L, D_MODEL, 2 * D_FF), D_MODEL ** -0.5),
        "w_down": nrm(ks[14], (L, D_FF, D_MODEL), D_FF ** -0.5),
        "ln_post_ffn": gain(ks[15], (L, D_MODEL)),
        "w_pe_gate": nrm(ks[16], (L, D_MODEL, D_MODEL), D_MODEL ** -0.5),
        "b_pe_gate": nrm(ks[17], (L, D_MODEL), 0.02),
        "w_pe_proj": nrm(ks[18], (L, PLE_DIM, D_MODEL), PLE_DIM ** -0.5),
    }


def reference(x, p, ln_pre_mix, w_in, sgu_ln_g, sgu_ln_b, w_spatial, b_spatial,
              attn_out_norm, sgu_out_norm, w_out, ln_post_mix, ln_pre_ffn, w_gate_up,
              w_down, ln_post_ffn, w_pe_gate, b_pe_gate, w_pe_proj):
    h = x
    splits = [ATTN_WIDTH, 2 * ATTN_WIDTH, 3 * ATTN_WIDTH, 3 * ATTN_WIDTH + SGU_WIDTH]
    for i in range(DEPTH):
        a = rmsnorm(h, ln_pre_mix[i])
        proj = a @ w_in[i]
        q, k, v, u, z = jnp.split(proj, splits, axis=-1)
        attn = dilated_attention(q, k, v)
        sgu = spatial_gating(u, z, sgu_ln_g[i], sgu_ln_b[i], w_spatial[i], b_spatial[i])
        groups = jnp.concatenate([rmsnorm(attn, attn_out_norm[i]),
                                  rmsnorm(sgu, sgu_out_norm[i])], axis=-1)
        mixed = groups @ w_out[i]
        h = h + rmsnorm(mixed, ln_post_mix[i])
        f = rmsnorm(h, ln_pre_ffn[i])
        g, up = jnp.split(f @ w_gate_up[i], 2, axis=-1)
        y = (jax.nn.silu(g) * up) @ w_down[i]
        h = h + rmsnorm(y, ln_post_ffn[i])
        gate = jax.nn.sigmoid(h @ w_pe_gate[i] + b_pe_gate[i])
        h = h + gate * (p[i] @ w_pe_proj[i])
    return h
```

```cpp
#include <hip/hip_runtime.h>
#include <hip/hip_cooperative_groups.h>
#include <cstdio>
#include <cstdint>
namespace cg = cooperative_groups;
namespace pg8 {
#define PG8_LAS __attribute__((address_space(3)))
typedef unsigned short bf16_t;
typedef short bf16x8 __attribute__((ext_vector_type(8)));
typedef float f32x4 __attribute__((ext_vector_type(4)));
typedef unsigned u32x4 __attribute__((ext_vector_type(4)));
constexpr int BM = 256, BK = 64, HALF = 128, HTB = HALF * BK * 2  , STAGE_BYTES = 8 * HTB, NXCD = 8, WGM = 8;

__host__ __device__ __forceinline__ int lds_byte(int r, int c) { const int st = (r >> 4) * 2 + (c >> 5), rr = r & 15, cc = c & 31, ob = rr * 64 + cc * 2; return st * 1024 + (ob ^ (((ob >> 9) & 1) << 5)); }
__host__ __device__ __forceinline__ void stage_rc(int b, int& R, int& C) { const int st = b / 1024, sb = b % 1024, swz = sb ^ (((sb >> 9) & 1) << 5); R = (st >> 1) * 16 + swz / 64; C = (st & 1) * 32 + (swz % 64) / 2; }
__host__ __device__ __forceinline__ int perm32(int rho) { const int n = rho >> 4, i = rho & 15; return 8 * (i >> 2) + 4 * n + (i & 3); }

struct Unit { int pm, pn; };
struct Gemm { const bf16_t* A; const bf16_t* Bt; int M, N, K; };

struct StaticOrder {
    int nM, nN, nwg, G, c;
    __host__ __device__ void init(int M, int N, int G_, int c_) { nM = M / BM; nN = N / BM; nwg = nM * nN; G = G_; c = c_; }
    __host__ __device__ bool next(int i, Unit& u) const {
        const long L = (long)i * G + c; if (L >= nwg) return false;
        int wgid = (int)L; { const int q = nwg / NXCD, r = nwg % NXCD, xcd = wgid % NXCD, off = wgid / NXCD; wgid = (xcd < r ? xcd * (q + 1) : r * (q + 1) + (xcd - r) * q) + off; }
        const int nig = WGM * nN, gid = wgid / nig, fm = gid * WGM, gsz = (nM - fm) < WGM ? (nM - fm) : WGM;
        u.pm = fm + ((wgid % nig) % gsz); u.pn = (wgid % nig) / gsz; return true;
    }
    __device__ __forceinline__ void a_ready(const Unit&) const {}
    __device__ __forceinline__ void done(const Unit&) const {}
};

__device__ __forceinline__ unsigned cvt_pk_bf16(float lo, float hi) { unsigned r; asm volatile("v_cvt_pk_bf16_f32 %0, %1, %2" : "=v"(r) : "v"(lo), "v"(hi)); return r; }
typedef unsigned u32x2 __attribute__((ext_vector_type(2)));
__device__ __forceinline__ int lane_id_asm() { int l; asm volatile("v_mbcnt_lo_u32_b32 %0, -1, 0\n\tv_mbcnt_hi_u32_b32 %0, -1, %0" : "=v"(l)); return l; }
__device__ __forceinline__ float gelu_tanh(float x) {
    const float u = 0.7978845608028654f * (x + 0.044715f * x * x * x);
    const float e = __builtin_amdgcn_exp2f(-2.885390081777927f * u);
    return x * __builtin_amdgcn_rcpf(1.0f + e);
}
__device__ __forceinline__ float sigmoid_f(float x) { return __builtin_amdgcn_rcpf(1.0f + __builtin_amdgcn_exp2f(-1.4426950408889634f * x)); }

template <int MODE> struct EpiBf16M {
    static constexpr bool PERM = true, AFTER_DRAIN = false;
    bf16_t* O; int ldc;
    __device__ __forceinline__ void operator()(const f32x4 (&acc)[2][2][4][2], const Unit& u, int wr, int wc, int fr, int fq) const {
        const int row0 = u.pm * BM + wr * 64 + fr, col0 = u.pn * BM + wc * 32 + 8 * fq;
        const int mode = (MODE == 1) ? (u.pn < 2 ? 1 : (u.pn >= 6 ? 2 : 0)) : 0;
#pragma unroll
        for (int ai = 0; ai < 2; ++ai)
#pragma unroll
            for (int m = 0; m < 4; ++m) { bf16_t* rowp = O + (size_t)(row0 + ai * HALF + m * 16) * ldc + col0;
#pragma unroll
                for (int bj = 0; bj < 2; ++bj) { f32x4 v0 = acc[ai][bj][m][0], v1 = acc[ai][bj][m][1];
                    if (mode == 1) { v0 = v0 * 0.125f; v1 = v1 * 0.125f; }
                    else if (mode == 2) {
#pragma unroll
                        for (int e = 0; e < 4; ++e) { v0[e] = gelu_tanh(v0[e]); v1[e] = gelu_tanh(v1[e]); } }
                    u32x4 w; w.x = cvt_pk_bf16(v0[0], v0[1]); w.y = cvt_pk_bf16(v0[2], v0[3]); w.z = cvt_pk_bf16(v1[0], v1[1]); w.w = cvt_pk_bf16(v1[2], v1[3]);
                    *(u32x4*)(rowp + bj * HALF) = w; } }
    }
};
struct EpiSwiglu {
    static constexpr bool PERM = true, AFTER_DRAIN = false;
    bf16_t* O; int ldc;
    __device__ __forceinline__ void operator()(const f32x4 (&acc)[2][2][4][2], const Unit& u, int wr, int wc, int fr, int fq) const {
        const int row0 = u.pm * BM + wr * 64 + fr, col0 = u.pn * HALF + wc * 32 + 8 * fq;
#pragma unroll
        for (int ai = 0; ai < 2; ++ai)
#pragma unroll
            for (int m = 0; m < 4; ++m) { bf16_t* rowp = O + (size_t)(row0 + ai * HALF + m * 16) * ldc + col0;
                f32x4 r0, r1;
#pragma unroll
                for (int e = 0; e < 4; ++e) { const float g0 = acc[ai][0][m][0][e], g1 = acc[ai][0][m][1][e];
                    r0[e] = g0 * sigmoid_f(g0) * acc[ai][1][m][0][e]; r1[e] = g1 * sigmoid_f(g1) * acc[ai][1][m][1][e]; }
                u32x4 w; w.x = cvt_pk_bf16(r0[0], r0[1]); w.y = cvt_pk_bf16(r0[2], r0[3]); w.z = cvt_pk_bf16(r1[0], r1[1]); w.w = cvt_pk_bf16(r1[2], r1[3]);
                *(u32x4*)rowp = w; }
    }
};
struct EpiF32 {
    static constexpr bool PERM = false, AFTER_DRAIN = false;
    float* O; int ldc;
    __device__ __forceinline__ void operator()(const f32x4 (&acc)[2][2][4][2], const Unit& u, int wr, int wc, int fr, int fq) const {
        const int row0 = u.pm * BM + wr * 64 + fr, col0 = u.pn * BM + wc * 32 + 4 * fq;
#pragma unroll
        for (int ai = 0; ai < 2; ++ai)
#pragma unroll
            for (int m = 0; m < 4; ++m) { float* rowp = O + (size_t)(row0 + ai * HALF + m * 16) * ldc + col0;
#pragma unroll
                for (int bj = 0; bj < 2; ++bj)
#pragma unroll
                    for (int n = 0; n < 2; ++n) *(f32x4*)(rowp + bj * HALF + n * 16) = acc[ai][bj][m][n]; }
    }
};
struct EpiFinal {
    static constexpr bool PERM = false, AFTER_DRAIN = false;
    const float* H2; const bf16_t* PE; const float* bias; float* O; int ldc;
    __device__ __forceinline__ void operator()(const f32x4 (&acc)[2][2][4][2], const Unit& u, int wr, int wc, int fr, int fq) const {
        const int row0 = u.pm * BM + wr * 64 + fr, col0 = u.pn * BM + wc * 32 + 4 * fq;
        f32x4 bv[2][2];
#pragma unroll
        for (int bj = 0; bj < 2; ++bj)
#pragma unroll
            for (int n = 0; n < 2; ++n) bv[bj][n] = *(const f32x4*)(bias + col0 + bj * HALF + n * 16);
#pragma unroll
        for (int ai = 0; ai < 2; ++ai)
#pragma unroll
            for (int m = 0; m < 4; ++m) { const size_t off = (size_t)(row0 + ai * HALF + m * 16) * ldc + col0;
#pragma unroll
                for (int bj = 0; bj < 2; ++bj)
#pragma unroll
                    for (int n = 0; n < 2; ++n) { const size_t o2 = off + bj * HALF + n * 16;
                        const f32x4 h = *(const f32x4*)(H2 + o2); const u32x2 pw = *(const u32x2*)(PE + o2);
                        f32x4 pe; pe[0] = __uint_as_float(pw.x << 16); pe[1] = __uint_as_float(pw.x & 0xffff0000u); pe[2] = __uint_as_float(pw.y << 16); pe[3] = __uint_as_float(pw.y & 0xffff0000u);
                        const f32x4 a = acc[ai][bj][m][n] + bv[bj][n]; f32x4 o;
#pragma unroll
                        for (int e = 0; e < 4; ++e) o[e] = h[e] + sigmoid_f(a[e]) * pe[e];
                        *(f32x4*)(O + o2) = o; } }
    }
};

template <class Epi, class Sched, bool ALIGN_EPI = false, bool SP2 = false>
__device__ __forceinline__ void gemm_phase(PG8_LAS unsigned char* lds, const Gemm g, const Sched& S, const Epi& E, const int wave_id) {
    const int wid = wave_id, lane = lane_id_asm(), tid = wid * 64 + lane, wr = wid >> 2, wc = wid & 3, fr = lane & 15, fq = lane >> 4;
    const int K = g.K, nt = K / BK;
    unsigned voffA[2], voffB[2];
#pragma unroll
    for (int i = 0; i < 2; ++i) { int R, C; stage_rc(tid * 16 + i * 8192, R, C); const int Rb = Epi::PERM ? ((R & ~31) + perm32(R & 31)) : R;
        voffA[i] = (unsigned)(R * K + C) * 2u; voffB[i] = (unsigned)(Rb * K + C) * 2u; }
    const size_t kstep = (size_t)(BK * 2);
    const size_t hstep = (size_t)HALF * K * 2;
    const size_t tstep = 2 * hstep;
    const unsigned ldsw = (unsigned)wid * 1024u;
    const int aoff = lds_byte(wr * 64 + fr, fq * 8), boff = lds_byte(wc * 32 + fr, fq * 8);
#define PG8_SA(b, h) (((b) * 2 + (h)) * HTB)
#define PG8_SB(b, h) ((4 + (b) * 2 + (h)) * HTB)
#define PG8_STAGE(bufoff, gbase, voff) do { _Pragma("unroll") for (int _i = 0; _i < 2; ++_i) \
        __builtin_amdgcn_global_load_lds((const unsigned*)((const char*)(gbase) + (voff)[_i]), (PG8_LAS unsigned*)(lds + (bufoff) + ldsw + _i * 8192), 16, 0, 0); } while (0)
#define PG8_LDA(dst, b, h) do { _Pragma("unroll") for (int m = 0; m < 4; ++m) _Pragma("unroll") for (int k = 0; k < 2; ++k) dst[m][k] = *(const PG8_LAS bf16x8*)(lds + PG8_SA(b, h) + aoff + m * 2048 + k * 1024); } while (0)
#define PG8_LDB(dst, b, h) do { _Pragma("unroll") for (int n = 0; n < 2; ++n) _Pragma("unroll") for (int k = 0; k < 2; ++k) dst[n][k] = *(const PG8_LAS bf16x8*)(lds + PG8_SB(b, h) + boff + n * 2048 + k * 1024); } while (0)
#define PG8_MMA(ai, bj, At, Bt) do { __builtin_amdgcn_s_setprio(1); _Pragma("unroll") for (int m = 0; m < 4; ++m) _Pragma("unroll") for (int n = 0; n < 2; ++n) _Pragma("unroll") for (int k = 0; k < 2; ++k) \
        acc[ai][bj][m][n] = __builtin_amdgcn_mfma_f32_16x16x32_bf16(Bt[n][k], At[m][k], acc[ai][bj][m][n], 0, 0, 0); __builtin_amdgcn_s_setprio(0); } while (0)
#define PG8_WAIT_V(n) asm volatile("s_waitcnt vmcnt(" #n ")" ::: "memory")
#define PG8_WAIT_L(n) asm volatile("s_waitcnt lgkmcnt(" #n ")" ::: "memory")
#define PG8_BAR __builtin_amdgcn_s_barrier()
#define PG8_SCHED __builtin_amdgcn_sched_barrier(0)
    Unit cur, nxt; int ui = 0;
    if (!S.next(0, cur)) return;
    f32x4 acc[2][2][4][2];
#pragma unroll
    for (int a = 0; a < 2; ++a)
#pragma unroll
        for (int b = 0; b < 2; ++b)
#pragma unroll
            for (int m = 0; m < 4; ++m)
#pragma unroll
                for (int n = 0; n < 2; ++n) acc[a][b][m][n] = (f32x4){0.f, 0.f, 0.f, 0.f};
    bf16x8 At[4][2], B0[2][2], B1[2][2];
    const char* cA = (const char*)g.A + (size_t)cur.pm * tstep; const char* cB = (const char*)g.Bt + (size_t)cur.pn * tstep;
    S.a_ready(cur);
    if constexpr (SP2) {
        PG8_STAGE(PG8_SB(0, 0), cB, voffB); PG8_STAGE(PG8_SB(0, 1), cB + hstep, voffB); PG8_STAGE(PG8_SA(0, 0), cA, voffA); PG8_STAGE(PG8_SA(0, 1), cA + hstep, voffA);
        if (wr == 1) PG8_BAR;
        PG8_WAIT_V(2); PG8_BAR;
        PG8_STAGE(PG8_SB(1, 0), cB + kstep, voffB); PG8_STAGE(PG8_SA(1, 0), cA + kstep, voffA); PG8_STAGE(PG8_SB(1, 1), cB + hstep + kstep, voffB);
        PG8_WAIT_V(6); PG8_BAR;
    } else {
        PG8_STAGE(PG8_SB(0, 0), cB, voffB); PG8_STAGE(PG8_SA(0, 0), cA, voffA); PG8_STAGE(PG8_SB(0, 1), cB + hstep, voffB); PG8_STAGE(PG8_SA(0, 1), cA + hstep, voffA);
        if (wr == 1) PG8_BAR;
        PG8_WAIT_V(4); PG8_BAR;
        PG8_STAGE(PG8_SB(1, 0), cB + kstep, voffB); PG8_STAGE(PG8_SA(1, 0), cA + kstep, voffA); PG8_STAGE(PG8_SB(1, 1), cB + hstep + kstep, voffB);
        PG8_WAIT_V(6); PG8_BAR;
    }
    for (;;) {
        const bool has_next = S.next(ui + 1, nxt);
        const char* nA = has_next ? (const char*)g.A + (size_t)nxt.pm * tstep : cA; const char* nB = has_next ? (const char*)g.Bt + (size_t)nxt.pn * tstep : cB;
        for (int t = 0; t < nt; t += 2) {
            const bool last = (t == nt - 2);
            const char* a1 = cA + (size_t)(t + 1) * kstep;
            const char* a2 = last ? nA : cA + (size_t)(t + 2) * kstep; const char* b2 = last ? nB : cB + (size_t)(t + 2) * kstep;
            const char* a3 = a2 + kstep; const char* b3 = b2 + kstep;
            if (last && has_next) S.a_ready(nxt);
            if constexpr (SP2) {
            PG8_LDB(B0, 0, 0); PG8_LDB(B1, 0, 1); PG8_SCHED; PG8_LDA(At, 0, 0); PG8_STAGE(PG8_SA(1, 1), a1 + hstep, voffA);
            PG8_WAIT_V(8); PG8_WAIT_L(0); PG8_BAR; PG8_MMA(0, 0, At, B0); PG8_MMA(0, 1, At, B1); PG8_BAR; PG8_SCHED;
            PG8_LDA(At, 0, 1); PG8_STAGE(PG8_SB(0, 0), b2, voffB); PG8_STAGE(PG8_SB(0, 1), b2 + hstep, voffB); PG8_STAGE(PG8_SA(0, 0), a2, voffA);
            PG8_WAIT_V(8); PG8_WAIT_L(0); PG8_BAR; PG8_MMA(1, 0, At, B0); PG8_MMA(1, 1, At, B1); PG8_BAR; PG8_SCHED;
            PG8_LDB(B0, 1, 0); PG8_LDB(B1, 1, 1); PG8_SCHED; PG8_LDA(At, 1, 0); PG8_STAGE(PG8_SA(0, 1), a2 + hstep, voffA);
            PG8_WAIT_V(8); PG8_WAIT_L(0); PG8_BAR; PG8_MMA(0, 0, At, B0); PG8_MMA(0, 1, At, B1); PG8_BAR; PG8_SCHED;
            PG8_LDA(At, 1, 1); PG8_STAGE(PG8_SB(1, 0), b3, voffB); PG8_STAGE(PG8_SB(1, 1), b3 + hstep, voffB); PG8_STAGE(PG8_SA(1, 0), a3, voffA);
            PG8_WAIT_V(8); PG8_WAIT_L(0); PG8_BAR; PG8_MMA(1, 0, At, B0); PG8_MMA(1, 1, At, B1); PG8_BAR; PG8_SCHED;
            } else {
            PG8_LDB(B0, 0, 0); PG8_SCHED; PG8_LDA(At, 0, 0); PG8_STAGE(PG8_SA(1, 1), a1 + hstep, voffA);
            PG8_WAIT_L(8); PG8_BAR; PG8_WAIT_L(0); PG8_MMA(0, 0, At, B0); PG8_BAR; PG8_SCHED;
            PG8_LDB(B1, 0, 1); PG8_STAGE(PG8_SB(0, 0), b2, voffB);
            PG8_BAR; PG8_WAIT_L(0); PG8_MMA(0, 1, At, B1); PG8_BAR;
            PG8_LDA(At, 0, 1); PG8_STAGE(PG8_SA(0, 0), a2, voffA);
            PG8_BAR; PG8_WAIT_L(0); PG8_MMA(1, 0, At, B0); PG8_BAR; PG8_SCHED;
            PG8_STAGE(PG8_SB(0, 1), b2 + hstep, voffB);
            PG8_WAIT_V(6); PG8_BAR; PG8_MMA(1, 1, At, B1); PG8_BAR;
            PG8_LDB(B0, 1, 0); PG8_SCHED; PG8_LDA(At, 1, 0); PG8_STAGE(PG8_SA(0, 1), a2 + hstep, voffA);
            PG8_WAIT_L(8); PG8_BAR; PG8_WAIT_L(0); PG8_MMA(0, 0, At, B0); PG8_BAR; PG8_SCHED;
            PG8_LDB(B1, 1, 1); PG8_STAGE(PG8_SB(1, 0), b3, voffB);
            PG8_BAR; PG8_WAIT_L(0); PG8_MMA(0, 1, At, B1); PG8_BAR;
            PG8_LDA(At, 1, 1); PG8_STAGE(PG8_SA(1, 0), a3, voffA);
            PG8_BAR; PG8_WAIT_L(0); PG8_MMA(1, 0, At, B0); PG8_BAR; PG8_SCHED;
            PG8_STAGE(PG8_SB(1, 1), b3 + hstep, voffB);
            PG8_WAIT_V(6); PG8_BAR; PG8_MMA(1, 1, At, B1); PG8_BAR;
            }
        }
        if constexpr (ALIGN_EPI) { if (wr == 0) PG8_BAR; }
        if constexpr (!Epi::AFTER_DRAIN) { E(acc, cur, wr, wc, fr, fq); S.done(cur); }
        if (!has_next) break;
#pragma unroll
        for (int a = 0; a < 2; ++a)
#pragma unroll
            for (int b = 0; b < 2; ++b)
#pragma unroll
                for (int m = 0; m < 4; ++m)
#pragma unroll
                    for (int n = 0; n < 2; ++n) acc[a][b][m][n] = (f32x4){0.f, 0.f, 0.f, 0.f};
        cur = nxt; cA = nA; cB = nB; ++ui;
        if constexpr (ALIGN_EPI) { if (wr == 1) PG8_BAR; }
    }
    PG8_WAIT_V(0);
    if constexpr (!ALIGN_EPI) { if (wr == 0) PG8_BAR; }
    PG8_BAR;
    if constexpr (Epi::AFTER_DRAIN) { E.fused(acc, cur, wr, wc, fr, fq, lds, wid, lane); S.done(cur); }
#undef PG8_SA
#undef PG8_SB
#undef PG8_STAGE
#undef PG8_LDA
#undef PG8_LDB
#undef PG8_MMA
#undef PG8_WAIT_V
#undef PG8_WAIT_L
#undef PG8_BAR
#undef PG8_SCHED
}
}

constexpr int NWAVES = 8;
constexpr int BATCH = 4, SEQ = 8192, DM = 1024, MTOK = BATCH * SEQ, PLE = 256, AW = 512, SW = 512, HD = 64, NH = 8, NG = 4, GD = 128, CHUNK = 128, DFF = 2816, PC = 2560;
constexpr float EPS = 1e-6f;
#ifndef MK_N_LAUNCHES
#define MK_N_LAUNCHES 10
#endif
constexpr int N_PHASES = 10;

constexpr size_t MiB = 1u << 20;
constexpr size_t WS_W1 = 2 * MiB, WS_W2 = 8 * MiB, WS_W3 = 10 * MiB, WS_W4 = 22 * MiB, WS_W5 = 28 * MiB, WS_W6 = 30 * MiB;
constexpr size_t WS_XN = 32 * MiB;
constexpr size_t WS_PE = 96 * MiB;
constexpr size_t WS_PB = 160 * MiB;
constexpr size_t WS_PROJ = 176 * MiB;
constexpr size_t WS_AO = 336 * MiB;
constexpr size_t WS_LSE = 432 * MiB;
constexpr size_t WS_SG = 436 * MiB;
constexpr size_t WS_GROUPS = 176 * MiB;
constexpr size_t WS_MIXED = 240 * MiB;
constexpr size_t WS_H1 = 368 * MiB;
constexpr size_t WS_ACT = 176 * MiB;
constexpr size_t WS_END = 496 * MiB;
static_assert(WS_ACT + (size_t)MTOK * DFF * 2 <= WS_H1 && WS_MIXED + (size_t)MTOK * DM * 4 <= WS_H1 && WS_H1 + (size_t)MTOK * DM * 4 <= WS_END, "ws map");
static_assert(WS_PROJ + (size_t)MTOK * PC * 2 <= WS_AO && WS_AO + 3 * (size_t)MTOK * AW * 2 <= WS_LSE && WS_SG + (size_t)MTOK * SW * 2 <= WS_END, "ws map 2");

constexpr int RING_BYTES = 131072;
constexpr int LDS_BYTES = 147456;

#define GAS __attribute__((address_space(1)))
#define LAS __attribute__((address_space(3)))
typedef unsigned short bf16;
typedef unsigned v4u __attribute__((ext_vector_type(4)));
typedef unsigned v2u __attribute__((ext_vector_type(2)));
typedef float f32x4 __attribute__((ext_vector_type(4)));
typedef short bf16x8 __attribute__((ext_vector_type(8)));
typedef short v4i16_t __attribute__((ext_vector_type(4)));
typedef float f32x2_t __attribute__((ext_vector_type(2)));
typedef __bf16 bf16x2_t __attribute__((ext_vector_type(2)));
#define LDS_WAIT() asm volatile("s_waitcnt lgkmcnt(0)" ::: "memory")
__device__ __forceinline__ unsigned pk2(float lo, float hi) { f32x2_t v = {lo, hi}; bf16x2_t b = __builtin_convertvector(v, bf16x2_t); return __builtin_bit_cast(unsigned, b); }
__device__ __forceinline__ float bflo(unsigned w) { return __uint_as_float(w << 16); }
__device__ __forceinline__ float bfhi(unsigned w) { return __uint_as_float(w & 0xffff0000u); }
__device__ __forceinline__ float wave_sum(float v) {
#pragma unroll
    for (int o = 1; o < 64; o <<= 1) v += __shfl_xor(v, o);
    return v;
}
__device__ __forceinline__ v4i16_t tr_read(LAS unsigned char* p) { return __builtin_amdgcn_ds_read_tr16_b64_v4i16((LAS v4i16_t*)p); }

struct Args { const float* in[19]; float* out; unsigned char* ws; int ph_lo, ph_hi; };
#define CAS __attribute__((address_space(4)))
__device__ __forceinline__ const float* arg_in(int i) {
    const CAS unsigned char* kp = (const CAS unsigned char*)__builtin_amdgcn_kernarg_segment_ptr();
    asm volatile("" : "+s"(kp));
    typedef const float* cfp_t;
    return *(const CAS cfp_t*)(kp + 8 * i);
}
struct Frame {
    LAS unsigned char* lds;
    int wave, vcu, G;
    float* out; unsigned char* ws;
};

__device__ __forceinline__ void p0_transpose_item(const float* W, int K, int N, bf16* WT, int mode, const float* ks0, const float* ks1, LAS float* scr, int item, int lane) {
    const int nblk = N / 32, kb = item / nblk, nb = item % nblk, k0 = 64 * kb, n0 = 32 * nb;
#pragma unroll 8
    for (int i = 0; i < 32; ++i) { const int kk = 2 * i + (lane >> 5); const int kg = k0 + kk;
        const float sc = ks0 ? (kg < 512 ? ks0[kg] : ks1[kg - 512]) : 1.0f;
        scr[kk * 33 + (lane & 31)] = W[(size_t)kg * N + n0 + (lane & 31)] * sc; }
    LDS_WAIT(); asm volatile("" ::: "memory");
    int d0 = n0;
    if (mode == 1) { d0 = (n0 < DFF) ? ((n0 / 128) * 256 + (n0 % 128)) : (((n0 - DFF) / 128) * 256 + 128 + ((n0 - DFF) % 128)); }
    const int c = lane & 7;
#pragma unroll
    for (int j = 0; j < 4; ++j) { const int n = (lane >> 3) + 8 * j; const LAS float* s = scr + (8 * c) * 33 + n;
        v4u o; o.x = pk2(s[0 * 33], s[1 * 33]); o.y = pk2(s[2 * 33], s[3 * 33]); o.z = pk2(s[4 * 33], s[5 * 33]); o.w = pk2(s[6 * 33], s[7 * 33]);
        *(GAS v4u*)(WT + (size_t)(d0 + n) * K + k0 + 8 * c) = o; }
    LDS_WAIT(); asm volatile("" ::: "memory");
}
__device__ __forceinline__ void p0_prologue(Frame& F, const Args& A) {
    const int lane_ = pg8::lane_id_asm();
    LAS float* scr = (LAS float*)(F.lds + F.wave * 16384);
    const int gw = F.vcu * NWAVES + F.wave, NGW = F.G * NWAVES;
    bf16* W1t = (bf16*)(F.ws + WS_W1); bf16* W2t = (bf16*)(F.ws + WS_W2); bf16* W3t = (bf16*)(F.ws + WS_W3);
    bf16* W4t = (bf16*)(F.ws + WS_W4); bf16* W5t = (bf16*)(F.ws + WS_W5); bf16* W6t = (bf16*)(F.ws + WS_W6);
    constexpr int I1 = (DM / 64) * (PC / 32), I2 = (DM / 64) * (DM / 32), I3 = (DM / 64) * (2 * DFF / 32), I4 = (DFF / 64) * (DM / 32), I5 = I2, I6 = (PLE / 64) * (DM / 32);
    constexpr int NITEMS = I1 + I2 + I3 + I4 + I5 + I6;
    for (int it = gw; it < NITEMS; it += NGW) {
        int r = it;
        if (r < I1) { p0_transpose_item(arg_in(3), DM, PC, W1t, 0, arg_in(2), arg_in(2) + 512, scr, r, lane_); continue; } r -= I1;
        if (r < I2) { p0_transpose_item(arg_in(10), DM, DM, W2t, 0, arg_in(8), arg_in(9), scr, r, lane_); continue; } r -= I2;
        if (r < I3) { p0_transpose_item(arg_in(13), DM, 2 * DFF, W3t, 1, arg_in(12), arg_in(12) + 512, scr, r, lane_); continue; } r -= I3;
        if (r < I4) { p0_transpose_item(arg_in(14), DFF, DM, W4t, 0, nullptr, nullptr, scr, r, lane_); continue; } r -= I4;
        if (r < I5) { p0_transpose_item(arg_in(16), DM, DM, W5t, 0, nullptr, nullptr, scr, r, lane_); continue; } r -= I5;
        p0_transpose_item(arg_in(18), PLE, DM, W6t, 0, nullptr, nullptr, scr, r, lane_);
    }
    bf16* XN = (bf16*)(F.ws + WS_XN); bf16* PB = (bf16*)(F.ws + WS_PB);
    for (int m = gw; m < MTOK; m += NGW) {
        const GAS f32x4* xr = (const GAS f32x4*)(arg_in(0) + (size_t)m * DM) + lane_;
        f32x4 v[4]; float s = 0.f;
#pragma unroll
        for (int j = 0; j < 4; ++j) { v[j] = xr[64 * j]; s += (v[j].x * v[j].x + v[j].y * v[j].y) + (v[j].z * v[j].z + v[j].w * v[j].w); }
        const f32x4 pv = *((const GAS f32x4*)(arg_in(1) + (size_t)m * PLE) + lane_);
        const float rinv = 1.0f / sqrtf(wave_sum(s) * (1.0f / DM) + EPS);
        GAS v2u* o8 = (GAS v2u*)(XN + (size_t)m * DM) + lane_;
#pragma unroll
        for (int j = 0; j < 4; ++j) { v2u o; o.x = pk2(v[j].x * rinv, v[j].y * rinv); o.y = pk2(v[j].z * rinv, v[j].w * rinv); o8[64 * j] = o; }
        v2u po; po.x = pk2(pv.x, pv.y); po.y = pk2(pv.z, pv.w);
        *((GAS v2u*)(PB + (size_t)m * PLE) + lane_) = po;
    }
}

constexpr int KP = 144;
constexpr int ATT_LDS_K = 0, ATT_LDS_V = 256 * KP;
constexpr int ATT_ITEMS = 3 * BATCH * NH * 64;
struct AttItem { int br, b, h, d, tok_cur, tok_prev; bool first; };
__device__ __forceinline__ AttItem att_decode(int id) {
    AttItem I; I.br = id / 2048; int rem = id % 2048; I.b = rem / 512; rem %= 512; I.h = rem / 64; const int s = rem % 64;
    I.d = 1 << (2 * I.br); const int nb = 64 >> (2 * I.br); const int r = s / nb, n = s % nb;
    I.first = (n == 0);
    I.tok_cur = I.b * SEQ + r + I.d * (128 * n); I.tok_prev = I.first ? I.tok_cur : I.tok_cur - I.d * 128;
    return I;
}
__device__ __forceinline__ void att_load(const AttItem& I, const bf16* PROJ, int tid, v4u (&kr)[4], v4u (&vr)[4]) {
#pragma unroll
    for (int i = 0; i < 4; ++i) { const int c = tid + 512 * i, row = c >> 3, ch = c & 7;
        const int tok = (row < 128) ? (I.tok_prev + I.d * row) : (I.tok_cur + I.d * (row - 128));
        const bf16* src = PROJ + (size_t)tok * PC + AW + I.h * HD + ch * 8;
        kr[i] = *(const GAS v4u*)src; vr[i] = *(const GAS v4u*)(src + AW); }
}
__device__ __forceinline__ void att_phase(Frame& F, const Args& A, int first_item, int n_items) {
    const bf16* PROJ = (const bf16*)(F.ws + WS_PROJ);
    bf16* AO = (bf16*)(F.ws + WS_AO); float* LSE = (float*)(F.ws + WS_LSE);
    LAS unsigned char* lds = F.lds;
    const int lane = pg8::lane_id_asm(), w = F.wave, tid = w * 64 + lane, l15 = lane & 15, fq = lane >> 4;
    v4u kr[4], vr[4];
    AttItem I = att_decode(first_item);
    att_load(I, PROJ, tid, kr, vr);
    for (int it = 0; it < n_items; ++it) {
#pragma unroll
        for (int i = 0; i < 4; ++i) { const int c = tid + 512 * i, row = c >> 3, ch = c & 7;
            *(LAS v4u*)(lds + ATT_LDS_K + row * KP + ch * 16) = kr[i]; *(LAS v4u*)(lds + ATT_LDS_V + row * KP + ch * 16) = vr[i]; }
        const AttItem C = I;
        __syncthreads();
        if (it + 1 < n_items) { I = att_decode(first_item + it + 1); att_load(I, PROJ, tid, kr, vr); }
        const int qtok = C.tok_cur + C.d * (16 * w + l15);
        const bf16* qp = PROJ + (size_t)qtok * PC + C.h * HD + 8 * fq;
        const bf16x8 q0 = *(const GAS bf16x8*)qp, q1 = *(const GAS bf16x8*)(qp + 32);
        f32x4 s[9];
#pragma unroll
        for (int kk = 0; kk < 9; ++kk) {
            LAS unsigned char* kp = lds + ATT_LDS_K + (16 * (w + kk) + l15) * KP + 16 * fq;
            const bf16x8 a0 = *(const LAS bf16x8*)kp, a1 = *(const LAS bf16x8*)(kp + 64);
            f32x4 z = {0.f, 0.f, 0.f, 0.f};
            z = __builtin_amdgcn_mfma_f32_16x16x32_bf16(a0, q0, z, 0, 0, 0);
            s[kk] = __builtin_amdgcn_mfma_f32_16x16x32_bf16(a1, q1, z, 0, 0, 0);
        }
        const float LOG2E = 1.4426950408889634f;
        const float c2 = LOG2E * (float)C.d * __builtin_amdgcn_exp2f(-(float)(C.h + 1));
        float mx = -3.0e38f;
#pragma unroll
        for (int kk = 0; kk < 9; ++kk)
#pragma unroll
            for (int j = 0; j < 4; ++j) { const int steps = 128 - 16 * kk + l15 - 4 * fq - j;
                const bool valid = (steps >= 0) && (steps <= 128) && (!C.first || (16 * (w + kk) + 4 * fq + j >= 128));
                const float v = valid ? (s[kk][j] * LOG2E - c2 * (float)steps) : -3.0e38f;
                s[kk][j] = v; mx = fmaxf(mx, v); }
        mx = fmaxf(mx, __shfl_xor(mx, 16)); mx = fmaxf(mx, __shfl_xor(mx, 32));
        float sum = 0.f;
#pragma unroll
        for (int kk = 0; kk < 9; ++kk)
#pragma unroll
            for (int j = 0; j < 4; ++j) { const float p = __builtin_amdgcn_exp2f(s[kk][j] - mx); s[kk][j] = p; sum += p; }
        sum += __shfl_xor(sum, 16); sum += __shfl_xor(sum, 32);
        f32x4 o[4];
#pragma unroll
        for (int d0 = 0; d0 < 4; ++d0) o[d0] = (f32x4){0.f, 0.f, 0.f, 0.f};
#pragma unroll
        for (int pp = 0; pp < 5; ++pp) {
            const int kA = 2 * pp, kB = (pp < 4) ? 2 * pp + 1 : 2 * pp;
            v4u pw; pw.x = pk2(s[kA][0], s[kA][1]); pw.y = pk2(s[kA][2], s[kA][3]);
            if (pp < 4) { pw.z = pk2(s[kB][0], s[kB][1]); pw.w = pk2(s[kB][2], s[kB][3]); } else { pw.z = 0u; pw.w = 0u; }
            const bf16x8 pf = __builtin_bit_cast(bf16x8, pw);
            LAS unsigned char* va = lds + ATT_LDS_V + (16 * (w + kA) + 4 * fq + (l15 >> 2)) * KP + 8 * (l15 & 3);
            LAS unsigned char* vb = lds + ATT_LDS_V + (16 * (w + kB) + 4 * fq + (l15 >> 2)) * KP + 8 * (l15 & 3);
#pragma unroll
            for (int d0 = 0; d0 < 4; ++d0) {
                const v4i16_t lo = tr_read(va + 32 * d0), hi = tr_read(vb + 32 * d0);
                const bf16x8 vf = {lo[0], lo[1], lo[2], lo[3], hi[0], hi[1], hi[2], hi[3]};
                o[d0] = __builtin_amdgcn_mfma_f32_16x16x32_bf16(vf, pf, o[d0], 0, 0, 0);
            }
        }
        const float inv = 1.0f / sum;
        bf16* op = AO + (size_t)C.br * MTOK * AW + (size_t)qtok * AW + C.h * HD + 4 * fq;
#pragma unroll
        for (int d0 = 0; d0 < 4; ++d0) { v2u ow; ow.x = pk2(o[d0][0] * inv, o[d0][1] * inv); ow.y = pk2(o[d0][2] * inv, o[d0][3] * inv); *(GAS v2u*)(op + 16 * d0) = ow; }
        if (fq == 0) LSE[(size_t)C.br * MTOK * NH + (size_t)qtok * NH + C.h] = mx + __builtin_amdgcn_logf(sum);
        __syncthreads();
    }
}

constexpr int ZP = 272;
constexpr int SGU_ITEMS = BATCH * (SEQ / CHUNK) * NG;
__device__ __forceinline__ void sgu_phase(Frame& F, const Args& A, int first_item, int n_items) {
    const bf16* PROJ = (const bf16*)(F.ws + WS_PROJ); bf16* SG = (bf16*)(F.ws + WS_SG);
    const float* lng = arg_in(4); const float* lnb = arg_in(5); const float* wsp = arg_in(6); const float* bsp = arg_in(7);
    LAS unsigned char* lds = F.lds;
    const int lane = pg8::lane_id_asm(), w = F.wave, tid = w * 64 + lane, l15 = lane & 15, fq = lane >> 4;
    for (int it = 0; it < n_items; ++it) {
        const int id = first_item + it, b = id / 256, n = (id % 256) / 4, g = id % 4;
        const int t0 = b * SEQ + n * CHUNK;
        const int c8 = tid & 15;
        f32x4 g0 = *(const GAS f32x4*)(lng + c8 * 8), g1 = *(const GAS f32x4*)(lng + c8 * 8 + 4), b0 = *(const GAS f32x4*)(lnb + c8 * 8), b1 = *(const GAS f32x4*)(lnb + c8 * 8 + 4);
#pragma unroll
        for (int i = 0; i < 4; ++i) { const int j = 32 * i + (tid >> 4);
            const v4u zw = *(const GAS v4u*)(PROJ + (size_t)(t0 + j) * PC + 2048 + g * GD + c8 * 8);
            float x[8] = {bflo(zw.x), bfhi(zw.x), bflo(zw.y), bfhi(zw.y), bflo(zw.z), bfhi(zw.z), bflo(zw.w), bfhi(zw.w)};
            float s = ((x[0] + x[1]) + (x[2] + x[3])) + ((x[4] + x[5]) + (x[6] + x[7]));
            s += __shfl_xor(s, 1); s += __shfl_xor(s, 2); s += __shfl_xor(s, 4); s += __shfl_xor(s, 8);
            const float mean = s * (1.0f / GD); float q = 0.f;
#pragma unroll
            for (int e = 0; e < 8; ++e) { x[e] -= mean; q += x[e] * x[e]; }
            q += __shfl_xor(q, 1); q += __shfl_xor(q, 2); q += __shfl_xor(q, 4); q += __shfl_xor(q, 8);
            const float rstd = 1.0f / sqrtf(q * (1.0f / GD) + EPS);
            v4u o; o.x = pk2(x[0] * rstd * g0.x + b0.x, x[1] * rstd * g0.y + b0.y); o.y = pk2(x[2] * rstd * g0.z + b0.z, x[3] * rstd * g0.w + b0.w);
            o.z = pk2(x[4] * rstd * g1.x + b1.x, x[5] * rstd * g1.y + b1.y); o.w = pk2(x[6] * rstd * g1.z + b1.z, x[7] * rstd * g1.w + b1.w);
            *(LAS v4u*)(lds + j * ZP + c8 * 16) = o; }
        __syncthreads();
        const int i_loc = 16 * w + l15;
        const float* wrow = wsp + ((size_t)g * CHUNK + i_loc) * CHUNK;
        f32x4 acc[8];
#pragma unroll
        for (int cb = 0; cb < 8; ++cb) acc[cb] = (f32x4){0.f, 0.f, 0.f, 0.f};
        const int nks = (w >> 1) + 1;
        for (int ks = 0; ks < nks; ++ks) {
            const int j0 = 32 * ks + 8 * fq;
            const f32x4 wa = *(const GAS f32x4*)(wrow + j0), wb = *(const GAS f32x4*)(wrow + j0 + 4);
            v4u ww; ww.x = pk2(j0 + 0 <= i_loc ? wa.x : 0.f, j0 + 1 <= i_loc ? wa.y : 0.f); ww.y = pk2(j0 + 2 <= i_loc ? wa.z : 0.f, j0 + 3 <= i_loc ? wa.w : 0.f);
            ww.z = pk2(j0 + 4 <= i_loc ? wb.x : 0.f, j0 + 5 <= i_loc ? wb.y : 0.f); ww.w = pk2(j0 + 6 <= i_loc ? wb.z : 0.f, j0 + 7 <= i_loc ? wb.w : 0.f);
            const bf16x8 wf = __builtin_bit_cast(bf16x8, ww);
            LAS unsigned char* zp = lds + (32 * ks + 8 * fq + (l15 >> 2)) * ZP + 8 * (l15 & 3);
#pragma unroll
            for (int cb = 0; cb < 8; ++cb) {
                const v4i16_t lo = tr_read(zp + 32 * cb), hi = tr_read(zp + 4 * ZP + 32 * cb);
                const bf16x8 zf = {lo[0], lo[1], lo[2], lo[3], hi[0], hi[1], hi[2], hi[3]};
                acc[cb] = __builtin_amdgcn_mfma_f32_16x16x32_bf16(zf, wf, acc[cb], 0, 0, 0);
            }
        }
        const float bs = bsp[g * CHUNK + i_loc];
        const bf16* up = PROJ + (size_t)(t0 + i_loc) * PC + 1536 + g * GD + 4 * fq;
        bf16* op = SG + (size_t)(t0 + i_loc) * SW + g * GD + 4 * fq;
#pragma unroll
        for (int cb = 0; cb < 8; ++cb) { const v2u uw = *(const GAS v2u*)(up + 16 * cb);
            v2u ow; ow.x = pk2(bflo(uw.x) * (acc[cb][0] + bs), bfhi(uw.x) * (acc[cb][1] + bs)); ow.y = pk2(bflo(uw.y) * (acc[cb][2] + bs), bfhi(uw.y) * (acc[cb][3] + bs));
            *(GAS v2u*)(op + 16 * cb) = ow; }
        __syncthreads();
    }
}

__device__ __forceinline__ void merge_phase(Frame& F, const Args& A) {
    const bf16* AO = (const bf16*)(F.ws + WS_AO); const float* LSE = (const float*)(F.ws + WS_LSE); const bf16* SG = (const bf16*)(F.ws + WS_SG);
    bf16* GR = (bf16*)(F.ws + WS_GROUPS);
    const int gw = F.vcu * NWAVES + F.wave, NGW = F.G * NWAVES, lane = pg8::lane_id_asm(), h = lane >> 3;
    for (int m = gw; m < MTOK; m += NGW) {
        float l0 = LSE[(size_t)m * NH + h], l1 = LSE[(size_t)MTOK * NH + (size_t)m * NH + h], l2 = LSE[(size_t)2 * MTOK * NH + (size_t)m * NH + h];
        const v4u a0 = *((const GAS v4u*)(AO + (size_t)m * AW) + lane), a1 = *((const GAS v4u*)(AO + (size_t)MTOK * AW + (size_t)m * AW) + lane), a2 = *((const GAS v4u*)(AO + (size_t)2 * MTOK * AW + (size_t)m * AW) + lane);
        const v4u sg = *((const GAS v4u*)(SG + (size_t)m * SW) + lane);
        const float lm = fmaxf(l0, fmaxf(l1, l2));
        float w0 = __builtin_amdgcn_exp2f(l0 - lm), w1 = __builtin_amdgcn_exp2f(l1 - lm), w2 = __builtin_amdgcn_exp2f(l2 - lm);
        const float wi = 1.0f / (w0 + w1 + w2); w0 *= wi; w1 *= wi; w2 *= wi;
        float o[8], sv[8];
        o[0] = w0 * bflo(a0.x) + w1 * bflo(a1.x) + w2 * bflo(a2.x); o[1] = w0 * bfhi(a0.x) + w1 * bfhi(a1.x) + w2 * bfhi(a2.x);
        o[2] = w0 * bflo(a0.y) + w1 * bflo(a1.y) + w2 * bflo(a2.y); o[3] = w0 * bfhi(a0.y) + w1 * bfhi(a1.y) + w2 * bfhi(a2.y);
        o[4] = w0 * bflo(a0.z) + w1 * bflo(a1.z) + w2 * bflo(a2.z); o[5] = w0 * bfhi(a0.z) + w1 * bfhi(a1.z) + w2 * bfhi(a2.z);
        o[6] = w0 * bflo(a0.w) + w1 * bflo(a1.w) + w2 * bflo(a2.w); o[7] = w0 * bfhi(a0.w) + w1 * bfhi(a1.w) + w2 * bfhi(a2.w);
        sv[0] = bflo(sg.x); sv[1] = bfhi(sg.x); sv[2] = bflo(sg.y); sv[3] = bfhi(sg.y); sv[4] = bflo(sg.z); sv[5] = bfhi(sg.z); sv[6] = bflo(sg.w); sv[7] = bfhi(sg.w);
        float sa = 0.f, ss = 0.f;
#pragma unroll
        for (int e = 0; e < 8; ++e) { sa += o[e] * o[e]; ss += sv[e] * sv[e]; }
        const float ra = 1.0f / sqrtf(wave_sum(sa) * (1.0f / AW) + EPS), rs = 1.0f / sqrtf(wave_sum(ss) * (1.0f / SW) + EPS);
        v4u oa, os;
        oa.x = pk2(o[0] * ra, o[1] * ra); oa.y = pk2(o[2] * ra, o[3] * ra); oa.z = pk2(o[4] * ra, o[5] * ra); oa.w = pk2(o[6] * ra, o[7] * ra);
        os.x = pk2(sv[0] * rs, sv[1] * rs); os.y = pk2(sv[2] * rs, sv[3] * rs); os.z = pk2(sv[4] * rs, sv[5] * rs); os.w = pk2(sv[6] * rs, sv[7] * rs);
        *((GAS v4u*)(GR + (size_t)m * DM) + lane) = oa; *((GAS v4u*)(GR + (size_t)m * DM + AW) + lane) = os;
    }
}

__device__ __forceinline__ void rowpass_mix(Frame& F, const Args& A) {
    const float* MIX = (const float*)(F.ws + WS_MIXED); float* H1 = (float*)(F.ws + WS_H1); bf16* FB = (bf16*)(F.ws + WS_XN);
    const float* gpost = arg_in(11);
    const int gw = F.vcu * NWAVES + F.wave, NGW = F.G * NWAVES, lane = pg8::lane_id_asm();
    f32x4 gv[4];
#pragma unroll
    for (int j = 0; j < 4; ++j) gv[j] = *((const GAS f32x4*)gpost + lane + 64 * j);
    for (int m = gw; m < MTOK; m += NGW) {
        const GAS f32x4* mr = (const GAS f32x4*)(MIX + (size_t)m * DM) + lane; const GAS f32x4* xr = (const GAS f32x4*)(arg_in(0) + (size_t)m * DM) + lane;
        f32x4 v[4], xv[4]; float s = 0.f;
#pragma unroll
        for (int j = 0; j < 4; ++j) { v[j] = mr[64 * j]; xv[j] = xr[64 * j]; s += (v[j].x * v[j].x + v[j].y * v[j].y) + (v[j].z * v[j].z + v[j].w * v[j].w); }
        const float r1 = 1.0f / sqrtf(wave_sum(s) * (1.0f / DM) + EPS); float s2 = 0.f;
        GAS f32x4* hr = (GAS f32x4*)(H1 + (size_t)m * DM) + lane;
#pragma unroll
        for (int j = 0; j < 4; ++j) { v[j] = xv[j] + v[j] * r1 * gv[j]; hr[64 * j] = v[j]; s2 += (v[j].x * v[j].x + v[j].y * v[j].y) + (v[j].z * v[j].z + v[j].w * v[j].w); }
        const float r2 = 1.0f / sqrtf(wave_sum(s2) * (1.0f / DM) + EPS);
        GAS v2u* o8 = (GAS v2u*)(FB + (size_t)m * DM) + lane;
#pragma unroll
        for (int j = 0; j < 4; ++j) { v2u o; o.x = pk2(v[j].x * r2, v[j].y * r2); o.y = pk2(v[j].z * r2, v[j].w * r2); o8[64 * j] = o; }
    }
}
__device__ __forceinline__ void rowpass_ffn(Frame& F, const Args& A) {
    const float* Y = F.out; float* H1 = (float*)(F.ws + WS_H1); bf16* HB = (bf16*)(F.ws + WS_XN);
    const float* gpost = arg_in(15);
    const int gw = F.vcu * NWAVES + F.wave, NGW = F.G * NWAVES, lane = pg8::lane_id_asm();
    f32x4 gv[4];
#pragma unroll
    for (int j = 0; j < 4; ++j) gv[j] = *((const GAS f32x4*)gpost + lane + 64 * j);
    for (int m = gw; m < MTOK; m += NGW) {
        const GAS f32x4* yr = (const GAS f32x4*)(Y + (size_t)m * DM) + lane; GAS f32x4* hr = (GAS f32x4*)(H1 + (size_t)m * DM) + lane;
        f32x4 v[4], hv[4]; float s = 0.f;
#pragma unroll
        for (int j = 0; j < 4; ++j) { v[j] = yr[64 * j]; hv[j] = hr[64 * j]; s += (v[j].x * v[j].x + v[j].y * v[j].y) + (v[j].z * v[j].z + v[j].w * v[j].w); }
        const float r1 = 1.0f / sqrtf(wave_sum(s) * (1.0f / DM) + EPS);
        GAS v2u* o8 = (GAS v2u*)(HB + (size_t)m * DM) + lane;
#pragma unroll
        for (int j = 0; j < 4; ++j) { v[j] = hv[j] + v[j] * r1 * gv[j]; hr[64 * j] = v[j]; v2u o; o.x = pk2(v[j].x, v[j].y); o.y = pk2(v[j].z, v[j].w); o8[64 * j] = o; }
    }
}

__device__ __forceinline__ void grid_bar(unsigned* ctr, unsigned target, int wave) {
    asm volatile("s_waitcnt vmcnt(0)" ::: "memory");
    __syncthreads();
    if (wave == 0) {
        if (pg8::lane_id_asm() == 0) {
            __builtin_amdgcn_fence(__ATOMIC_RELEASE, "agent");
            asm volatile("s_waitcnt vmcnt(0)" ::: "memory");
            __hip_atomic_fetch_add(ctr, 1u, __ATOMIC_RELAXED, __HIP_MEMORY_SCOPE_AGENT);
            while (__hip_atomic_load(ctr, __ATOMIC_RELAXED, __HIP_MEMORY_SCOPE_AGENT) < target) __builtin_amdgcn_s_sleep(2);
            __builtin_amdgcn_fence(__ATOMIC_ACQUIRE, "agent");
            asm volatile("s_waitcnt vmcnt(0)" ::: "memory");
        }
    }
    __syncthreads();
}

__global__ void __launch_bounds__(NWAVES * 64, 2) mk_fwd(Args args) {
    extern __shared__ __attribute__((aligned(16))) unsigned char lds_raw[];
    cg::grid_group grid = cg::this_grid();
    Frame F;
    F.lds = (LAS unsigned char*)lds_raw;
    F.wave = __builtin_amdgcn_readfirstlane(threadIdx.x >> 6);
    F.G = gridDim.x; { const int bx = blockIdx.x; F.vcu = (F.G % 8 == 0) ? (bx % 8) * (F.G / 8) + bx / 8 : bx; }
    F.out = args.out; F.ws = args.ws;
    const int lo = args.ph_lo, hi = args.ph_hi;
#define IN(k) (lo <= (k) && (k) < hi)
    unsigned* const bar_ctr = (unsigned*)F.ws;
#define SEAM(k) do { if (IN(k) && IN((k) + 1)) { if ((k) == 0) grid.sync(); else grid_bar(bar_ctr, (unsigned)F.G * (unsigned)(k), F.wave); } } while (0)
    const pg8::bf16_t* XN = (const pg8::bf16_t*)(F.ws + WS_XN);

    if (IN(0)) { if (blockIdx.x == 0 && threadIdx.x == 0) __hip_atomic_store(bar_ctr, 0u, __ATOMIC_RELAXED, __HIP_MEMORY_SCOPE_AGENT); p0_prologue(F, args); }
    SEAM(0);
    if (IN(1)) {
        { pg8::Gemm g{XN, (const pg8::bf16_t*)(F.ws + WS_W1), MTOK, PC, DM}; pg8::StaticOrder S; S.init(MTOK, PC, F.G, (int)blockIdx.x);
          pg8::EpiBf16M<1> E{(pg8::bf16_t*)(F.ws + WS_PROJ), PC};
          pg8::gemm_phase<pg8::EpiBf16M<1>, pg8::StaticOrder, true, true>(F.lds, g, S, E, F.wave); }
        { pg8::Gemm g{(const pg8::bf16_t*)(F.ws + WS_PB), (const pg8::bf16_t*)(F.ws + WS_W6), MTOK, DM, PLE}; pg8::StaticOrder S; S.init(MTOK, DM, F.G, (int)blockIdx.x);
          pg8::EpiBf16M<0> E{(pg8::bf16_t*)(F.ws + WS_PE), DM};
          pg8::gemm_phase<pg8::EpiBf16M<0>, pg8::StaticOrder, true, true>(F.lds, g, S, E, F.wave); }
    }
    SEAM(1);
    if (IN(2)) {
        { const int per = (ATT_ITEMS + F.G - 1) / F.G; const int f0 = F.vcu * per; int n = ATT_ITEMS - f0; n = n < 0 ? 0 : (n > per ? per : n); if (n > 0) att_phase(F, args, f0, n); }
        __syncthreads();
        { const int per = (SGU_ITEMS + F.G - 1) / F.G; const int f0 = F.vcu * per; int n = SGU_ITEMS - f0; n = n < 0 ? 0 : (n > per ? per : n); if (n > 0) sgu_phase(F, args, f0, n); }
    }
    SEAM(2);
    if (IN(3)) { merge_phase(F, args); }
    SEAM(3);
    if (IN(4)) {
        pg8::Gemm g{(const pg8::bf16_t*)(F.ws + WS_GROUPS), (const pg8::bf16_t*)(F.ws + WS_W2), MTOK, DM, DM}; pg8::StaticOrder S; S.init(MTOK, DM, F.G, (int)blockIdx.x);
        pg8::EpiF32 E{(float*)(F.ws + WS_MIXED), DM};
        pg8::gemm_phase<pg8::EpiF32, pg8::StaticOrder, true, true>(F.lds, g, S, E, F.wave);
    }
    SEAM(4);
    if (IN(5)) { rowpass_mix(F, args); }
    SEAM(5);
    if (IN(6)) {
        pg8::Gemm g{XN, (const pg8::bf16_t*)(F.ws + WS_W3), MTOK, 2 * DFF, DM}; pg8::StaticOrder S; S.init(MTOK, 2 * DFF, F.G, (int)blockIdx.x);
        pg8::EpiSwiglu E{(pg8::bf16_t*)(F.ws + WS_ACT), DFF};
        pg8::gemm_phase<pg8::EpiSwiglu, pg8::StaticOrder, true, true>(F.lds, g, S, E, F.wave);
    }
    SEAM(6);
    if (IN(7)) {
        pg8::Gemm g{(const pg8::bf16_t*)(F.ws + WS_ACT), (const pg8::bf16_t*)(F.ws + WS_W4), MTOK, DM, DFF}; pg8::StaticOrder S; S.init(MTOK, DM, F.G, (int)blockIdx.x);
        pg8::EpiF32 E{F.out, DM};
        pg8::gemm_phase<pg8::EpiF32, pg8::StaticOrder, true, true>(F.lds, g, S, E, F.wave);
    }
    SEAM(7);
    if (IN(8)) { rowpass_ffn(F, args); }
    SEAM(8);
    if (IN(9)) {
        pg8::Gemm g{XN, (const pg8::bf16_t*)(F.ws + WS_W5), MTOK, DM, DM}; pg8::StaticOrder S; S.init(MTOK, DM, F.G, (int)blockIdx.x);
        pg8::EpiFinal E{(const float*)(F.ws + WS_H1), (const pg8::bf16_t*)(F.ws + WS_PE), arg_in(17), F.out, DM};
        pg8::gemm_phase<pg8::EpiFinal, pg8::StaticOrder, true, true>(F.lds, g, S, E, F.wave);
    }
#undef IN
#undef SEAM
}

extern "C" void kernel_launch(void* const* d_in, const int* in_sizes, int n_in, void* d_out, int out_size, void* d_ws, size_t ws_size, hipStream_t stream) {
    static int grid = 0;
    if (grid == 0) {
        if (n_in != 19 || in_sizes[0] != MTOK * DM || out_size != MTOK * DM || ws_size < WS_END) { fprintf(stderr, "kernel_launch: unexpected shapes (n_in %d, in0 %d, out %d, ws %zu); nothing launched\n", n_in, n_in > 0 ? in_sizes[0] : -1, out_size, ws_size); grid = -1; return; }
        int dev = 0, cus = 0, per_cu = 0;
        if (hipGetDevice(&dev) != hipSuccess || hipDeviceGetAttribute(&cus, hipDeviceAttributeMultiprocessorCount, dev) != hipSuccess) { grid = -1; return; }
        if (hipFuncSetAttribute((const void*)mk_fwd, hipFuncAttributeMaxDynamicSharedMemorySize, LDS_BYTES) != hipSuccess) { fprintf(stderr, "kernel_launch: hipFuncSetAttribute failed\n"); grid = -1; return; }
        if (hipOccupancyMaxActiveBlocksPerMultiprocessor(&per_cu, (const void*)mk_fwd, NWAVES * 64, LDS_BYTES) != hipSuccess || per_cu < 1) { fprintf(stderr, "kernel_launch: occupancy query says %d\n", per_cu); per_cu = 1; }
        (void)hipGetLastError();
        grid = cus;
    }
    if (grid < 0) return;
    Args a{};
    for (int i = 0; i < 19; ++i) a.in[i] = (const float*)d_in[i];
    a.out = (float*)d_out; a.ws = (unsigned char*)d_ws;
    if (MK_N_LAUNCHES == 1) {
        a.ph_lo = 0; a.ph_hi = N_PHASES;
        void* params[] = {&a};
        hipError_t e = hipLaunchCooperativeKernel((const void*)mk_fwd, dim3(grid), dim3(NWAVES * 64), params, LDS_BYTES, stream);
        if (e != hipSuccess) fprintf(stderr, "kernel_launch: cooperative launch failed: %s (grid %d)\n", hipGetErrorString(e), grid);
    } else {
        for (int ph = 0; ph < N_PHASES; ++ph) {
            a.ph_lo = ph; a.ph_hi = ph + 1;
            hipLaunchKernelGGL(mk_fwd, dim3(grid), dim3(NWAVES * 64), LDS_BYTES, stream, a);
        }
    }
}
```

```cpp
#include <hip/hip_runtime.h>
#include <hip/hip_cooperative_groups.h>
#include <cstdio>
#include <cstdint>
namespace cg = cooperative_groups;
namespace pg8 {
#define PG8_LAS __attribute__((address_space(3)))
typedef unsigned short bf16_t;
typedef short bf16x8 __attribute__((ext_vector_type(8)));
typedef float f32x4 __attribute__((ext_vector_type(4)));
typedef unsigned u32x4 __attribute__((ext_vector_type(4)));
constexpr int BM = 256, BK = 64, HALF = 128, HTB = HALF * BK * 2  , STAGE_BYTES = 8 * HTB, NXCD = 8, WGM = 8;

__host__ __device__ __forceinline__ int lds_byte(int r, int c) { const int st = (r >> 4) * 2 + (c >> 5), rr = r & 15, cc = c & 31, ob = rr * 64 + cc * 2; return st * 1024 + (ob ^ (((ob >> 9) & 1) << 5)); }
__host__ __device__ __forceinline__ void stage_rc(int b, int& R, int& C) { const int st = b / 1024, sb = b % 1024, swz = sb ^ (((sb >> 9) & 1) << 5); R = (st >> 1) * 16 + swz / 64; C = (st & 1) * 32 + (swz % 64) / 2; }
__host__ __device__ __forceinline__ int perm32(int rho) { const int n = rho >> 4, i = rho & 15; return 8 * (i >> 2) + 4 * n + (i & 3); }

struct Unit { int pm, pn; };
struct Gemm { const bf16_t* A; const bf16_t* Bt; int M, N, K; };

struct StaticOrder {
    int nM, nN, nwg, G, c;
    __host__ __device__ void init(int M, int N, int G_, int c_) { nM = M / BM; nN = N / BM; nwg = nM * nN; G = G_; c = c_; }
    __host__ __device__ bool next(int i, Unit& u) const {
        const long L = (long)i * G + c; if (L >= nwg) return false;
        int wgid = (int)L; { const int q = nwg / NXCD, r = nwg % NXCD, xcd = wgid % NXCD, off = wgid / NXCD; wgid = (xcd < r ? xcd * (q + 1) : r * (q + 1) + (xcd - r) * q) + off; }
        const int nig = WGM * nN, gid = wgid / nig, fm = gid * WGM, gsz = (nM - fm) < WGM ? (nM - fm) : WGM;
        u.pm = fm + ((wgid % nig) % gsz); u.pn = (wgid % nig) / gsz; return true;
    }
    __device__ __forceinline__ void a_ready(const Unit&) const {}
    __device__ __forceinline__ void done(const Unit&) const {}
};

__device__ __forceinline__ unsigned cvt_pk_bf16(float lo, float hi) { unsigned r; asm volatile("v_cvt_pk_bf16_f32 %0, %1, %2" : "=v"(r) : "v"(lo), "v"(hi)); return r; }
typedef unsigned u32x2 __attribute__((ext_vector_type(2)));
__device__ __forceinline__ int lane_id_asm() { int l; asm volatile("v_mbcnt_lo_u32_b32 %0, -1, 0\n\tv_mbcnt_hi_u32_b32 %0, -1, %0" : "=v"(l)); return l; }
__device__ __forceinline__ float gelu_tanh(float x) {
    const float u = 0.7978845608028654f * (x + 0.044715f * x * x * x);
    const float e = __builtin_amdgcn_exp2f(-2.885390081777927f * u);
    return x * __builtin_amdgcn_rcpf(1.0f + e);
}
__device__ __forceinline__ float sigmoid_f(float x) { return __builtin_amdgcn_rcpf(1.0f + __builtin_amdgcn_exp2f(-1.4426950408889634f * x)); }

template <int MODE> struct EpiBf16M {
    static constexpr bool PERM = true, AFTER_DRAIN = false;
    bf16_t* O; int ldc;
    __device__ __forceinline__ void operator()(const f32x4 (&acc)[2][2][4][2], const Unit& u, int wr, int wc, int fr, int fq) const {
        const int row0 = u.pm * BM + wr * 64 + fr, col0 = u.pn * BM + wc * 32 + 8 * fq;
        const int mode = (MODE == 1) ? (u.pn < 2 ? 1 : (u.pn >= 6 ? 2 : 0)) : 0;
#pragma unroll
        for (int ai = 0; ai < 2; ++ai)
#pragma unroll
            for (int m = 0; m < 4; ++m) { bf16_t* rowp = O + (size_t)(row0 + ai * HALF + m * 16) * ldc + col0;
#pragma unroll
                for (int bj = 0; bj < 2; ++bj) { f32x4 v0 = acc[ai][bj][m][0], v1 = acc[ai][bj][m][1];
                    if (mode == 1) { v0 = v0 * 0.125f; v1 = v1 * 0.125f; }
                    else if (mode == 2) {
#pragma unroll
                        for (int e = 0; e < 4; ++e) { v0[e] = gelu_tanh(v0[e]); v1[e] = gelu_tanh(v1[e]); } }
                    u32x4 w; w.x = cvt_pk_bf16(v0[0], v0[1]); w.y = cvt_pk_bf16(v0[2], v0[3]); w.z = cvt_pk_bf16(v1[0], v1[1]); w.w = cvt_pk_bf16(v1[2], v1[3]);
                    *(u32x4*)(rowp + bj * HALF) = w; } }
    }
};
struct EpiSwiglu {
    static constexpr bool PERM = true, AFTER_DRAIN = false;
    bf16_t* O; int ldc;
    __device__ __forceinline__ void operator()(const f32x4 (&acc)[2][2][4][2], const Unit& u, int wr, int wc, int fr, int fq) const {
        const int row0 = u.pm * BM + wr * 64 + fr, col0 = u.pn * HALF + wc * 32 + 8 * fq;
#pragma unroll
        for (int ai = 0; ai < 2; ++ai)
#pragma unroll
            for (int m = 0; m < 4; ++m) { bf16_t* rowp = O + (size_t)(row0 + ai * HALF + m * 16) * ldc + col0;
                f32x4 r0, r1;
#pragma unroll
                for (int e = 0; e < 4; ++e) { const float g0 = acc[ai][0][m][0][e], g1 = acc[ai][0][m][1][e];
                    r0[e] = g0 * sigmoid_f(g0) * acc[ai][1][m][0][e]; r1[e] = g1 * sigmoid_f(g1) * acc[ai][1][m][1][e]; }
                u32x4 w; w.x = cvt_pk_bf16(r0[0], r0[1]); w.y = cvt_pk_bf16(r0[2], r0[3]); w.z = cvt_pk_bf16(r1[0], r1[1]); w.w = cvt_pk_bf16(r1[2], r1[3]);
                *(u32x4*)rowp = w; }
    }
};
struct EpiF32 {
    static constexpr bool PERM = false, AFTER_DRAIN = false;
    float* O; int ldc;
    __device__ __forceinline__ void operator()(const f32x4 (&acc)[2][2][4][2], const Unit& u, int wr, int wc, int fr, int fq) const {
        const int row0 = u.pm * BM + wr * 64 + fr, col0 = u.pn * BM + wc * 32 + 4 * fq;
#pragma unroll
        for (int ai = 0; ai < 2; ++ai)
#pragma unroll
            for (int m = 0; m < 4; ++m) { float* rowp = O + (size_t)(row0 + ai * HALF + m * 16) * ldc + col0;
#pragma unroll
                for (int bj = 0; bj < 2; ++bj)
#pragma unroll
                    for (int n = 0; n < 2; ++n) *(f32x4*)(rowp + bj * HALF + n * 16) = acc[ai][bj][m][n]; }
    }
};
struct EpiFinal {
    static constexpr bool PERM = false, AFTER_DRAIN = false;
    const float* H2; const bf16_t* PE; const float* bias; float* O; int ldc;
    __device__ __forceinline__ void operator()(const f32x4 (&acc)[2][2][4][2], const Unit& u, int wr, int wc, int fr, int fq) const {
        const int row0 = u.pm * BM + wr * 64 + fr, col0 = u.pn * BM + wc * 32 + 4 * fq;
        f32x4 bv[2][2];
#pragma unroll
        for (int bj = 0; bj < 2; ++bj)
#pragma unroll
            for (int n = 0; n < 2; ++n) bv[bj][n] = *(const f32x4*)(bias + col0 + bj * HALF + n * 16);
#pragma unroll
        for (int ai = 0; ai < 2; ++ai)
#pragma unroll
            for (int m = 0; m < 4; ++m) { const size_t off = (size_t)(row0 + ai * HALF + m * 16) * ldc + col0;
#pragma unroll
                for (int bj = 0; bj < 2; ++bj)
#pragma unroll
                    for (int n = 0; n < 2; ++n) { const size_t o2 = off + bj * HALF + n * 16;
                        const f32x4 h = *(const f32x4*)(H2 + o2); const u32x2 pw = *(const u32x2*)(PE + o2);
                        f32x4 pe; pe[0] = __uint_as_float(pw.x << 16); pe[1] = __uint_as_float(pw.x & 0xffff0000u); pe[2] = __uint_as_float(pw.y << 16); pe[3] = __uint_as_float(pw.y & 0xffff0000u);
                        const f32x4 a = acc[ai][bj][m][n] + bv[bj][n]; f32x4 o;
#pragma unroll
                        for (int e = 0; e < 4; ++e) o[e] = h[e] + sigmoid_f(a[e]) * pe[e];
                        *(f32x4*)(O + o2) = o; } }
    }
};

template <class Epi, class Sched, bool ALIGN_EPI = false, bool SP2 = false>
__device__ __forceinline__ void gemm_phase(PG8_LAS unsigned char* lds, const Gemm g, const Sched& S, const Epi& E, const int wave_id) {
    const int wid = wave_id, lane = lane_id_asm(), tid = wid * 64 + lane, wr = wid >> 2, wc = wid & 3, fr = lane & 15, fq = lane >> 4;
    const int K = g.K, nt = K / BK;
    unsigned voffA[2], voffB[2];
#pragma unroll
    for (int i = 0; i < 2; ++i) { int R, C; stage_rc(tid * 16 + i * 8192, R, C); const int Rb = Epi::PERM ? ((R & ~31) + perm32(R & 31)) : R;
        voffA[i] = (unsigned)(R * K + C) * 2u; voffB[i] = (unsigned)(Rb * K + C) * 2u; }
    const size_t kstep = (size_t)(BK * 2);
    const size_t hstep = (size_t)HALF * K * 2;
    const size_t tstep = 2 * hstep;
    const unsigned ldsw = (unsigned)wid * 1024u;
    const int aoff = lds_byte(wr * 64 + fr, fq * 8), boff = lds_byte(wc * 32 + fr, fq * 8);
#define PG8_SA(b, h) (((b) * 2 + (h)) * HTB)
#define PG8_SB(b, h) ((4 + (b) * 2 + (h)) * HTB)
#define PG8_STAGE(bufoff, gbase, voff) do { _Pragma("unroll") for (int _i = 0; _i < 2; ++_i) \
        __builtin_amdgcn_global_load_lds((const unsigned*)((const char*)(gbase) + (voff)[_i]), (PG8_LAS unsigned*)(lds + (bufoff) + ldsw + _i * 8192), 16, 0, 0); } while (0)
#define PG8_LDA(dst, b, h) do { _Pragma("unroll") for (int m = 0; m < 4; ++m) _Pragma("unroll") for (int k = 0; k < 2; ++k) dst[m][k] = *(const PG8_LAS bf16x8*)(lds + PG8_SA(b, h) + aoff + m * 2048 + k * 1024); } while (0)
#define PG8_LDB(dst, b, h) do { _Pragma("unroll") for (int n = 0; n < 2; ++n) _Pragma("unroll") for (int k = 0; k < 2; ++k) dst[n][k] = *(const PG8_LAS bf16x8*)(lds + PG8_SB(b, h) + boff + n * 2048 + k * 1024); } while (0)
#define PG8_MMA(ai, bj, At, Bt) do { __builtin_amdgcn_s_setprio(1); _Pragma("unroll") for (int m = 0; m < 4; ++m) _Pragma("unroll") for (int n = 0; n < 2; ++n) _Pragma("unroll") for (int k = 0; k < 2; ++k) \
        acc[ai][bj][m][n] = __builtin_amdgcn_mfma_f32_16x16x32_bf16(Bt[n][k], At[m][k], acc[ai][bj][m][n], 0, 0, 0); __builtin_amdgcn_s_setprio(0); } while (0)
#define PG8_WAIT_V(n) asm volatile("s_waitcnt vmcnt(" #n ")" ::: "memory")
#define PG8_WAIT_L(n) asm volatile("s_waitcnt lgkmcnt(" #n ")" ::: "memory")
#define PG8_BAR __builtin_amdgcn_s_barrier()
#define PG8_SCHED __builtin_amdgcn_sched_barrier(0)
    Unit cur, nxt; int ui = 0;
    if (!S.next(0, cur)) return;
    f32x4 acc[2][2][4][2];
#pragma unroll
    for (int a = 0; a < 2; ++a)
#pragma unroll
        for (int b = 0; b < 2; ++b)
#pragma unroll
            for (int m = 0; m < 4; ++m)
#pragma unroll
                for (int n = 0; n < 2; ++n) acc[a][b][m][n] = (f32x4){0.f, 0.f, 0.f, 0.f};
    bf16x8 At[4][2], B0[2][2], B1[2][2];
    const char* cA = (const char*)g.A + (size_t)cur.pm * tstep; const char* cB = (const char*)g.Bt + (size_t)cur.pn * tstep;
    S.a_ready(cur);
    if constexpr (SP2) {
        PG8_STAGE(PG8_SB(0, 0), cB, voffB); PG8_STAGE(PG8_SB(0, 1), cB + hstep, voffB); PG8_STAGE(PG8_SA(0, 0), cA, voffA); PG8_STAGE(PG8_SA(0, 1), cA + hstep, voffA);
        if (wr == 1) PG8_BAR;
        PG8_WAIT_V(2); PG8_BAR;
        PG8_STAGE(PG8_SB(1, 0), cB + kstep, voffB); PG8_STAGE(PG8_SA(1, 0), cA + kstep, voffA); PG8_STAGE(PG8_SB(1, 1), cB + hstep + kstep, voffB);
        PG8_WAIT_V(6); PG8_BAR;
    } else {
        PG8_STAGE(PG8_SB(0, 0), cB, voffB); PG8_STAGE(PG8_SA(0, 0), cA, voffA); PG8_STAGE(PG8_SB(0, 1), cB + hstep, voffB); PG8_STAGE(PG8_SA(0, 1), cA + hstep, voffA);
        if (wr == 1) PG8_BAR;
        PG8_WAIT_V(4); PG8_BAR;
        PG8_STAGE(PG8_SB(1, 0), cB + kstep, voffB); PG8_STAGE(PG8_SA(1, 0), cA + kstep, voffA); PG8_STAGE(PG8_SB(1, 1), cB + hstep + kstep, voffB);
        PG8_WAIT_V(6); PG8_BAR;
    }
    for (;;) {
        const bool has_next = S.next(ui + 1, nxt);
        const char* nA = has_next ? (const char*)g.A + (size_t)nxt.pm * tstep : cA; const char* nB = has_next ? (const char*)g.Bt + (size_t)nxt.pn * tstep : cB;
        for (int t = 0; t < nt; t += 2) {
            const bool last = (t == nt - 2);
            const char* a1 = cA + (size_t)(t + 1) * kstep;
            const char* a2 = last ? nA : cA + (size_t)(t + 2) * kstep; const char* b2 = last ? nB : cB + (size_t)(t + 2) * kstep;
            const char* a3 = a2 + kstep; const char* b3 = b2 + kstep;
            if (last && has_next) S.a_ready(nxt);
            if constexpr (SP2) {
            PG8_LDB(B0, 0, 0); PG8_LDB(B1, 0, 1); PG8_SCHED; PG8_LDA(At, 0, 0); PG8_STAGE(PG8_SA(1, 1), a1 + hstep, voffA);
            PG8_WAIT_V(8); PG8_WAIT_L(0); PG8_BAR; PG8_MMA(0, 0, At, B0); PG8_MMA(0, 1, At, B1); PG8_BAR; PG8_SCHED;
            PG8_LDA(At, 0, 1); PG8_STAGE(PG8_SB(0, 0), b2, voffB); PG8_STAGE(PG8_SB(0, 1), b2 + hstep, voffB); PG8_STAGE(PG8_SA(0, 0), a2, voffA);
            PG8_WAIT_V(8); PG8_WAIT_L(0); PG8_BAR; PG8_MMA(1, 0, At, B0); PG8_MMA(1, 1, At, B1); PG8_BAR; PG8_SCHED;
            PG8_LDB(B0, 1, 0); PG8_LDB(B1, 1, 1); PG8_SCHED; PG8_LDA(At, 1, 0); PG8_STAGE(PG8_SA(0, 1), a2 + hstep, voffA);
            PG8_WAIT_V(8); PG8_WAIT_L(0); PG8_BAR; PG8_MMA(0, 0, At, B0); PG8_MMA(0, 1, At, B1); PG8_BAR; PG8_SCHED;
            PG8_LDA(At, 1, 1); PG8_STAGE(PG8_SB(1, 0), b3, voffB); PG8_STAGE(PG8_SB(1, 1), b3 + hstep, voffB); PG8_STAGE(PG8_SA(1, 0), a3, voffA);
            PG8_WAIT_V(8); PG8_WAIT_L(0); PG8_BAR; PG8_MMA(1, 0, At, B0); PG8_MMA(1, 1, At, B1); PG8_BAR; PG8_SCHED;
            } else {
            PG8_LDB(B0, 0, 0); PG8_SCHED; PG8_LDA(At, 0, 0); PG8_STAGE(PG8_SA(1, 1), a1 + hstep, voffA);
            PG8_WAIT_L(8); PG8_BAR; PG8_WAIT_L(0); PG8_MMA(0, 0, At, B0); PG8_BAR; PG8_SCHED;
            PG8_LDB(B1, 0, 1); PG8_STAGE(PG8_SB(0, 0), b2, voffB);
            PG8_BAR; PG8_WAIT_L(0); PG8_MMA(0, 1, At, B1); PG8_BAR;
            PG8_LDA(At, 0, 1); PG8_STAGE(PG8_SA(0, 0), a2, voffA);
            PG8_BAR; PG8_WAIT_L(0); PG8_MMA(1, 0, At, B0); PG8_BAR; PG8_SCHED;
            PG8_STAGE(PG8_SB(0, 1), b2 + hstep, voffB);
            PG8_WAIT_V(6); PG8_BAR; PG8_MMA(1, 1, At, B1); PG8_BAR;
            PG8_LDB(B0, 1, 0); PG8_SCHED; PG8_LDA(At, 1, 0); PG8_STAGE(PG8_SA(0, 1), a2 + hstep, voffA);
            PG8_WAIT_L(8); PG8_BAR; PG8_WAIT_L(0); PG8_MMA(0, 0, At, B0); PG8_BAR; PG8_SCHED;
            PG8_LDB(B1, 1, 1); PG8_STAGE(PG8_SB(1, 0), b3, voffB);
            PG8_BAR; PG8_WAIT_L(0); PG8_MMA(0, 1, At, B1); PG8_BAR;
            PG8_LDA(At, 1, 1); PG8_STAGE(PG8_SA(1, 0), a3, voffA);
            PG8_BAR; PG8_WAIT_L(0); PG8_MMA(1, 0, At, B0); PG8_BAR; PG8_SCHED;
            PG8_STAGE(PG8_SB(1, 1), b3 + hstep, voffB);
            PG8_WAIT_V(6); PG8_BAR; PG8_MMA(1, 1, At, B1); PG8_BAR;
            }
        }
        if constexpr (ALIGN_EPI) { if (wr == 0) PG8_BAR; }
        if constexpr (!Epi::AFTER_DRAIN) { E(acc, cur, wr, wc, fr, fq); S.done(cur); }
        if (!has_next) break;
#pragma unroll
        for (int a = 0; a < 2; ++a)
#pragma unroll
            for (int b = 0; b < 2; ++b)
#pragma unroll
                for (int m = 0; m < 4; ++m)
#pragma unroll
                    for (int n = 0; n < 2; ++n) acc[a][b][m][n] = (f32x4){0.f, 0.f, 0.f, 0.f};
        cur = nxt; cA = nA; cB = nB; ++ui;
        if constexpr (ALIGN_EPI) { if (wr == 1) PG8_BAR; }
    }
    PG8_WAIT_V(0);
    if constexpr (!ALIGN_EPI) { if (wr == 0) PG8_BAR; }
    PG8_BAR;
    if constexpr (Epi::AFTER_DRAIN) { E.fused(acc, cur, wr, wc, fr, fq, lds, wid, lane); S.done(cur); }
#undef PG8_SA
#undef PG8_SB
#undef PG8_STAGE
#undef PG8_LDA
#undef PG8_LDB
#undef PG8_MMA
#undef PG8_WAIT_V
#undef PG8_WAIT_L
#undef PG8_BAR
#undef PG8_SCHED
}
}

constexpr int NWAVES = 8;
constexpr int BATCH = 4, SEQ = 8192, DM = 1024, MTOK = BATCH * SEQ, PLE = 256, AW = 512, SW = 512, HD = 64, NH = 8, NG = 4, GD = 128, CHUNK = 128, DFF = 2816, PC = 2560;
constexpr float EPS = 1e-6f;
#ifndef MK_N_LAUNCHES
#define MK_N_LAUNCHES 1
#endif
constexpr int N_PHASES = 10;

constexpr size_t MiB = 1u << 20;
constexpr size_t WS_W1 = 2 * MiB, WS_W2 = 8 * MiB, WS_W3 = 10 * MiB, WS_W4 = 22 * MiB, WS_W5 = 28 * MiB, WS_W6 = 30 * MiB;
constexpr size_t WS_XN = 32 * MiB;
constexpr size_t WS_PE = 96 * MiB;
constexpr size_t WS_PB = 160 * MiB;
constexpr size_t WS_PROJ = 176 * MiB;
constexpr size_t WS_AO = 336 * MiB;
constexpr size_t WS_LSE = 432 * MiB;
constexpr size_t WS_SG = 436 * MiB;
constexpr size_t WS_GROUPS = 176 * MiB;
constexpr size_t WS_MIXED = 240 * MiB;
constexpr size_t WS_H1 = 368 * MiB;
constexpr size_t WS_ACT = 176 * MiB;
constexpr size_t WS_END = 496 * MiB;
static_assert(WS_ACT + (size_t)MTOK * DFF * 2 <= WS_H1 && WS_MIXED + (size_t)MTOK * DM * 4 <= WS_H1 && WS_H1 + (size_t)MTOK * DM * 4 <= WS_END, "ws map");
static_assert(WS_PROJ + (size_t)MTOK * PC * 2 <= WS_AO && WS_AO + 3 * (size_t)MTOK * AW * 2 <= WS_LSE && WS_SG + (size_t)MTOK * SW * 2 <= WS_END, "ws map 2");

constexpr int RING_BYTES = 131072;
constexpr int LDS_BYTES = 147456;

#define GAS __attribute__((address_space(1)))
#define LAS __attribute__((address_space(3)))
typedef unsigned short bf16;
typedef unsigned v4u __attribute__((ext_vector_type(4)));
typedef unsigned v2u __attribute__((ext_vector_type(2)));
typedef float f32x4 __attribute__((ext_vector_type(4)));
typedef short bf16x8 __attribute__((ext_vector_type(8)));
typedef short v4i16_t __attribute__((ext_vector_type(4)));
typedef float f32x2_t __attribute__((ext_vector_type(2)));
typedef __bf16 bf16x2_t __attribute__((ext_vector_type(2)));
#define LDS_WAIT() asm volatile("s_waitcnt lgkmcnt(0)" ::: "memory")
__device__ __forceinline__ unsigned pk2(float lo, float hi) { f32x2_t v = {lo, hi}; bf16x2_t b = __builtin_convertvector(v, bf16x2_t); return __builtin_bit_cast(unsigned, b); }
__device__ __forceinline__ float bflo(unsigned w) { return __uint_as_float(w << 16); }
__device__ __forceinline__ float bfhi(unsigned w) { return __uint_as_float(w & 0xffff0000u); }
__device__ __forceinline__ float wave_sum(float v) {
#pragma unroll
    for (int o = 1; o < 64; o <<= 1) v += __shfl_xor(v, o);
    return v;
}
__device__ __forceinline__ v4i16_t tr_read(LAS unsigned char* p) { return __builtin_amdgcn_ds_read_tr16_b64_v4i16((LAS v4i16_t*)p); }

struct Args { const float* in[19]; float* out; unsigned char* ws; int ph_lo, ph_hi; };
#define CAS __attribute__((address_space(4)))
__device__ __forceinline__ const float* arg_in(int i) {
    const CAS unsigned char* kp = (const CAS unsigned char*)__builtin_amdgcn_kernarg_segment_ptr();
    asm volatile("" : "+s"(kp));
    typedef const float* cfp_t;
    return *(const CAS cfp_t*)(kp + 8 * i);
}
struct Frame {
    LAS unsigned char* lds;
    int wave, vcu, G;
    float* out; unsigned char* ws;
};

__device__ __forceinline__ void p0_transpose_item(const float* W, int K, int N, bf16* WT, int mode, const float* ks0, const float* ks1, LAS float* scr, int item, int lane) {
    const int nblk = N / 32, kb = item / nblk, nb = item % nblk, k0 = 64 * kb, n0 = 32 * nb;
#pragma unroll 8
    for (int i = 0; i < 32; ++i) { const int kk = 2 * i + (lane >> 5); const int kg = k0 + kk;
        const float sc = ks0 ? (kg < 512 ? ks0[kg] : ks1[kg - 512]) : 1.0f;
        scr[kk * 33 + (lane & 31)] = W[(size_t)kg * N + n0 + (lane & 31)] * sc; }
    LDS_WAIT(); asm volatile("" ::: "memory");
    int d0 = n0;
    if (mode == 1) { d0 = (n0 < DFF) ? ((n0 / 128) * 256 + (n0 % 128)) : (((n0 - DFF) / 128) * 256 + 128 + ((n0 - DFF) % 128)); }
    const int c = lane & 7;
#pragma unroll
    for (int j = 0; j < 4; ++j) { const int n = (lane >> 3) + 8 * j; const LAS float* s = scr + (8 * c) * 33 + n;
        v4u o; o.x = pk2(s[0 * 33], s[1 * 33]); o.y = pk2(s[2 * 33], s[3 * 33]); o.z = pk2(s[4 * 33], s[5 * 33]); o.w = pk2(s[6 * 33], s[7 * 33]);
        *(GAS v4u*)(WT + (size_t)(d0 + n) * K + k0 + 8 * c) = o; }
    LDS_WAIT(); asm volatile("" ::: "memory");
}
__device__ __forceinline__ void p0_prologue(Frame& F, const Args& A) {
    const int lane_ = pg8::lane_id_asm();
    LAS float* scr = (LAS float*)(F.lds + F.wave * 16384);
    const int gw = F.vcu * NWAVES + F.wave, NGW = F.G * NWAVES;
    bf16* W1t = (bf16*)(F.ws + WS_W1); bf16* W2t = (bf16*)(F.ws + WS_W2); bf16* W3t = (bf16*)(F.ws + WS_W3);
    bf16* W4t = (bf16*)(F.ws + WS_W4); bf16* W5t = (bf16*)(F.ws + WS_W5); bf16* W6t = (bf16*)(F.ws + WS_W6);
    constexpr int I1 = (DM / 64) * (PC / 32), I2 = (DM / 64) * (DM / 32), I3 = (DM / 64) * (2 * DFF / 32), I4 = (DFF / 64) * (DM / 32), I5 = I2, I6 = (PLE / 64) * (DM / 32);
    constexpr int NITEMS = I1 + I2 + I3 + I4 + I5 + I6;
    for (int it = gw; it < NITEMS; it += NGW) {
        int r = it;
        if (r < I1) { p0_transpose_item(arg_in(3), DM, PC, W1t, 0, arg_in(2), arg_in(2) + 512, scr, r, lane_); continue; } r -= I1;
        if (r < I2) { p0_transpose_item(arg_in(10), DM, DM, W2t, 0, arg_in(8), arg_in(9), scr, r, lane_); continue; } r -= I2;
        if (r < I3) { p0_transpose_item(arg_in(13), DM, 2 * DFF, W3t, 1, arg_in(12), arg_in(12) + 512, scr, r, lane_); continue; } r -= I3;
        if (r < I4) { p0_transpose_item(arg_in(14), DFF, DM, W4t, 0, nullptr, nullptr, scr, r, lane_); continue; } r -= I4;
        if (r < I5) { p0_transpose_item(arg_in(16), DM, DM, W5t, 0, nullptr, nullptr, scr, r, lane_); continue; } r -= I5;
        p0_transpose_item(arg_in(18), PLE, DM, W6t, 0, nullptr, nullptr, scr, r, lane_);
    }
    bf16* XN = (bf16*)(F.ws + WS_XN); bf16* PB = (bf16*)(F.ws + WS_PB);
    for (int m = gw; m < MTOK; m += NGW) {
        const GAS f32x4* xr = (const GAS f32x4*)(arg_in(0) + (size_t)m * DM) + lane_;
        f32x4 v[4]; float s = 0.f;
#pragma unroll
        for (int j = 0; j < 4; ++j) { v[j] = xr[64 * j]; s += (v[j].x * v[j].x + v[j].y * v[j].y) + (v[j].z * v[j].z + v[j].w * v[j].w); }
        const f32x4 pv = *((const GAS f32x4*)(arg_in(1) + (size_t)m * PLE) + lane_);
        const float rinv = 1.0f / sqrtf(wave_sum(s) * (1.0f / DM) + EPS);
        GAS v2u* o8 = (GAS v2u*)(XN + (size_t)m * DM) + lane_;
#pragma unroll
        for (int j = 0; j < 4; ++j) { v2u o; o.x = pk2(v[j].x * rinv, v[j].y * rinv); o.y = pk2(v[j].z * rinv, v[j].w * rinv); o8[64 * j] = o; }
        v2u po; po.x = pk2(pv.x, pv.y); po.y = pk2(pv.z, pv.w);
        *((GAS v2u*)(PB + (size_t)m * PLE) + lane_) = po;
    }
}

constexpr int KP = 144;
constexpr int ATT_LDS_K = 0, ATT_LDS_V = 256 * KP;
constexpr int ATT_ITEMS = 3 * BATCH * NH * 64;
struct AttItem { int br, b, h, d, tok_cur, tok_prev; bool first; };
__device__ __forceinline__ AttItem att_decode(int id) {
    AttItem I; I.br = id / 2048; int rem = id % 2048; I.b = rem / 512; rem %= 512; I.h = rem / 64; const int s = rem % 64;
    I.d = 1 << (2 * I.br); const int nb = 64 >> (2 * I.br); const int r = s / nb, n = s % nb;
    I.first = (n == 0);
    I.tok_cur = I.b * SEQ + r + I.d * (128 * n); I.tok_prev = I.first ? I.tok_cur : I.tok_cur - I.d * 128;
    return I;
}
__device__ __forceinline__ void att_load(const AttItem& I, const bf16* PROJ, int tid, v4u (&kr)[4], v4u (&vr)[4]) {
#pragma unroll
    for (int i = 0; i < 4; ++i) { const int c = tid + 512 * i, row = c >> 3, ch = c & 7;
        const int tok = (row < 128) ? (I.tok_prev + I.d * row) : (I.tok_cur + I.d * (row - 128));
        const bf16* src = PROJ + (size_t)tok * PC + AW + I.h * HD + ch * 8;
        kr[i] = *(const GAS v4u*)src; vr[i] = *(const GAS v4u*)(src + AW); }
}
__device__ __forceinline__ void att_phase(Frame& F, const Args& A, int first_item, int n_items) {
    const bf16* PROJ = (const bf16*)(F.ws + WS_PROJ);
    bf16* AO = (bf16*)(F.ws + WS_AO); float* LSE = (float*)(F.ws + WS_LSE);
    LAS unsigned char* lds = F.lds;
    const int lane = pg8::lane_id_asm(), w = F.wave, tid = w * 64 + lane, l15 = lane & 15, fq = lane >> 4;
    v4u kr[4], vr[4];
    AttItem I = att_decode(first_item);
    att_load(I, PROJ, tid, kr, vr);
    for (int it = 0; it < n_items; ++it) {
#pragma unroll
        for (int i = 0; i < 4; ++i) { const int c = tid + 512 * i, row = c >> 3, ch = c & 7;
            *(LAS v4u*)(lds + ATT_LDS_K + row * KP + ch * 16) = kr[i]; *(LAS v4u*)(lds + ATT_LDS_V + row * KP + ch * 16) = vr[i]; }
        const AttItem C = I;
        __syncthreads();
        if (it + 1 < n_items) { I = att_decode(first_item + it + 1); att_load(I, PROJ, tid, kr, vr); }
        const int qtok = C.tok_cur + C.d * (16 * w + l15);
        const bf16* qp = PROJ + (size_t)qtok * PC + C.h * HD + 8 * fq;
        const bf16x8 q0 = *(const GAS bf16x8*)qp, q1 = *(const GAS bf16x8*)(qp + 32);
        f32x4 s[9];
#pragma unroll
        for (int kk = 0; kk < 9; ++kk) {
            LAS unsigned char* kp = lds + ATT_LDS_K + (16 * (w + kk) + l15) * KP + 16 * fq;
            const bf16x8 a0 = *(const LAS bf16x8*)kp, a1 = *(const LAS bf16x8*)(kp + 64);
            f32x4 z = {0.f, 0.f, 0.f, 0.f};
            z = __builtin_amdgcn_mfma_f32_16x16x32_bf16(a0, q0, z, 0, 0, 0);
            s[kk] = __builtin_amdgcn_mfma_f32_16x16x32_bf16(a1, q1, z, 0, 0, 0);
        }
        const float LOG2E = 1.4426950408889634f;
        const float c2 = LOG2E * (float)C.d * __builtin_amdgcn_exp2f(-(float)(C.h + 1));
        float mx = -3.0e38f;
#pragma unroll
        for (int kk = 0; kk < 9; ++kk)
#pragma unroll
            for (int j = 0; j < 4; ++j) { const int steps = 128 - 16 * kk + l15 - 4 * fq - j;
                const bool valid = (steps >= 0) && (steps <= 128) && (!C.first || (16 * (w + kk) + 4 * fq + j >= 128));
                const float v = valid ? (s[kk][j] * LOG2E - c2 * (float)steps) : -3.0e38f;
                s[kk][j] = v; mx = fmaxf(mx, v); }
        mx = fmaxf(mx, __shfl_xor(mx, 16)); mx = fmaxf(mx, __shfl_xor(mx, 32));
        float sum = 0.f;
#pragma unroll
        for (int kk = 0; kk < 9; ++kk)
#pragma unroll
            for (int j = 0; j < 4; ++j) { const float p = __builtin_amdgcn_exp2f(s[kk][j] - mx); s[kk][j] = p; sum += p; }
        sum += __shfl_xor(sum, 16); sum += __shfl_xor(sum, 32);
        f32x4 o[4];
#pragma unroll
        for (int d0 = 0; d0 < 4; ++d0) o[d0] = (f32x4){0.f, 0.f, 0.f, 0.f};
#pragma unroll
        for (int pp = 0; pp < 5; ++pp) {
            const int kA = 2 * pp, kB = (pp < 4) ? 2 * pp + 1 : 2 * pp;
            v4u pw; pw.x = pk2(s[kA][0], s[kA][1]); pw.y = pk2(s[kA][2], s[kA][3]);
            if (pp < 4) { pw.z = pk2(s[kB][0], s[kB][1]); pw.w = pk2(s[kB][2], s[kB][3]); } else { pw.z = 0u; pw.w = 0u; }
            const bf16x8 pf = __builtin_bit_cast(bf16x8, pw);
            LAS unsigned char* va = lds + ATT_LDS_V + (16 * (w + kA) + 4 * fq + (l15 >> 2)) * KP + 8 * (l15 & 3);
            LAS unsigned char* vb = lds + ATT_LDS_V + (16 * (w + kB) + 4 * fq + (l15 >> 2)) * KP + 8 * (l15 & 3);
#pragma unroll
            for (int d0 = 0; d0 < 4; ++d0) {
                const v4i16_t lo = tr_read(va + 32 * d0), hi = tr_read(vb + 32 * d0);
                const bf16x8 vf = {lo[0], lo[1], lo[2], lo[3], hi[0], hi[1], hi[2], hi[3]};
                o[d0] = __builtin_amdgcn_mfma_f32_16x16x32_bf16(vf, pf, o[d0], 0, 0, 0);
            }
        }
        const float inv = 1.0f / sum;
        bf16* op = AO + (size_t)C.br * MTOK * AW + (size_t)qtok * AW + C.h * HD + 4 * fq;
#pragma unroll
        for (int d0 = 0; d0 < 4; ++d0) { v2u ow; ow.x = pk2(o[d0][0] * inv, o[d0][1] * inv); ow.y = pk2(o[d0][2] * inv, o[d0][3] * inv); *(GAS v2u*)(op + 16 * d0) = ow; }
        if (fq == 0) LSE[(size_t)C.br * MTOK * NH + (size_t)qtok * NH + C.h] = mx + __builtin_amdgcn_logf(sum);
        __syncthreads();
    }
}

constexpr int ZP = 272;
constexpr int SGU_ITEMS = BATCH * (SEQ / CHUNK) * NG;
__device__ __forceinline__ void sgu_phase(Frame& F, const Args& A, int first_item, int n_items) {
    const bf16* PROJ = (const bf16*)(F.ws + WS_PROJ); bf16* SG = (bf16*)(F.ws + WS_SG);
    const float* lng = arg_in(4); const float* lnb = arg_in(5); const float* wsp = arg_in(6); const float* bsp = arg_in(7);
    LAS unsigned char* lds = F.lds;
    const int lane = pg8::lane_id_asm(), w = F.wave, tid = w * 64 + lane, l15 = lane & 15, fq = lane >> 4;
    for (int it = 0; it < n_items; ++it) {
        const int id = first_item + it, b = id / 256, n = (id % 256) / 4, g = id % 4;
        const int t0 = b * SEQ + n * CHUNK;
        const int c8 = tid & 15;
        f32x4 g0 = *(const GAS f32x4*)(lng + c8 * 8), g1 = *(const GAS f32x4*)(lng + c8 * 8 + 4), b0 = *(const GAS f32x4*)(lnb + c8 * 8), b1 = *(const GAS f32x4*)(lnb + c8 * 8 + 4);
#pragma unroll
        for (int i = 0; i < 4; ++i) { const int j = 32 * i + (tid >> 4);
            const v4u zw = *(const GAS v4u*)(PROJ + (size_t)(t0 + j) * PC + 2048 + g * GD + c8 * 8);
            float x[8] = {bflo(zw.x), bfhi(zw.x), bflo(zw.y), bfhi(zw.y), bflo(zw.z), bfhi(zw.z), bflo(zw.w), bfhi(zw.w)};
            float s = ((x[0] + x[1]) + (x[2] + x[3])) + ((x[4] + x[5]) + (x[6] + x[7]));
            s += __shfl_xor(s, 1); s += __shfl_xor(s, 2); s += __shfl_xor(s, 4); s += __shfl_xor(s, 8);
            const float mean = s * (1.0f / GD); float q = 0.f;
#pragma unroll
            for (int e = 0; e < 8; ++e) { x[e] -= mean; q += x[e] * x[e]; }
            q += __shfl_xor(q, 1); q += __shfl_xor(q, 2); q += __shfl_xor(q, 4); q += __shfl_xor(q, 8);
            const float rstd = 1.0f / sqrtf(q * (1.0f / GD) + EPS);
            v4u o; o.x = pk2(x[0] * rstd * g0.x + b0.x, x[1] * rstd * g0.y + b0.y); o.y = pk2(x[2] * rstd * g0.z + b0.z, x[3] * rstd * g0.w + b0.w);
            o.z = pk2(x[4] * rstd * g1.x + b1.x, x[5] * rstd * g1.y + b1.y); o.w = pk2(x[6] * rstd * g1.z + b1.z, x[7] * rstd * g1.w + b1.w);
            *(LAS v4u*)(lds + j * ZP + c8 * 16) = o; }
        __syncthreads();
        const int i_loc = 16 * w + l15;
        const float* wrow = wsp + ((size_t)g * CHUNK + i_loc) * CHUNK;
        f32x4 acc[8];
#pragma unroll
        for (int cb = 0; cb < 8; ++cb) acc[cb] = (f32x4){0.f, 0.f, 0.f, 0.f};
        const int nks = (w >> 1) + 1;
        for (int ks = 0; ks < nks; ++ks) {
            const int j0 = 32 * ks + 8 * fq;
            const f32x4 wa = *(const GAS f32x4*)(wrow + j0), wb = *(const GAS f32x4*)(wrow + j0 + 4);
            v4u ww; ww.x = pk2(j0 + 0 <= i_loc ? wa.x : 0.f, j0 + 1 <= i_loc ? wa.y : 0.f); ww.y = pk2(j0 + 2 <= i_loc ? wa.z : 0.f, j0 + 3 <= i_loc ? wa.w : 0.f);
            ww.z = pk2(j0 + 4 <= i_loc ? wb.x : 0.f, j0 + 5 <= i_loc ? wb.y : 0.f); ww.w = pk2(j0 + 6 <= i_loc ? wb.z : 0.f, j0 + 7 <= i_loc ? wb.w : 0.f);
            const bf16x8 wf = __builtin_bit_cast(bf16x8, ww);
            LAS unsigned char* zp = lds + (32 * ks + 8 * fq + (l15 >> 2)) * ZP + 8 * (l15 & 3);
#pragma unroll
            for (int cb = 0; cb < 8; ++cb) {
                const v4i16_t lo = tr_read(zp + 32 * cb), hi = tr_read(zp + 4 * ZP + 32 * cb);
                const bf16x8 zf = {lo[0], lo[1], lo[2], lo[3], hi[0], hi[1], hi[2], hi[3]};
                acc[cb] = __builtin_amdgcn_mfma_f32_16x16x32_bf16(zf, wf, acc[cb], 0, 0, 0);
            }
        }
        const float bs = bsp[g * CHUNK + i_loc];
        const bf16* up = PROJ + (size_t)(t0 + i_loc) * PC + 1536 + g * GD + 4 * fq;
        bf16* op = SG + (size_t)(t0 + i_loc) * SW + g * GD + 4 * fq;
#pragma unroll
        for (int cb = 0; cb < 8; ++cb) { const v2u uw = *(const GAS v2u*)(up + 16 * cb);
            v2u ow; ow.x = pk2(bflo(uw.x) * (acc[cb][0] + bs), bfhi(uw.x) * (acc[cb][1] + bs)); ow.y = pk2(bflo(uw.y) * (acc[cb][2] + bs), bfhi(uw.y) * (acc[cb][3] + bs));
            *(GAS v2u*)(op + 16 * cb) = ow; }
        __syncthreads();
    }
}

__device__ __forceinline__ void merge_phase(Frame& F, const Args& A) {
    const bf16* AO = (const bf16*)(F.ws + WS_AO); const float* LSE = (const float*)(F.ws + WS_LSE); const bf16* SG = (const bf16*)(F.ws + WS_SG);
    bf16* GR = (bf16*)(F.ws + WS_GROUPS);
    const int gw = F.vcu * NWAVES + F.wave, NGW = F.G * NWAVES, lane = pg8::lane_id_asm(), h = lane >> 3;
    for (int m = gw; m < MTOK; m += NGW) {
        float l0 = LSE[(size_t)m * NH + h], l1 = LSE[(size_t)MTOK * NH + (size_t)m * NH + h], l2 = LSE[(size_t)2 * MTOK * NH + (size_t)m * NH + h];
        const v4u a0 = *((const GAS v4u*)(AO + (size_t)m * AW) + lane), a1 = *((const GAS v4u*)(AO + (size_t)MTOK * AW + (size_t)m * AW) + lane), a2 = *((const GAS v4u*)(AO + (size_t)2 * MTOK * AW + (size_t)m * AW) + lane);
        const v4u sg = *((const GAS v4u*)(SG + (size_t)m * SW) + lane);
        const float lm = fmaxf(l0, fmaxf(l1, l2));
        float w0 = __builtin_amdgcn_exp2f(l0 - lm), w1 = __builtin_amdgcn_exp2f(l1 - lm), w2 = __builtin_amdgcn_exp2f(l2 - lm);
        const float wi = 1.0f / (w0 + w1 + w2); w0 *= wi; w1 *= wi; w2 *= wi;
        float o[8], sv[8];
        o[0] = w0 * bflo(a0.x) + w1 * bflo(a1.x) + w2 * bflo(a2.x); o[1] = w0 * bfhi(a0.x) + w1 * bfhi(a1.x) + w2 * bfhi(a2.x);
        o[2] = w0 * bflo(a0.y) + w1 * bflo(a1.y) + w2 * bflo(a2.y); o[3] = w0 * bfhi(a0.y) + w1 * bfhi(a1.y) + w2 * bfhi(a2.y);
        o[4] = w0 * bflo(a0.z) + w1 * bflo(a1.z) + w2 * bflo(a2.z); o[5] = w0 * bfhi(a0.z) + w1 * bfhi(a1.z) + w2 * bfhi(a2.z);
        o[6] = w0 * bflo(a0.w) + w1 * bflo(a1.w) + w2 * bflo(a2.w); o[7] = w0 * bfhi(a0.w) + w1 * bfhi(a1.w) + w2 * bfhi(a2.w);
        sv[0] = bflo(sg.x); sv[1] = bfhi(sg.x); sv[2] = bflo(sg.y); sv[3] = bfhi(sg.y); sv[4] = bflo(sg.z); sv[5] = bfhi(sg.z); sv[6] = bflo(sg.w); sv[7] = bfhi(sg.w);
        float sa = 0.f, ss = 0.f;
#pragma unroll
        for (int e = 0; e < 8; ++e) { sa += o[e] * o[e]; ss += sv[e] * sv[e]; }
        const float ra = 1.0f / sqrtf(wave_sum(sa) * (1.0f / AW) + EPS), rs = 1.0f / sqrtf(wave_sum(ss) * (1.0f / SW) + EPS);
        v4u oa, os;
        oa.x = pk2(o[0] * ra, o[1] * ra); oa.y = pk2(o[2] * ra, o[3] * ra); oa.z = pk2(o[4] * ra, o[5] * ra); oa.w = pk2(o[6] * ra, o[7] * ra);
        os.x = pk2(sv[0] * rs, sv[1] * rs); os.y = pk2(sv[2] * rs, sv[3] * rs); os.z = pk2(sv[4] * rs, sv[5] * rs); os.w = pk2(sv[6] * rs, sv[7] * rs);
        *((GAS v4u*)(GR + (size_t)m * DM) + lane) = oa; *((GAS v4u*)(GR + (size_t)m * DM + AW) + lane) = os;
    }
}

__device__ __forceinline__ void rowpass_mix(Frame& F, const Args& A) {
    const float* MIX = (const float*)(F.ws + WS_MIXED); float* H1 = (float*)(F.ws + WS_H1); bf16* FB = (bf16*)(F.ws + WS_XN);
    const float* gpost = arg_in(11);
    const int gw = F.vcu * NWAVES + F.wave, NGW = F.G * NWAVES, lane = pg8::lane_id_asm();
    f32x4 gv[4];
#pragma unroll
    for (int j = 0; j < 4; ++j) gv[j] = *((const GAS f32x4*)gpost + lane + 64 * j);
    for (int m = gw; m < MTOK; m += NGW) {
        const GAS f32x4* mr = (const GAS f32x4*)(MIX + (size_t)m * DM) + lane; const GAS f32x4* xr = (const GAS f32x4*)(arg_in(0) + (size_t)m * DM) + lane;
        f32x4 v[4], xv[4]; float s = 0.f;
#pragma unroll
        for (int j = 0; j < 4; ++j) { v[j] = mr[64 * j]; xv[j] = xr[64 * j]; s += (v[j].x * v[j].x + v[j].y * v[j].y) + (v[j].z * v[j].z + v[j].w * v[j].w); }
        const float r1 = 1.0f / sqrtf(wave_sum(s) * (1.0f / DM) + EPS); float s2 = 0.f;
        GAS f32x4* hr = (GAS f32x4*)(H1 + (size_t)m * DM) + lane;
#pragma unroll
        for (int j = 0; j < 4; ++j) { v[j] = xv[j] + v[j] * r1 * gv[j]; hr[64 * j] = v[j]; s2 += (v[j].x * v[j].x + v[j].y * v[j].y) + (v[j].z * v[j].z + v[j].w * v[j].w); }
        const float r2 = 1.0f / sqrtf(wave_sum(s2) * (1.0f / DM) + EPS);
        GAS v2u* o8 = (GAS v2u*)(FB + (size_t)m * DM) + lane;
#pragma unroll
        for (int j = 0; j < 4; ++j) { v2u o; o.x = pk2(v[j].x * r2, v[j].y * r2); o.y = pk2(v[j].z * r2, v[j].w * r2); o8[64 * j] = o; }
    }
}
__device__ __forceinline__ void rowpass_ffn(Frame& F, const Args& A) {
    const float* Y = F.out; float* H1 = (float*)(F.ws + WS_H1); bf16* HB = (bf16*)(F.ws + WS_XN);
    const float* gpost = arg_in(15);
    const int gw = F.vcu * NWAVES + F.wave, NGW = F.G * NWAVES, lane = pg8::lane_id_asm();
    f32x4 gv[4];
#pragma unroll
    for (int j = 0; j < 4; ++j) gv[j] = *((const GAS f32x4*)gpost + lane + 64 * j);
    for (int m = gw; m < MTOK; m += NGW) {
        const GAS f32x4* yr = (const GAS f32x4*)(Y + (size_t)m * DM) + lane; GAS f32x4* hr = (GAS f32x4*)(H1 + (size_t)m * DM) + lane;
        f32x4 v[4], hv[4]; float s = 0.f;
#pragma unroll
        for (int j = 0; j < 4; ++j) { v[j] = yr[64 * j]; hv[j] = hr[64 * j]; s += (v[j].x * v[j].x + v[j].y * v[j].y) + (v[j].z * v[j].z + v[j].w * v[j].w); }
        const float r1 = 1.0f / sqrtf(wave_sum(s) * (1.0f / DM) + EPS);
        GAS v2u* o8 = (GAS v2u*)(HB + (size_t)m * DM) + lane;
#pragma unroll
        for (int j = 0; j < 4; ++j) { v[j] = hv[j] + v[j] * r1 * gv[j]; hr[64 * j] = v[j]; v2u o; o.x = pk2(v[j].x, v[j].y); o.y = pk2(v[j].z, v[j].w); o8[64 * j] = o; }
    }
}

__device__ __forceinline__ void grid_bar(unsigned* ctr, unsigned target, int wave) {
    asm volatile("s_waitcnt vmcnt(0)" ::: "memory");
    __syncthreads();
    if (wave == 0) {
        if (pg8::lane_id_asm() == 0) {
            __builtin_amdgcn_fence(__ATOMIC_RELEASE, "agent");
            asm volatile("s_waitcnt vmcnt(0)" ::: "memory");
            __hip_atomic_fetch_add(ctr, 1u, __ATOMIC_RELAXED, __HIP_MEMORY_SCOPE_AGENT);
            while (__hip_atomic_load(ctr, __ATOMIC_RELAXED, __HIP_MEMORY_SCOPE_AGENT) < target) __builtin_amdgcn_s_sleep(2);
            __builtin_amdgcn_fence(__ATOMIC_ACQUIRE, "agent");
            asm volatile("s_waitcnt vmcnt(0)" ::: "memory");
        }
    }
    __syncthreads();
}

__global__ void __launch_bounds__(NWAVES * 64, 2) mk_fwd(Args args) {
    extern __shared__ __attribute__((aligned(16))) unsigned char lds_raw[];
    cg::grid_group grid = cg::this_grid();
    Frame F;
    F.lds = (LAS unsigned char*)lds_raw;
    F.wave = __builtin_amdgcn_readfirstlane(threadIdx.x >> 6);
    F.G = gridDim.x; { const int bx = blockIdx.x; F.vcu = (F.G % 8 == 0) ? (bx % 8) * (F.G / 8) + bx / 8 : bx; }
    F.out = args.out; F.ws = args.ws;
    const int lo = args.ph_lo, hi = args.ph_hi;
#define IN(k) (lo <= (k) && (k) < hi)
    unsigned* const bar_ctr = (unsigned*)F.ws;
#define SEAM(k) do { if (IN(k) && IN((k) + 1)) { if ((k) == 0) grid.sync(); else grid_bar(bar_ctr, (unsigned)F.G * (unsigned)(k), F.wave); } } while (0)
    const pg8::bf16_t* XN = (const pg8::bf16_t*)(F.ws + WS_XN);

    if (IN(0)) { if (blockIdx.x == 0 && threadIdx.x == 0) __hip_atomic_store(bar_ctr, 0u, __ATOMIC_RELAXED, __HIP_MEMORY_SCOPE_AGENT); p0_prologue(F, args); }
    SEAM(0);
    if (IN(1)) {
        { pg8::Gemm g{XN, (const pg8::bf16_t*)(F.ws + WS_W1), MTOK, PC, DM}; pg8::StaticOrder S; S.init(MTOK, PC, F.G, (int)blockIdx.x);
          pg8::EpiBf16M<1> E{(pg8::bf16_t*)(F.ws + WS_PROJ), PC};
          pg8::gemm_phase<pg8::EpiBf16M<1>, pg8::StaticOrder, true, true>(F.lds, g, S, E, F.wave); }
        { pg8::Gemm g{(const pg8::bf16_t*)(F.ws + WS_PB), (const pg8::bf16_t*)(F.ws + WS_W6), MTOK, DM, PLE}; pg8::StaticOrder S; S.init(MTOK, DM, F.G, (int)blockIdx.x);
          pg8::EpiBf16M<0> E{(pg8::bf16_t*)(F.ws + WS_PE), DM};
          pg8::gemm_phase<pg8::EpiBf16M<0>, pg8::StaticOrder, true, true>(F.lds, g, S, E, F.wave); }
    }
    SEAM(1);
    if (IN(2)) {
        { const int per = (ATT_ITEMS + F.G - 1) / F.G; const int f0 = F.vcu * per; int n = ATT_ITEMS - f0; n = n < 0 ? 0 : (n > per ? per : n); if (n > 0) att_phase(F, args, f0, n); }
        __syncthreads();
        { const int per = (SGU_ITEMS + F.G - 1) / F.G; const int f0 = F.vcu * per; int n = SGU_ITEMS - f0; n = n < 0 ? 0 : (n > per ? per : n); if (n > 0) sgu_phase(F, args, f0, n); }
    }
    SEAM(2);
    if (IN(3)) { merge_phase(F, args); }
    SEAM(3);
    if (IN(4)) {
        pg8::Gemm g{(const pg8::bf16_t*)(F.ws + WS_GROUPS), (const pg8::bf16_t*)(F.ws + WS_W2), MTOK, DM, DM}; pg8::StaticOrder S; S.init(MTOK, DM, F.G, (int)blockIdx.x);
        pg8::EpiF32 E{(float*)(F.ws + WS_MIXED), DM};
        pg8::gemm_phase<pg8::EpiF32, pg8::StaticOrder, true, true>(F.lds, g, S, E, F.wave);
    }
    SEAM(4);
    if (IN(5)) { rowpass_mix(F, args); }
    SEAM(5);
    if (IN(6)) {
        pg8::Gemm g{XN, (const pg8::bf16_t*)(F.ws + WS_W3), MTOK, 2 * DFF, DM}; pg8::StaticOrder S; S.init(MTOK, 2 * DFF, F.G, (int)blockIdx.x);
        pg8::EpiSwiglu E{(pg8::bf16_t*)(F.ws + WS_ACT), DFF};
        pg8::gemm_phase<pg8::EpiSwiglu, pg8::StaticOrder, true, true>(F.lds, g, S, E, F.wave);
    }
    SEAM(6);
    if (IN(7)) {
        pg8::Gemm g{(const pg8::bf16_t*)(F.ws + WS_ACT), (const pg8::bf16_t*)(F.ws + WS_W4), MTOK, DM, DFF}; pg8::StaticOrder S; S.init(MTOK, DM, F.G, (int)blockIdx.x);
        pg8::EpiF32 E{F.out, DM};
        pg8::gemm_phase<pg8::EpiF32, pg8::StaticOrder, true, true>(F.lds, g, S, E, F.wave);
    }
    SEAM(7);
    if (IN(8)) { rowpass_ffn(F, args); }
    SEAM(8);
    if (IN(9)) {
        pg8::Gemm g{XN, (const pg8::bf16_t*)(F.ws + WS_W5), MTOK, DM, DM}; pg8::StaticOrder S; S.init(MTOK, DM, F.G, (int)blockIdx.x);
        pg8::EpiFinal E{(const float*)(F.ws + WS_H1), (const pg8::bf16_t*)(F.ws + WS_PE), arg_in(17), F.out, DM};
        pg8::gemm_phase<pg8::EpiFinal, pg8::StaticOrder, true, true>(F.lds, g, S, E, F.wave);
    }
#undef IN
#undef SEAM
}

extern "C" void kernel_launch(void* const* d_in, const int* in_sizes, int n_in, void* d_out, int out_size, void* d_ws, size_t ws_size, hipStream_t stream) {
    static int grid = 0;
    if (grid == 0) {
        if (n_in != 19 || in_sizes[0] != MTOK * DM || out_size != MTOK * DM || ws_size < WS_END) { fprintf(stderr, "kernel_launch: unexpected shapes (n_in %d, in0 %d, out %d, ws %zu); nothing launched\n", n_in, n_in > 0 ? in_sizes[0] : -1, out_size, ws_size); grid = -1; return; }
        int dev = 0, cus = 0, per_cu = 0;
        if (hipGetDevice(&dev) != hipSuccess || hipDeviceGetAttribute(&cus, hipDeviceAttributeMultiprocessorCount, dev) != hipSuccess) { grid = -1; return; }
        if (hipFuncSetAttribute((const void*)mk_fwd, hipFuncAttributeMaxDynamicSharedMemorySize, LDS_BYTES) != hipSuccess) { fprintf(stderr, "kernel_launch: hipFuncSetAttribute failed\n"); grid = -1; return; }
        if (hipOccupancyMaxActiveBlocksPerMultiprocessor(&per_cu, (const void*)mk_fwd, NWAVES * 64, LDS_BYTES) != hipSuccess || per_cu < 1) { fprintf(stderr, "kernel_launch: occupancy query says %d\n", per_cu); per_cu = 1; }
        (void)hipGetLastError();
        grid = cus;
    }
    if (grid < 0) return;
    Args a{};
    for (int i = 0; i < 19; ++i) a.in[i] = (const float*)d_in[i];
    a.out = (float*)d_out; a.ws = (unsigned char*)d_ws;
    if (MK_N_LAUNCHES == 1) {
        a.ph_lo = 0; a.ph_hi = N_PHASES;
        void* params[] = {&a};
        hipError_t e = hipLaunchCooperativeKernel((const void*)mk_fwd, dim3(grid), dim3(NWAVES * 64), params, LDS_BYTES, stream);
        if (e != hipSuccess) fprintf(stderr, "kernel_launch: cooperative launch failed: %s (grid %d)\n", hipGetErrorString(e), grid);
    } else {
        for (int ph = 0; ph < N_PHASES; ++ph) {
            a.ph_lo = ph; a.ph_hi = ph + 1;
            hipLaunchKernelGGL(mk_fwd, dim3(grid), dim3(NWAVES * 64), LDS_BYTES, stream, a);
        }
    }
}
```

```cpp
#include <hip/hip_runtime.h>
#include <hip/hip_cooperative_groups.h>
#include <cstdio>
#include <cstdint>
namespace cg = cooperative_groups;
namespace pg8 {
#define PG8_LAS __attribute__((address_space(3)))
typedef unsigned short bf16_t;
typedef short bf16x8 __attribute__((ext_vector_type(8)));
typedef float f32x4 __attribute__((ext_vector_type(4)));
typedef unsigned u32x4 __attribute__((ext_vector_type(4)));
constexpr int BM = 256, BK = 64, HALF = 128, HTB = HALF * BK * 2  , STAGE_BYTES = 8 * HTB, NXCD = 8, WGM = 8;

__host__ __device__ __forceinline__ int lds_byte(int r, int c) { const int st = (r >> 4) * 2 + (c >> 5), rr = r & 15, cc = c & 31, ob = rr * 64 + cc * 2; return st * 1024 + (ob ^ (((ob >> 9) & 1) << 5)); }
__host__ __device__ __forceinline__ void stage_rc(int b, int& R, int& C) { const int st = b / 1024, sb = b % 1024, swz = sb ^ (((sb >> 9) & 1) << 5); R = (st >> 1) * 16 + swz / 64; C = (st & 1) * 32 + (swz % 64) / 2; }
__host__ __device__ __forceinline__ int perm32(int rho) { const int n = rho >> 4, i = rho & 15; return 8 * (i >> 2) + 4 * n + (i & 3); }

struct Unit { int pm, pn; };
struct Gemm { const bf16_t* A; const bf16_t* Bt; int M, N, K; };

struct StaticOrder {
    int nM, nN, nwg, G, c;
    __host__ __device__ void init(int M, int N, int G_, int c_) { nM = M / BM; nN = N / BM; nwg = nM * nN; G = G_; c = c_; }
    __host__ __device__ bool next(int i, Unit& u) const {
        const long L = (long)i * G + c; if (L >= nwg) return false;
        int wgid = (int)L; { const int q = nwg / NXCD, r = nwg % NXCD, xcd = wgid % NXCD, off = wgid / NXCD; wgid = (xcd < r ? xcd * (q + 1) : r * (q + 1) + (xcd - r) * q) + off; }
        const int nig = WGM * nN, gid = wgid / nig, fm = gid * WGM, gsz = (nM - fm) < WGM ? (nM - fm) : WGM;
        u.pm = fm + ((wgid % nig) % gsz); u.pn = (wgid % nig) / gsz; return true;
    }
    __device__ __forceinline__ void a_ready(const Unit&) const {}
    __device__ __forceinline__ void done(const Unit&) const {}
};

__device__ __forceinline__ unsigned cvt_pk_bf16(float lo, float hi) { unsigned r; asm volatile("v_cvt_pk_bf16_f32 %0, %1, %2" : "=v"(r) : "v"(lo), "v"(hi)); return r; }
typedef unsigned u32x2 __attribute__((ext_vector_type(2)));
__device__ __forceinline__ int lane_id_asm() { int l; asm volatile("v_mbcnt_lo_u32_b32 %0, -1, 0\n\tv_mbcnt_hi_u32_b32 %0, -1, %0" : "=v"(l)); return l; }
__device__ __forceinline__ float gelu_tanh(float x) {
    const float u = 0.7978845608028654f * (x + 0.044715f * x * x * x);
    const float e = __builtin_amdgcn_exp2f(-2.885390081777927f * u);
    return x * __builtin_amdgcn_rcpf(1.0f + e);
}
__device__ __forceinline__ float sigmoid_f(float x) { return __builtin_amdgcn_rcpf(1.0f + __builtin_amdgcn_exp2f(-1.4426950408889634f * x)); }

template <int MODE> struct EpiBf16M {
    static constexpr bool PERM = true, AFTER_DRAIN = false;
    bf16_t* O; int ldc; const float* ss;
    __device__ __forceinline__ void operator()(const f32x4 (&acc)[2][2][4][2], const Unit& u, int wr, int wc, int fr, int fq) const {
        const int row0 = u.pm * BM + wr * 64 + fr, col0 = u.pn * BM + wc * 32 + 8 * fq;
        const int mode = (MODE == 1) ? (u.pn < 2 ? 1 : (u.pn >= 6 ? 2 : 0)) : 0;
#pragma unroll
        for (int ai = 0; ai < 2; ++ai)
#pragma unroll
            for (int m = 0; m < 4; ++m) { const int row = row0 + ai * HALF + m * 16; bf16_t* rowp = O + (size_t)row * ldc + col0;
                float rs = 1.0f;
                if (MODE == 1) { rs = 1.0f / sqrtf(ss[row] * (1.0f / 1024.0f) + 1e-6f); if (mode == 1) rs *= 0.125f; }
#pragma unroll
                for (int bj = 0; bj < 2; ++bj) { f32x4 v0 = acc[ai][bj][m][0], v1 = acc[ai][bj][m][1];
                    if (MODE == 1) { v0 = v0 * rs; v1 = v1 * rs; }
                    if (false) { }
                    else if (mode == 2) {
#pragma unroll
                        for (int e = 0; e < 4; ++e) { v0[e] = gelu_tanh(v0[e]); v1[e] = gelu_tanh(v1[e]); } }
                    u32x4 w; w.x = cvt_pk_bf16(v0[0], v0[1]); w.y = cvt_pk_bf16(v0[2], v0[3]); w.z = cvt_pk_bf16(v1[0], v1[1]); w.w = cvt_pk_bf16(v1[2], v1[3]);
                    *(u32x4*)(rowp + bj * HALF) = w; } }
    }
};
struct EpiSwiglu {
    static constexpr bool PERM = true, AFTER_DRAIN = false;
    bf16_t* O; int ldc; const float* ss;
    __device__ __forceinline__ void operator()(const f32x4 (&acc)[2][2][4][2], const Unit& u, int wr, int wc, int fr, int fq) const {
        const int row0 = u.pm * BM + wr * 64 + fr, col0 = u.pn * HALF + wc * 32 + 8 * fq;
#pragma unroll
        for (int ai = 0; ai < 2; ++ai)
#pragma unroll
            for (int m = 0; m < 4; ++m) { const int row = row0 + ai * HALF + m * 16; bf16_t* rowp = O + (size_t)row * ldc + col0;
                const float r2 = 1.0f / sqrtf(ss[row] * (1.0f / 1024.0f) + 1e-6f);
                f32x4 r0, r1;
#pragma unroll
                for (int e = 0; e < 4; ++e) { const float g0 = acc[ai][0][m][0][e] * r2, g1 = acc[ai][0][m][1][e] * r2;
                    r0[e] = g0 * sigmoid_f(g0) * (acc[ai][1][m][0][e] * r2); r1[e] = g1 * sigmoid_f(g1) * (acc[ai][1][m][1][e] * r2); }
                u32x4 w; w.x = cvt_pk_bf16(r0[0], r0[1]); w.y = cvt_pk_bf16(r0[2], r0[3]); w.z = cvt_pk_bf16(r1[0], r1[1]); w.w = cvt_pk_bf16(r1[2], r1[3]);
                *(u32x4*)rowp = w; }
    }
};
template <bool SS2> struct EpiResNorm {
    static constexpr bool PERM = false, AFTER_DRAIN = false;
    bf16_t* HB; const float* gain; float* ss1; unsigned* cnt; float* ss2; int ldc;
    __device__ __forceinline__ void operator()(f32x4 (&acc)[2][2][4][2], const Unit& u, int wr, int wc, int fr, int fq) const {
        const int row0 = u.pm * BM + wr * 64 + fr, col0 = u.pn * BM + wc * 32 + 4 * fq;
        u32x2 pre[4][2][2];
#pragma unroll
        for (int m = 0; m < 4; ++m)
#pragma unroll
            for (int bj = 0; bj < 2; ++bj)
#pragma unroll
                for (int n = 0; n < 2; ++n) pre[m][bj][n] = *(const u32x2*)(HB + (size_t)(row0 + m * 16) * ldc + col0 + bj * HALF + n * 16);
#pragma unroll
        for (int ai = 0; ai < 2; ++ai)
#pragma unroll
            for (int m = 0; m < 4; ++m) { float q = 0.f;
#pragma unroll
                for (int bj = 0; bj < 2; ++bj)
#pragma unroll
                    for (int n = 0; n < 2; ++n) { const f32x4 x = acc[ai][bj][m][n]; q += (x[0] * x[0] + x[1] * x[1]) + (x[2] * x[2] + x[3] * x[3]); }
                q += __shfl_xor(q, 16); q += __shfl_xor(q, 32);
                if (fq == 0) unsafeAtomicAdd(ss1 + row0 + ai * HALF + m * 16, q); }
        asm volatile("s_waitcnt vmcnt(0)" ::: "memory");
        unsigned* c = cnt + 64 * u.pm;
        if (fr == 0 && fq == 0) __hip_atomic_fetch_add(c, 1u, __ATOMIC_RELAXED, __HIP_MEMORY_SCOPE_AGENT);
        f32x4 gv[2][2];
#pragma unroll
        for (int bj = 0; bj < 2; ++bj)
#pragma unroll
            for (int n = 0; n < 2; ++n) gv[bj][n] = *(const f32x4*)(gain + col0 + bj * HALF + n * 16);
        while (__hip_atomic_load(c, __ATOMIC_RELAXED, __HIP_MEMORY_SCOPE_AGENT) < 32u) __builtin_amdgcn_s_sleep(1);
        __builtin_amdgcn_fence(__ATOMIC_ACQUIRE, "agent");
        float r1[2][4];
#pragma unroll
        for (int ai = 0; ai < 2; ++ai)
#pragma unroll
            for (int m = 0; m < 4; ++m) r1[ai][m] = __hip_atomic_load(ss1 + row0 + ai * HALF + m * 16, __ATOMIC_RELAXED, __HIP_MEMORY_SCOPE_AGENT);
#pragma unroll
        for (int ai = 0; ai < 2; ++ai)
#pragma unroll
            for (int m = 0; m < 4; ++m) { const int row = row0 + ai * HALF + m * 16; const size_t off = (size_t)row * ldc + col0;
                const float rr = 1.0f / sqrtf(r1[ai][m] * (1.0f / 1024.0f) + 1e-6f);
                float q2 = 0.f;
#pragma unroll
                for (int bj = 0; bj < 2; ++bj)
#pragma unroll
                    for (int n = 0; n < 2; ++n) { const size_t o2 = off + bj * HALF + n * 16;
                        const u32x2 pw = (ai == 0) ? pre[m][bj][n] : *(const u32x2*)(HB + o2);
                        f32x4 b; b[0] = __uint_as_float(pw.x << 16); b[1] = __uint_as_float(pw.x & 0xffff0000u); b[2] = __uint_as_float(pw.y << 16); b[3] = __uint_as_float(pw.y & 0xffff0000u);
                        const f32x4 h = b + acc[ai][bj][m][n] * rr * gv[bj][n];
                        u32x2 w; w.x = cvt_pk_bf16(h[0], h[1]); w.y = cvt_pk_bf16(h[2], h[3]); *(u32x2*)(HB + o2) = w;
                        if (SS2) q2 += (h[0] * h[0] + h[1] * h[1]) + (h[2] * h[2] + h[3] * h[3]); }
                if (SS2) { q2 += __shfl_xor(q2, 16); q2 += __shfl_xor(q2, 32); if (fq == 0) unsafeAtomicAdd(ss2 + row, q2); }
                if (m & 1) asm volatile("" ::: "memory"); }
    }
};
struct EpiF32 {
    static constexpr bool PERM = false, AFTER_DRAIN = false;
    float* O; int ldc;
    __device__ __forceinline__ void operator()(const f32x4 (&acc)[2][2][4][2], const Unit& u, int wr, int wc, int fr, int fq) const {
        const int row0 = u.pm * BM + wr * 64 + fr, col0 = u.pn * BM + wc * 32 + 4 * fq;
#pragma unroll
        for (int ai = 0; ai < 2; ++ai)
#pragma unroll
            for (int m = 0; m < 4; ++m) { float* rowp = O + (size_t)(row0 + ai * HALF + m * 16) * ldc + col0;
#pragma unroll
                for (int bj = 0; bj < 2; ++bj)
#pragma unroll
                    for (int n = 0; n < 2; ++n) *(f32x4*)(rowp + bj * HALF + n * 16) = acc[ai][bj][m][n]; }
    }
};
struct EpiFinal {
    static constexpr bool PERM = false, AFTER_DRAIN = false;
    const bf16_t* H2; const bf16_t* PE; const float* bias; float* O; int ldc;
    __device__ __forceinline__ void operator()(const f32x4 (&acc)[2][2][4][2], const Unit& u, int wr, int wc, int fr, int fq) const {
        const int row0 = u.pm * BM + wr * 64 + fr, col0 = u.pn * BM + wc * 32 + 4 * fq;
        f32x4 bv[2][2];
#pragma unroll
        for (int bj = 0; bj < 2; ++bj)
#pragma unroll
            for (int n = 0; n < 2; ++n) bv[bj][n] = *(const f32x4*)(bias + col0 + bj * HALF + n * 16);
#pragma unroll
        for (int ai = 0; ai < 2; ++ai)
#pragma unroll
            for (int m = 0; m < 4; ++m) { const size_t off = (size_t)(row0 + ai * HALF + m * 16) * ldc + col0;
#pragma unroll
                for (int bj = 0; bj < 2; ++bj)
#pragma unroll
                    for (int n = 0; n < 2; ++n) { const size_t o2 = off + bj * HALF + n * 16;
                        const u32x2 hw = *(const u32x2*)(H2 + o2); const u32x2 pw = *(const u32x2*)(PE + o2);
                        f32x4 h; h[0] = __uint_as_float(hw.x << 16); h[1] = __uint_as_float(hw.x & 0xffff0000u); h[2] = __uint_as_float(hw.y << 16); h[3] = __uint_as_float(hw.y & 0xffff0000u);
                        f32x4 pe; pe[0] = __uint_as_float(pw.x << 16); pe[1] = __uint_as_float(pw.x & 0xffff0000u); pe[2] = __uint_as_float(pw.y << 16); pe[3] = __uint_as_float(pw.y & 0xffff0000u);
                        const f32x4 a = acc[ai][bj][m][n] + bv[bj][n]; f32x4 o;
#pragma unroll
                        for (int e = 0; e < 4; ++e) o[e] = h[e] + sigmoid_f(a[e]) * pe[e];
                        *(f32x4*)(O + o2) = o; } }
    }
};

template <class Epi, class Sched, bool ALIGN_EPI = false, bool SP2 = false>
__device__ __forceinline__ void gemm_phase(PG8_LAS unsigned char* lds, const Gemm g, const Sched& S, const Epi& E, const int wave_id) {
    const int wid = wave_id, lane = lane_id_asm(), tid = wid * 64 + lane, wr = wid >> 2, wc = wid & 3, fr = lane & 15, fq = lane >> 4;
    const int K = g.K, nt = K / BK;
    unsigned voffA[2], voffB[2];
#pragma unroll
    for (int i = 0; i < 2; ++i) { int R, C; stage_rc(tid * 16 + i * 8192, R, C); const int Rb = Epi::PERM ? ((R & ~31) + perm32(R & 31)) : R;
        voffA[i] = (unsigned)(R * K + C) * 2u; voffB[i] = (unsigned)(Rb * K + C) * 2u; }
    const size_t kstep = (size_t)(BK * 2);
    const size_t hstep = (size_t)HALF * K * 2;
    const size_t tstep = 2 * hstep;
    const unsigned ldsw = (unsigned)wid * 1024u;
    const int aoff = lds_byte(wr * 64 + fr, fq * 8), boff = lds_byte(wc * 32 + fr, fq * 8);
#define PG8_SA(b, h) (((b) * 2 + (h)) * HTB)
#define PG8_SB(b, h) ((4 + (b) * 2 + (h)) * HTB)
#define PG8_STAGE(bufoff, gbase, voff) do { _Pragma("unroll") for (int _i = 0; _i < 2; ++_i) \
        __builtin_amdgcn_global_load_lds((const unsigned*)((const char*)(gbase) + (voff)[_i]), (PG8_LAS unsigned*)(lds + (bufoff) + ldsw + _i * 8192), 16, 0, 0); } while (0)
#define PG8_LDA(dst, b, h) do { _Pragma("unroll") for (int m = 0; m < 4; ++m) _Pragma("unroll") for (int k = 0; k < 2; ++k) dst[m][k] = *(const PG8_LAS bf16x8*)(lds + PG8_SA(b, h) + aoff + m * 2048 + k * 1024); } while (0)
#define PG8_LDB(dst, b, h) do { _Pragma("unroll") for (int n = 0; n < 2; ++n) _Pragma("unroll") for (int k = 0; k < 2; ++k) dst[n][k] = *(const PG8_LAS bf16x8*)(lds + PG8_SB(b, h) + boff + n * 2048 + k * 1024); } while (0)
#define PG8_MMA(ai, bj, At, Bt) do { __builtin_amdgcn_s_setprio(1); _Pragma("unroll") for (int m = 0; m < 4; ++m) _Pragma("unroll") for (int n = 0; n < 2; ++n) _Pragma("unroll") for (int k = 0; k < 2; ++k) \
        acc[ai][bj][m][n] = __builtin_amdgcn_mfma_f32_16x16x32_bf16(Bt[n][k], At[m][k], acc[ai][bj][m][n], 0, 0, 0); __builtin_amdgcn_s_setprio(0); } while (0)
#define PG8_WAIT_V(n) asm volatile("s_waitcnt vmcnt(" #n ")" ::: "memory")
#define PG8_WAIT_L(n) asm volatile("s_waitcnt lgkmcnt(" #n ")" ::: "memory")
#define PG8_BAR __builtin_amdgcn_s_barrier()
#define PG8_SCHED __builtin_amdgcn_sched_barrier(0)
    Unit cur, nxt; int ui = 0;
    if (!S.next(0, cur)) return;
    f32x4 acc[2][2][4][2];
#pragma unroll
    for (int a = 0; a < 2; ++a)
#pragma unroll
        for (int b = 0; b < 2; ++b)
#pragma unroll
            for (int m = 0; m < 4; ++m)
#pragma unroll
                for (int n = 0; n < 2; ++n) acc[a][b][m][n] = (f32x4){0.f, 0.f, 0.f, 0.f};
    bf16x8 At[4][2], B0[2][2], B1[2][2];
    const char* cA = (const char*)g.A + (size_t)cur.pm * tstep; const char* cB = (const char*)g.Bt + (size_t)cur.pn * tstep;
    S.a_ready(cur);
    if constexpr (SP2) {
        PG8_STAGE(PG8_SB(0, 0), cB, voffB); PG8_STAGE(PG8_SB(0, 1), cB + hstep, voffB); PG8_STAGE(PG8_SA(0, 0), cA, voffA); PG8_STAGE(PG8_SA(0, 1), cA + hstep, voffA);
        if (wr == 1) PG8_BAR;
        PG8_WAIT_V(2); PG8_BAR;
        PG8_STAGE(PG8_SB(1, 0), cB + kstep, voffB); PG8_STAGE(PG8_SA(1, 0), cA + kstep, voffA); PG8_STAGE(PG8_SB(1, 1), cB + hstep + kstep, voffB);
        PG8_WAIT_V(6); PG8_BAR;
    } else {
        PG8_STAGE(PG8_SB(0, 0), cB, voffB); PG8_STAGE(PG8_SA(0, 0), cA, voffA); PG8_STAGE(PG8_SB(0, 1), cB + hstep, voffB); PG8_STAGE(PG8_SA(0, 1), cA + hstep, voffA);
        if (wr == 1) PG8_BAR;
        PG8_WAIT_V(4); PG8_BAR;
        PG8_STAGE(PG8_SB(1, 0), cB + kstep, voffB); PG8_STAGE(PG8_SA(1, 0), cA + kstep, voffA); PG8_STAGE(PG8_SB(1, 1), cB + hstep + kstep, voffB);
        PG8_WAIT_V(6); PG8_BAR;
    }
    for (;;) {
        const bool has_next = S.next(ui + 1, nxt);
        const char* nA = has_next ? (const char*)g.A + (size_t)nxt.pm * tstep : cA; const char* nB = has_next ? (const char*)g.Bt + (size_t)nxt.pn * tstep : cB;
        for (int t = 0; t < nt; t += 2) {
            const bool last = (t == nt - 2);
            const char* a1 = cA + (size_t)(t + 1) * kstep;
            const char* a2 = last ? nA : cA + (size_t)(t + 2) * kstep; const char* b2 = last ? nB : cB + (size_t)(t + 2) * kstep;
            const char* a3 = a2 + kstep; const char* b3 = b2 + kstep;
            if (last && has_next) S.a_ready(nxt);
            if constexpr (SP2) {
            PG8_LDB(B0, 0, 0); PG8_LDB(B1, 0, 1); PG8_SCHED; PG8_LDA(At, 0, 0); PG8_STAGE(PG8_SA(1, 1), a1 + hstep, voffA);
            PG8_WAIT_V(8); PG8_WAIT_L(0); PG8_BAR; PG8_MMA(0, 0, At, B0); PG8_MMA(0, 1, At, B1); PG8_BAR; PG8_SCHED;
            PG8_LDA(At, 0, 1); PG8_STAGE(PG8_SB(0, 0), b2, voffB); PG8_STAGE(PG8_SB(0, 1), b2 + hstep, voffB); PG8_STAGE(PG8_SA(0, 0), a2, voffA);
            PG8_WAIT_V(8); PG8_WAIT_L(0); PG8_BAR; PG8_MMA(1, 0, At, B0); PG8_MMA(1, 1, At, B1); PG8_BAR; PG8_SCHED;
            PG8_LDB(B0, 1, 0); PG8_LDB(B1, 1, 1); PG8_SCHED; PG8_LDA(At, 1, 0); PG8_STAGE(PG8_SA(0, 1), a2 + hstep, voffA);
            PG8_WAIT_V(8); PG8_WAIT_L(0); PG8_BAR; PG8_MMA(0, 0, At, B0); PG8_MMA(0, 1, At, B1); PG8_BAR; PG8_SCHED;
            PG8_LDA(At, 1, 1); PG8_STAGE(PG8_SB(1, 0), b3, voffB); PG8_STAGE(PG8_SB(1, 1), b3 + hstep, voffB); PG8_STAGE(PG8_SA(1, 0), a3, voffA);
            PG8_WAIT_V(8); PG8_WAIT_L(0); PG8_BAR; PG8_MMA(1, 0, At, B0); PG8_MMA(1, 1, At, B1); PG8_BAR; PG8_SCHED;
            } else {
            PG8_LDB(B0, 0, 0); PG8_SCHED; PG8_LDA(At, 0, 0); PG8_STAGE(PG8_SA(1, 1), a1 + hstep, voffA);
            PG8_WAIT_L(8); PG8_BAR; PG8_WAIT_L(0); PG8_MMA(0, 0, At, B0); PG8_BAR; PG8_SCHED;
            PG8_LDB(B1, 0, 1); PG8_STAGE(PG8_SB(0, 0), b2, voffB);
            PG8_BAR; PG8_WAIT_L(0); PG8_MMA(0, 1, At, B1); PG8_BAR;
            PG8_LDA(At, 0, 1); PG8_STAGE(PG8_SA(0, 0), a2, voffA);
            PG8_BAR; PG8_WAIT_L(0); PG8_MMA(1, 0, At, B0); PG8_BAR; PG8_SCHED;
            PG8_STAGE(PG8_SB(0, 1), b2 + hstep, voffB);
            PG8_WAIT_V(6); PG8_BAR; PG8_MMA(1, 1, At, B1); PG8_BAR;
            PG8_LDB(B0, 1, 0); PG8_SCHED; PG8_LDA(At, 1, 0); PG8_STAGE(PG8_SA(0, 1), a2 + hstep, voffA);
            PG8_WAIT_L(8); PG8_BAR; PG8_WAIT_L(0); PG8_MMA(0, 0, At, B0); PG8_BAR; PG8_SCHED;
            PG8_LDB(B1, 1, 1); PG8_STAGE(PG8_SB(1, 0), b3, voffB);
            PG8_BAR; PG8_WAIT_L(0); PG8_MMA(0, 1, At, B1); PG8_BAR;
            PG8_LDA(At, 1, 1); PG8_STAGE(PG8_SA(1, 0), a3, voffA);
            PG8_BAR; PG8_WAIT_L(0); PG8_MMA(1, 0, At, B0); PG8_BAR; PG8_SCHED;
            PG8_STAGE(PG8_SB(1, 1), b3 + hstep, voffB);
            PG8_WAIT_V(6); PG8_BAR; PG8_MMA(1, 1, At, B1); PG8_BAR;
            }
        }
        if constexpr (ALIGN_EPI) { if (wr == 0) PG8_BAR; }
        if constexpr (!Epi::AFTER_DRAIN) { E(acc, cur, wr, wc, fr, fq); S.done(cur); }
        if (!has_next) break;
#pragma unroll
        for (int a = 0; a < 2; ++a)
#pragma unroll
            for (int b = 0; b < 2; ++b)
#pragma unroll
                for (int m = 0; m < 4; ++m)
#pragma unroll
                    for (int n = 0; n < 2; ++n) acc[a][b][m][n] = (f32x4){0.f, 0.f, 0.f, 0.f};
        cur = nxt; cA = nA; cB = nB; ++ui;
        if constexpr (ALIGN_EPI) { if (wr == 1) PG8_BAR; }
    }
    PG8_WAIT_V(0);
    if constexpr (!ALIGN_EPI) { if (wr == 0) PG8_BAR; }
    PG8_BAR;
    if constexpr (Epi::AFTER_DRAIN) { E.fused(acc, cur, wr, wc, fr, fq, lds, wid, lane); S.done(cur); }
#undef PG8_SA
#undef PG8_SB
#undef PG8_STAGE
#undef PG8_LDA
#undef PG8_LDB
#undef PG8_MMA
#undef PG8_WAIT_V
#undef PG8_WAIT_L
#undef PG8_BAR
#undef PG8_SCHED
}
}

constexpr int NWAVES = 8;
constexpr int BATCH = 4, SEQ = 8192, DM = 1024, MTOK = BATCH * SEQ, PLE = 256, AW = 512, SW = 512, HD = 64, NH = 8, NG = 4, GD = 128, CHUNK = 128, DFF = 2816, PC = 2560;
constexpr float EPS = 1e-6f;
#ifndef MK_N_LAUNCHES
#define MK_N_LAUNCHES 1
#endif
constexpr int N_PHASES = 10;

constexpr size_t MiB = 1u << 20;
constexpr size_t WS_W1 = 2 * MiB, WS_W2 = 8 * MiB, WS_W3 = 10 * MiB, WS_W4 = 22 * MiB, WS_W5 = 28 * MiB, WS_W6 = 30 * MiB;
constexpr size_t WS_XN = 32 * MiB;
constexpr size_t WS_PE = 96 * MiB;
constexpr size_t WS_PB = 160 * MiB;
constexpr size_t WS_PROJ = 176 * MiB;
constexpr size_t WS_AO = 336 * MiB;
constexpr size_t WS_LSE = 432 * MiB;
constexpr size_t WS_SG = 436 * MiB;
constexpr size_t WS_GROUPS = 176 * MiB;
constexpr size_t WS_MIXED = 240 * MiB;
constexpr size_t WS_H1 = 368 * MiB;
constexpr size_t WS_ACT = 176 * MiB;
constexpr size_t WS_END = 496 * MiB;
static_assert(WS_ACT + (size_t)MTOK * DFF * 2 <= WS_H1 && WS_MIXED + (size_t)MTOK * DM * 4 <= WS_H1 && WS_H1 + (size_t)MTOK * DM * 4 <= WS_END, "ws map");
static_assert(WS_PROJ + (size_t)MTOK * PC * 2 <= WS_AO && WS_AO + 3 * (size_t)MTOK * AW * 2 <= WS_LSE && WS_SG + (size_t)MTOK * SW * 2 <= WS_END, "ws map 2");

constexpr size_t CT_ZERO_LO = 4096, CT_SS1 = 4096, CT_SS2 = CT_SS1 + 131072, CT_SS3 = CT_SS2 + 131072, CT_CNT1 = 524288, CT_CNT3 = CT_CNT1 + 32768, CT_ZERO_HI = CT_CNT3 + 32768, CT_SS0 = 1048576;
static_assert(CT_SS3 + 131072 <= CT_CNT1 && CT_ZERO_HI <= 2 * MiB && (MTOK / 256) * 256 <= 32768, "control map");
constexpr int RING_BYTES = 131072;
constexpr int LDS_BYTES = 147456;

#define GAS __attribute__((address_space(1)))
#define LAS __attribute__((address_space(3)))
typedef unsigned short bf16;
typedef unsigned v4u __attribute__((ext_vector_type(4)));
typedef unsigned v2u __attribute__((ext_vector_type(2)));
typedef float f32x4 __attribute__((ext_vector_type(4)));
typedef short bf16x8 __attribute__((ext_vector_type(8)));
typedef short v4i16_t __attribute__((ext_vector_type(4)));
typedef float f32x2_t __attribute__((ext_vector_type(2)));
typedef __bf16 bf16x2_t __attribute__((ext_vector_type(2)));
#define LDS_WAIT() asm volatile("s_waitcnt lgkmcnt(0)" ::: "memory")
__device__ __forceinline__ unsigned pk2(float lo, float hi) { f32x2_t v = {lo, hi}; bf16x2_t b = __builtin_convertvector(v, bf16x2_t); return __builtin_bit_cast(unsigned, b); }
__device__ __forceinline__ float bflo(unsigned w) { return __uint_as_float(w << 16); }
__device__ __forceinline__ float bfhi(unsigned w) { return __uint_as_float(w & 0xffff0000u); }
__device__ __forceinline__ float wave_sum(float v) {
#pragma unroll
    for (int o = 1; o < 64; o <<= 1) v += __shfl_xor(v, o);
    return v;
}
__device__ __forceinline__ v4i16_t tr_read(LAS unsigned char* p) { return __builtin_amdgcn_ds_read_tr16_b64_v4i16((LAS v4i16_t*)p); }

struct Args { const float* in[19]; float* out; unsigned char* ws; int ph_lo, ph_hi; };
#define CAS __attribute__((address_space(4)))
__device__ __forceinline__ const float* arg_in(int i) {
    const CAS unsigned char* kp = (const CAS unsigned char*)__builtin_amdgcn_kernarg_segment_ptr();
    asm volatile("" : "+s"(kp));
    typedef const float* cfp_t;
    return *(const CAS cfp_t*)(kp + 8 * i);
}
struct Frame {
    LAS unsigned char* lds;
    int wave, vcu, G;
    float* out; unsigned char* ws;
};

__device__ __forceinline__ void p0_transpose_item(const float* W, int K, int N, bf16* WT, int mode, const float* ks0, const float* ks1, LAS float* scr, int item, int lane) {
    const int nblk = N / 32, kb = item / nblk, nb = item % nblk, k0 = 64 * kb, n0 = 32 * nb;
#pragma unroll 8
    for (int i = 0; i < 32; ++i) { const int kk = 2 * i + (lane >> 5); const int kg = k0 + kk;
        const float sc = ks0 ? (kg < 512 ? ks0[kg] : ks1[kg - 512]) : 1.0f;
        scr[kk * 33 + (lane & 31)] = W[(size_t)kg * N + n0 + (lane & 31)] * sc; }
    LDS_WAIT(); asm volatile("" ::: "memory");
    int d0 = n0;
    if (mode == 1) { d0 = (n0 < DFF) ? ((n0 / 128) * 256 + (n0 % 128)) : (((n0 - DFF) / 128) * 256 + 128 + ((n0 - DFF) % 128)); }
    const int c = lane & 7;
#pragma unroll
    for (int j = 0; j < 4; ++j) { const int n = (lane >> 3) + 8 * j; const LAS float* s = scr + (8 * c) * 33 + n;
        v4u o; o.x = pk2(s[0 * 33], s[1 * 33]); o.y = pk2(s[2 * 33], s[3 * 33]); o.z = pk2(s[4 * 33], s[5 * 33]); o.w = pk2(s[6 * 33], s[7 * 33]);
        *(GAS v4u*)(WT + (size_t)(d0 + n) * K + k0 + 8 * c) = o; }
    LDS_WAIT(); asm volatile("" ::: "memory");
}
__device__ __forceinline__ void p0_prologue(Frame& F, const Args& A) {
    const int lane_ = pg8::lane_id_asm();
    LAS float* scr = (LAS float*)(F.lds + F.wave * 16384);
    const int gw = F.vcu * NWAVES + F.wave, NGW = F.G * NWAVES;
    bf16* W1t = (bf16*)(F.ws + WS_W1); bf16* W2t = (bf16*)(F.ws + WS_W2); bf16* W3t = (bf16*)(F.ws + WS_W3);
    bf16* W4t = (bf16*)(F.ws + WS_W4); bf16* W5t = (bf16*)(F.ws + WS_W5); bf16* W6t = (bf16*)(F.ws + WS_W6);
    constexpr int I1 = (DM / 64) * (PC / 32), I2 = (DM / 64) * (DM / 32), I3 = (DM / 64) * (2 * DFF / 32), I4 = (DFF / 64) * (DM / 32), I5 = I2, I6 = (PLE / 64) * (DM / 32);
    constexpr int NITEMS = I1 + I2 + I3 + I4 + I5 + I6;
    for (int it = gw; it < NITEMS; it += NGW) {
        int r = it;
        if (r < I1) { p0_transpose_item(arg_in(3), DM, PC, W1t, 0, arg_in(2), arg_in(2) + 512, scr, r, lane_); continue; } r -= I1;
        if (r < I2) { p0_transpose_item(arg_in(10), DM, DM, W2t, 0, arg_in(8), arg_in(9), scr, r, lane_); continue; } r -= I2;
        if (r < I3) { p0_transpose_item(arg_in(13), DM, 2 * DFF, W3t, 1, arg_in(12), arg_in(12) + 512, scr, r, lane_); continue; } r -= I3;
        if (r < I4) { p0_transpose_item(arg_in(14), DFF, DM, W4t, 0, nullptr, nullptr, scr, r, lane_); continue; } r -= I4;
        if (r < I5) { p0_transpose_item(arg_in(16), DM, DM, W5t, 0, nullptr, nullptr, scr, r, lane_); continue; } r -= I5;
        p0_transpose_item(arg_in(18), PLE, DM, W6t, 0, nullptr, nullptr, scr, r, lane_);
    }
    { const v4u z = {0u, 0u, 0u, 0u}; GAS v4u* zp = (GAS v4u*)(F.ws + CT_ZERO_LO);
      for (int i = gw * 64 + lane_; i < (int)((CT_ZERO_HI - CT_ZERO_LO) / 16); i += NGW * 64) zp[i] = z; }
    bf16* XN = (bf16*)(F.ws + WS_XN); bf16* PB = (bf16*)(F.ws + WS_PB);
    for (int m = gw; m < MTOK; m += NGW) {
        const GAS f32x4* xr = (const GAS f32x4*)(arg_in(0) + (size_t)m * DM) + lane_;
        f32x4 v[4]; float s = 0.f;
#pragma unroll
        for (int j = 0; j < 4; ++j) { v[j] = xr[64 * j]; s += (v[j].x * v[j].x + v[j].y * v[j].y) + (v[j].z * v[j].z + v[j].w * v[j].w); }
        const f32x4 pv = *((const GAS f32x4*)(arg_in(1) + (size_t)m * PLE) + lane_);
        const float ssum = wave_sum(s);
        if (lane_ == 0) ((float*)(F.ws + CT_SS0))[m] = ssum;
        GAS v2u* o8 = (GAS v2u*)(XN + (size_t)m * DM) + lane_;
#pragma unroll
        for (int j = 0; j < 4; ++j) { v2u o; o.x = pk2(v[j].x, v[j].y); o.y = pk2(v[j].z, v[j].w); o8[64 * j] = o; }
        v2u po; po.x = pk2(pv.x, pv.y); po.y = pk2(pv.z, pv.w);
        *((GAS v2u*)(PB + (size_t)m * PLE) + lane_) = po;
    }
}

constexpr int KP = 144;
constexpr int ATT_LDS_K = 0, ATT_LDS_V = 256 * KP;
constexpr int ATT_ITEMS = 3 * BATCH * NH * 64;
struct AttItem { int br, b, h, d, tok_cur, tok_prev; bool first; };
__device__ __forceinline__ AttItem att_decode(int id) {
    AttItem I; I.br = id / 2048; int rem = id % 2048; I.b = rem / 512; rem %= 512; I.h = rem / 64; const int s = rem % 64;
    I.d = 1 << (2 * I.br); const int nb = 64 >> (2 * I.br); const int r = s / nb, n = s % nb;
    I.first = (n == 0);
    I.tok_cur = I.b * SEQ + r + I.d * (128 * n); I.tok_prev = I.first ? I.tok_cur : I.tok_cur - I.d * 128;
    return I;
}
__device__ __forceinline__ void att_load(const AttItem& I, const bf16* PROJ, int tid, v4u (&kr)[4], v4u (&vr)[4]) {
#pragma unroll
    for (int i = 0; i < 4; ++i) { const int c = tid + 512 * i, row = c >> 3, ch = c & 7;
        const int tok = (row < 128) ? (I.tok_prev + I.d * row) : (I.tok_cur + I.d * (row - 128));
        const bf16* src = PROJ + (size_t)tok * PC + AW + I.h * HD + ch * 8;
        kr[i] = *(const GAS v4u*)src; vr[i] = *(const GAS v4u*)(src + AW); }
}
__device__ __forceinline__ void att_phase(Frame& F, const Args& A, int first_item, int n_items) {
    const bf16* PROJ = (const bf16*)(F.ws + WS_PROJ);
    bf16* AO = (bf16*)(F.ws + WS_AO); float* LSE = (float*)(F.ws + WS_LSE);
    LAS unsigned char* lds = F.lds;
    const int lane = pg8::lane_id_asm(), w = F.wave, tid = w * 64 + lane, l15 = lane & 15, fq = lane >> 4;
    v4u kr[4], vr[4];
    AttItem I = att_decode(first_item);
    att_load(I, PROJ, tid, kr, vr);
    for (int it = 0; it < n_items; ++it) {
#pragma unroll
        for (int i = 0; i < 4; ++i) { const int c = tid + 512 * i, row = c >> 3, ch = c & 7;
            *(LAS v4u*)(lds + ATT_LDS_K + row * KP + ch * 16) = kr[i]; *(LAS v4u*)(lds + ATT_LDS_V + row * KP + ch * 16) = vr[i]; }
        const AttItem C = I;
        __syncthreads();
        if (it + 1 < n_items) { I = att_decode(first_item + it + 1); att_load(I, PROJ, tid, kr, vr); }
        const int qtok = C.tok_cur + C.d * (16 * w + l15);
        const bf16* qp = PROJ + (size_t)qtok * PC + C.h * HD + 8 * fq;
        const bf16x8 q0 = *(const GAS bf16x8*)qp, q1 = *(const GAS bf16x8*)(qp + 32);
        f32x4 s[9];
#pragma unroll
        for (int kk = 0; kk < 9; ++kk) {
            LAS unsigned char* kp = lds + ATT_LDS_K + (16 * (w + kk) + l15) * KP + 16 * fq;
            const bf16x8 a0 = *(const LAS bf16x8*)kp, a1 = *(const LAS bf16x8*)(kp + 64);
            f32x4 z = {0.f, 0.f, 0.f, 0.f};
            z = __builtin_amdgcn_mfma_f32_16x16x32_bf16(a0, q0, z, 0, 0, 0);
            s[kk] = __builtin_amdgcn_mfma_f32_16x16x32_bf16(a1, q1, z, 0, 0, 0);
        }
        const float LOG2E = 1.4426950408889634f, NEGBIG = -3.0e38f;
        const float c2 = LOG2E * (float)C.d * __builtin_amdgcn_exp2f(-(float)(C.h + 1));
        const int t = l15 - 4 * fq; const float ft = (float)t;
        float mx = NEGBIG;
#pragma unroll
        for (int kk = 0; kk < 9; ++kk) {
            const bool blk_dead = C.first && (w + kk < 8);
#pragma unroll
            for (int j = 0; j < 4; ++j) {
                float v = s[kk][j] * LOG2E - c2 * ((float)(128 - 16 * kk - j) + ft);
                if (kk == 0) v = (t > j) ? NEGBIG : v;
                if (kk == 8) v = (t < j) ? NEGBIG : v;
                v = blk_dead ? NEGBIG : v;
                s[kk][j] = v; mx = fmaxf(mx, v); }
        }
        mx = fmaxf(mx, __shfl_xor(mx, 16)); mx = fmaxf(mx, __shfl_xor(mx, 32));
        float sum = 0.f;
#pragma unroll
        for (int kk = 0; kk < 9; ++kk)
#pragma unroll
            for (int j = 0; j < 4; ++j) { const float p = __builtin_amdgcn_exp2f(s[kk][j] - mx); s[kk][j] = p; sum += p; }
        sum += __shfl_xor(sum, 16); sum += __shfl_xor(sum, 32);
        f32x4 o[4];
#pragma unroll
        for (int d0 = 0; d0 < 4; ++d0) o[d0] = (f32x4){0.f, 0.f, 0.f, 0.f};
#pragma unroll
        for (int pp = 0; pp < 5; ++pp) {
            const int kA = 2 * pp, kB = (pp < 4) ? 2 * pp + 1 : 2 * pp;
            v4u pw; pw.x = pk2(s[kA][0], s[kA][1]); pw.y = pk2(s[kA][2], s[kA][3]);
            if (pp < 4) { pw.z = pk2(s[kB][0], s[kB][1]); pw.w = pk2(s[kB][2], s[kB][3]); } else { pw.z = 0u; pw.w = 0u; }
            const bf16x8 pf = __builtin_bit_cast(bf16x8, pw);
            LAS unsigned char* va = lds + ATT_LDS_V + (16 * (w + kA) + 4 * fq + (l15 >> 2)) * KP + 8 * (l15 & 3);
            LAS unsigned char* vb = lds + ATT_LDS_V + (16 * (w + kB) + 4 * fq + (l15 >> 2)) * KP + 8 * (l15 & 3);
#pragma unroll
            for (int d0 = 0; d0 < 4; ++d0) {
                const v4i16_t lo = tr_read(va + 32 * d0), hi = tr_read(vb + 32 * d0);
                const bf16x8 vf = {lo[0], lo[1], lo[2], lo[3], hi[0], hi[1], hi[2], hi[3]};
                o[d0] = __builtin_amdgcn_mfma_f32_16x16x32_bf16(vf, pf, o[d0], 0, 0, 0);
            }
        }
        const float inv = 1.0f / sum;
        bf16* op = AO + (size_t)C.br * MTOK * AW + (size_t)qtok * AW + C.h * HD + 4 * fq;
#pragma unroll
        for (int d0 = 0; d0 < 4; ++d0) { v2u ow; ow.x = pk2(o[d0][0] * inv, o[d0][1] * inv); ow.y = pk2(o[d0][2] * inv, o[d0][3] * inv); *(GAS v2u*)(op + 16 * d0) = ow; }
        if (fq == 0) LSE[(size_t)C.br * MTOK * NH + (size_t)qtok * NH + C.h] = mx + __builtin_amdgcn_logf(sum);
        __syncthreads();
    }
}

constexpr int ZP = 272;
constexpr int SGU_ITEMS = BATCH * (SEQ / CHUNK) * NG;
__device__ __forceinline__ void sgu_phase(Frame& F, const Args& A, int first_item, int n_items) {
    const bf16* PROJ = (const bf16*)(F.ws + WS_PROJ); bf16* SG = (bf16*)(F.ws + WS_SG);
    const float* lng = arg_in(4); const float* lnb = arg_in(5); const float* wsp = arg_in(6); const float* bsp = arg_in(7);
    LAS unsigned char* lds = F.lds;
    const int lane = pg8::lane_id_asm(), w = F.wave, tid = w * 64 + lane, l15 = lane & 15, fq = lane >> 4;
    for (int it = 0; it < n_items; ++it) {
        const int id = first_item + it, b = id / 256, n = (id % 256) / 4, g = id % 4;
        const int t0 = b * SEQ + n * CHUNK;
        const int c8 = tid & 15;
        f32x4 g0 = *(const GAS f32x4*)(lng + c8 * 8), g1 = *(const GAS f32x4*)(lng + c8 * 8 + 4), b0 = *(const GAS f32x4*)(lnb + c8 * 8), b1 = *(const GAS f32x4*)(lnb + c8 * 8 + 4);
#pragma unroll
        for (int i = 0; i < 4; ++i) { const int j = 32 * i + (tid >> 4);
            const v4u zw = *(const GAS v4u*)(PROJ + (size_t)(t0 + j) * PC + 2048 + g * GD + c8 * 8);
            float x[8] = {bflo(zw.x), bfhi(zw.x), bflo(zw.y), bfhi(zw.y), bflo(zw.z), bfhi(zw.z), bflo(zw.w), bfhi(zw.w)};
            float s = ((x[0] + x[1]) + (x[2] + x[3])) + ((x[4] + x[5]) + (x[6] + x[7]));
            s += __shfl_xor(s, 1); s += __shfl_xor(s, 2); s += __shfl_xor(s, 4); s += __shfl_xor(s, 8);
            const float mean = s * (1.0f / GD); float q = 0.f;
#pragma unroll
            for (int e = 0; e < 8; ++e) { x[e] -= mean; q += x[e] * x[e]; }
            q += __shfl_xor(q, 1); q += __shfl_xor(q, 2); q += __shfl_xor(q, 4); q += __shfl_xor(q, 8);
            const float rstd = 1.0f / sqrtf(q * (1.0f / GD) + EPS);
            v4u o; o.x = pk2(x[0] * rstd * g0.x + b0.x, x[1] * rstd * g0.y + b0.y); o.y = pk2(x[2] * rstd * g0.z + b0.z, x[3] * rstd * g0.w + b0.w);
            o.z = pk2(x[4] * rstd * g1.x + b1.x, x[5] * rstd * g1.y + b1.y); o.w = pk2(x[6] * rstd * g1.z + b1.z, x[7] * rstd * g1.w + b1.w);
            *(LAS v4u*)(lds + j * ZP + c8 * 16) = o; }
        __syncthreads();
        const int i_loc = 16 * w + l15;
        const float* wrow = wsp + ((size_t)g * CHUNK + i_loc) * CHUNK;
        f32x4 acc[8];
#pragma unroll
        for (int cb = 0; cb < 8; ++cb) acc[cb] = (f32x4){0.f, 0.f, 0.f, 0.f};
        const int nks = (w >> 1) + 1;
        for (int ks = 0; ks < nks; ++ks) {
            const int j0 = 32 * ks + 8 * fq;
            const f32x4 wa = *(const GAS f32x4*)(wrow + j0), wb = *(const GAS f32x4*)(wrow + j0 + 4);
            v4u ww; ww.x = pk2(j0 + 0 <= i_loc ? wa.x : 0.f, j0 + 1 <= i_loc ? wa.y : 0.f); ww.y = pk2(j0 + 2 <= i_loc ? wa.z : 0.f, j0 + 3 <= i_loc ? wa.w : 0.f);
            ww.z = pk2(j0 + 4 <= i_loc ? wb.x : 0.f, j0 + 5 <= i_loc ? wb.y : 0.f); ww.w = pk2(j0 + 6 <= i_loc ? wb.z : 0.f, j0 + 7 <= i_loc ? wb.w : 0.f);
            const bf16x8 wf = __builtin_bit_cast(bf16x8, ww);
            LAS unsigned char* zp = lds + (32 * ks + 8 * fq + (l15 >> 2)) * ZP + 8 * (l15 & 3);
#pragma unroll
            for (int cb = 0; cb < 8; ++cb) {
                const v4i16_t lo = tr_read(zp + 32 * cb), hi = tr_read(zp + 4 * ZP + 32 * cb);
                const bf16x8 zf = {lo[0], lo[1], lo[2], lo[3], hi[0], hi[1], hi[2], hi[3]};
                acc[cb] = __builtin_amdgcn_mfma_f32_16x16x32_bf16(zf, wf, acc[cb], 0, 0, 0);
            }
        }
        const float bs = bsp[g * CHUNK + i_loc];
        const bf16* up = PROJ + (size_t)(t0 + i_loc) * PC + 1536 + g * GD + 4 * fq;
        bf16* op = SG + (size_t)(t0 + i_loc) * SW + g * GD + 4 * fq;
#pragma unroll
        for (int cb = 0; cb < 8; ++cb) { const v2u uw = *(const GAS v2u*)(up + 16 * cb);
            v2u ow; ow.x = pk2(bflo(uw.x) * (acc[cb][0] + bs), bfhi(uw.x) * (acc[cb][1] + bs)); ow.y = pk2(bflo(uw.y) * (acc[cb][2] + bs), bfhi(uw.y) * (acc[cb][3] + bs));
            *(GAS v2u*)(op + 16 * cb) = ow; }
        __syncthreads();
    }
}

__device__ __forceinline__ void merge_phase(Frame& F, const Args& A) {
    const bf16* AO = (const bf16*)(F.ws + WS_AO); const float* LSE = (const float*)(F.ws + WS_LSE); const bf16* SG = (const bf16*)(F.ws + WS_SG);
    bf16* GR = (bf16*)(F.ws + WS_GROUPS);
    const int gw = F.vcu * NWAVES + F.wave, NGW = F.G * NWAVES, lane = pg8::lane_id_asm(), h = lane >> 3;
    for (int m = gw; m < MTOK; m += NGW) {
        float l0 = LSE[(size_t)m * NH + h], l1 = LSE[(size_t)MTOK * NH + (size_t)m * NH + h], l2 = LSE[(size_t)2 * MTOK * NH + (size_t)m * NH + h];
        const v4u a0 = *((const GAS v4u*)(AO + (size_t)m * AW) + lane), a1 = *((const GAS v4u*)(AO + (size_t)MTOK * AW + (size_t)m * AW) + lane), a2 = *((const GAS v4u*)(AO + (size_t)2 * MTOK * AW + (size_t)m * AW) + lane);
        const v4u sg = *((const GAS v4u*)(SG + (size_t)m * SW) + lane);
        const float lm = fmaxf(l0, fmaxf(l1, l2));
        float w0 = __builtin_amdgcn_exp2f(l0 - lm), w1 = __builtin_amdgcn_exp2f(l1 - lm), w2 = __builtin_amdgcn_exp2f(l2 - lm);
        const float wi = 1.0f / (w0 + w1 + w2); w0 *= wi; w1 *= wi; w2 *= wi;
        float o[8], sv[8];
        o[0] = w0 * bflo(a0.x) + w1 * bflo(a1.x) + w2 * bflo(a2.x); o[1] = w0 * bfhi(a0.x) + w1 * bfhi(a1.x) + w2 * bfhi(a2.x);
        o[2] = w0 * bflo(a0.y) + w1 * bflo(a1.y) + w2 * bflo(a2.y); o[3] = w0 * bfhi(a0.y) + w1 * bfhi(a1.y) + w2 * bfhi(a2.y);
        o[4] = w0 * bflo(a0.z) + w1 * bflo(a1.z) + w2 * bflo(a2.z); o[5] = w0 * bfhi(a0.z) + w1 * bfhi(a1.z) + w2 * bfhi(a2.z);
        o[6] = w0 * bflo(a0.w) + w1 * bflo(a1.w) + w2 * bflo(a2.w); o[7] = w0 * bfhi(a0.w) + w1 * bfhi(a1.w) + w2 * bfhi(a2.w);
        sv[0] = bflo(sg.x); sv[1] = bfhi(sg.x); sv[2] = bflo(sg.y); sv[3] = bfhi(sg.y); sv[4] = bflo(sg.z); sv[5] = bfhi(sg.z); sv[6] = bflo(sg.w); sv[7] = bfhi(sg.w);
        float sa = 0.f, ss = 0.f;
#pragma unroll
        for (int e = 0; e < 8; ++e) { sa += o[e] * o[e]; ss += sv[e] * sv[e]; }
        const float ra = 1.0f / sqrtf(wave_sum(sa) * (1.0f / AW) + EPS), rs = 1.0f / sqrtf(wave_sum(ss) * (1.0f / SW) + EPS);
        v4u oa, os;
        oa.x = pk2(o[0] * ra, o[1] * ra); oa.y = pk2(o[2] * ra, o[3] * ra); oa.z = pk2(o[4] * ra, o[5] * ra); oa.w = pk2(o[6] * ra, o[7] * ra);
        os.x = pk2(sv[0] * rs, sv[1] * rs); os.y = pk2(sv[2] * rs, sv[3] * rs); os.z = pk2(sv[4] * rs, sv[5] * rs); os.w = pk2(sv[6] * rs, sv[7] * rs);
        *((GAS v4u*)(GR + (size_t)m * DM) + lane) = oa; *((GAS v4u*)(GR + (size_t)m * DM + AW) + lane) = os;
    }
}

__device__ __forceinline__ void rowpass_mix(Frame& F, const Args& A) {
    const float* MIX = (const float*)(F.ws + WS_MIXED); float* H1 = (float*)(F.ws + WS_H1); bf16* FB = (bf16*)(F.ws + WS_XN);
    const float* gpost = arg_in(11);
    const int gw = F.vcu * NWAVES + F.wave, NGW = F.G * NWAVES, lane = pg8::lane_id_asm();
    f32x4 gv[4];
#pragma unroll
    for (int j = 0; j < 4; ++j) gv[j] = *((const GAS f32x4*)gpost + lane + 64 * j);
    for (int m = gw; m < MTOK; m += NGW) {
        const GAS f32x4* mr = (const GAS f32x4*)(MIX + (size_t)m * DM) + lane; const GAS f32x4* xr = (const GAS f32x4*)(arg_in(0) + (size_t)m * DM) + lane;
        f32x4 v[4], xv[4]; float s = 0.f;
#pragma unroll
        for (int j = 0; j < 4; ++j) { v[j] = mr[64 * j]; xv[j] = xr[64 * j]; s += (v[j].x * v[j].x + v[j].y * v[j].y) + (v[j].z * v[j].z + v[j].w * v[j].w); }
        const float r1 = 1.0f / sqrtf(wave_sum(s) * (1.0f / DM) + EPS); float s2 = 0.f;
        GAS f32x4* hr = (GAS f32x4*)(H1 + (size_t)m * DM) + lane;
#pragma unroll
        for (int j = 0; j < 4; ++j) { v[j] = xv[j] + v[j] * r1 * gv[j]; hr[64 * j] = v[j]; s2 += (v[j].x * v[j].x + v[j].y * v[j].y) + (v[j].z * v[j].z + v[j].w * v[j].w); }
        const float r2 = 1.0f / sqrtf(wave_sum(s2) * (1.0f / DM) + EPS);
        GAS v2u* o8 = (GAS v2u*)(FB + (size_t)m * DM) + lane;
#pragma unroll
        for (int j = 0; j < 4; ++j) { v2u o; o.x = pk2(v[j].x * r2, v[j].y * r2); o.y = pk2(v[j].z * r2, v[j].w * r2); o8[64 * j] = o; }
    }
}
__device__ __forceinline__ void rowpass_ffn(Frame& F, const Args& A) {
    const float* Y = F.out; float* H1 = (float*)(F.ws + WS_H1); bf16* HB = (bf16*)(F.ws + WS_XN);
    const float* gpost = arg_in(15);
    const int gw = F.vcu * NWAVES + F.wave, NGW = F.G * NWAVES, lane = pg8::lane_id_asm();
    f32x4 gv[4];
#pragma unroll
    for (int j = 0; j < 4; ++j) gv[j] = *((const GAS f32x4*)gpost + lane + 64 * j);
    for (int m = gw; m < MTOK; m += NGW) {
        const GAS f32x4* yr = (const GAS f32x4*)(Y + (size_t)m * DM) + lane; GAS f32x4* hr = (GAS f32x4*)(H1 + (size_t)m * DM) + lane;
        f32x4 v[4], hv[4]; float s = 0.f;
#pragma unroll
        for (int j = 0; j < 4; ++j) { v[j] = yr[64 * j]; hv[j] = hr[64 * j]; s += (v[j].x * v[j].x + v[j].y * v[j].y) + (v[j].z * v[j].z + v[j].w * v[j].w); }
        const float r1 = 1.0f / sqrtf(wave_sum(s) * (1.0f / DM) + EPS);
        GAS v2u* o8 = (GAS v2u*)(HB + (size_t)m * DM) + lane;
#pragma unroll
        for (int j = 0; j < 4; ++j) { v[j] = hv[j] + v[j] * r1 * gv[j]; hr[64 * j] = v[j]; v2u o; o.x = pk2(v[j].x, v[j].y); o.y = pk2(v[j].z, v[j].w); o8[64 * j] = o; }
    }
}

__device__ __forceinline__ void grid_bar(unsigned* ctr, unsigned target, int wave) {
    asm volatile("s_waitcnt vmcnt(0)" ::: "memory");
    __syncthreads();
    if (wave == 0) {
        if (pg8::lane_id_asm() == 0) {
            __builtin_amdgcn_fence(__ATOMIC_RELEASE, "agent");
            asm volatile("s_waitcnt vmcnt(0)" ::: "memory");
            __hip_atomic_fetch_add(ctr, 1u, __ATOMIC_RELAXED, __HIP_MEMORY_SCOPE_AGENT);
            while (__hip_atomic_load(ctr, __ATOMIC_RELAXED, __HIP_MEMORY_SCOPE_AGENT) < target) __builtin_amdgcn_s_sleep(2);
            __builtin_amdgcn_fence(__ATOMIC_ACQUIRE, "agent");
            asm volatile("s_waitcnt vmcnt(0)" ::: "memory");
        }
    }
    __syncthreads();
}

__global__ void __launch_bounds__(NWAVES * 64, 2) mk_fwd(Args args) {
    extern __shared__ __attribute__((aligned(16))) unsigned char lds_raw[];
    cg::grid_group grid = cg::this_grid();
    Frame F;
    F.lds = (LAS unsigned char*)lds_raw;
    F.wave = __builtin_amdgcn_readfirstlane(threadIdx.x >> 6);
    F.G = gridDim.x; { const int bx = blockIdx.x; F.vcu = (F.G % 8 == 0) ? (bx % 8) * (F.G / 8) + bx / 8 : bx; }
    F.out = args.out; F.ws = args.ws;
#ifndef REPEAT_MASK
#define REPEAT_MASK 0
#endif
#define REPS(k) ((((REPEAT_MASK) >> (k)) & 1) ? 2 : 1)
    unsigned* const bar_ctr = (unsigned*)F.ws;
    unsigned epoch = 0;
#define SEAM() do { ++epoch; if (epoch == 1) grid.sync(); else grid_bar(bar_ctr, (unsigned)F.G * (epoch - 1), F.wave); } while (0)
    const pg8::bf16_t* XN = (const pg8::bf16_t*)(F.ws + WS_XN);

    for (int rep_ = 0; rep_ < REPS(0); ++rep_) { if (blockIdx.x == 0 && threadIdx.x == 0) __hip_atomic_store(bar_ctr, 0u, __ATOMIC_RELAXED, __HIP_MEMORY_SCOPE_AGENT); p0_prologue(F, args); }
    SEAM();
    for (int rep_ = 0; rep_ < REPS(1); ++rep_) {
        { pg8::Gemm g{XN, (const pg8::bf16_t*)(F.ws + WS_W1), MTOK, PC, DM}; pg8::StaticOrder S; S.init(MTOK, PC, F.G, (int)blockIdx.x);
          pg8::EpiBf16M<1> E{(pg8::bf16_t*)(F.ws + WS_PROJ), PC, (const float*)(F.ws + CT_SS0)};
          pg8::gemm_phase<pg8::EpiBf16M<1>, pg8::StaticOrder, true, true>(F.lds, g, S, E, F.wave); }
        { pg8::Gemm g{(const pg8::bf16_t*)(F.ws + WS_PB), (const pg8::bf16_t*)(F.ws + WS_W6), MTOK, DM, PLE}; pg8::StaticOrder S; S.init(MTOK, DM, F.G, (int)blockIdx.x);
          pg8::EpiBf16M<0> E{(pg8::bf16_t*)(F.ws + WS_PE), DM, nullptr};
          pg8::gemm_phase<pg8::EpiBf16M<0>, pg8::StaticOrder, true, true>(F.lds, g, S, E, F.wave); }
    }
    SEAM();
    for (int rep_ = 0; rep_ < REPS(2); ++rep_) {
        { const int per = (ATT_ITEMS + F.G - 1) / F.G; const int f0 = F.vcu * per; int n = ATT_ITEMS - f0; n = n < 0 ? 0 : (n > per ? per : n); if (n > 0) att_phase(F, args, f0, n); }
        __syncthreads();
        { const int per = (SGU_ITEMS + F.G - 1) / F.G; const int f0 = F.vcu * per; int n = SGU_ITEMS - f0; n = n < 0 ? 0 : (n > per ? per : n); if (n > 0) sgu_phase(F, args, f0, n); }
    }
    SEAM();
    for (int rep_ = 0; rep_ < REPS(3); ++rep_) { merge_phase(F, args); }
    SEAM();
    {
        pg8::Gemm g{(const pg8::bf16_t*)(F.ws + WS_GROUPS), (const pg8::bf16_t*)(F.ws + WS_W2), MTOK, DM, DM}; pg8::StaticOrder S; S.init(MTOK, DM, F.G, (int)blockIdx.x);
        pg8::EpiResNorm<true> E{(pg8::bf16_t*)(F.ws + WS_XN), arg_in(11), (float*)(F.ws + CT_SS1), (unsigned*)(F.ws + CT_CNT1), (float*)(F.ws + CT_SS2), DM};
        pg8::gemm_phase<pg8::EpiResNorm<true>, pg8::StaticOrder, true, true>(F.lds, g, S, E, F.wave);
    }
    SEAM();
    for (int rep_ = 0; rep_ < REPS(6); ++rep_) {
        pg8::Gemm g{XN, (const pg8::bf16_t*)(F.ws + WS_W3), MTOK, 2 * DFF, DM}; pg8::StaticOrder S; S.init(MTOK, 2 * DFF, F.G, (int)blockIdx.x);
        pg8::EpiSwiglu E{(pg8::bf16_t*)(F.ws + WS_ACT), DFF, (const float*)(F.ws + CT_SS2)};
        pg8::gemm_phase<pg8::EpiSwiglu, pg8::StaticOrder, true, true>(F.lds, g, S, E, F.wave);
    }
    SEAM();
    {
        pg8::Gemm g{(const pg8::bf16_t*)(F.ws + WS_ACT), (const pg8::bf16_t*)(F.ws + WS_W4), MTOK, DM, DFF}; pg8::StaticOrder S; S.init(MTOK, DM, F.G, (int)blockIdx.x);
        pg8::EpiResNorm<false> E{(pg8::bf16_t*)(F.ws + WS_XN), arg_in(15), (float*)(F.ws + CT_SS3), (unsigned*)(F.ws + CT_CNT3), nullptr, DM};
        pg8::gemm_phase<pg8::EpiResNorm<false>, pg8::StaticOrder, true, true>(F.lds, g, S, E, F.wave);
    }
    SEAM();
    for (int rep_ = 0; rep_ < REPS(9); ++rep_) {
        pg8::Gemm g{XN, (const pg8::bf16_t*)(F.ws + WS_W5), MTOK, DM, DM}; pg8::StaticOrder S; S.init(MTOK, DM, F.G, (int)blockIdx.x);
        pg8::EpiFinal E{XN, (const pg8::bf16_t*)(F.ws + WS_PE), arg_in(17), F.out, DM};
        pg8::gemm_phase<pg8::EpiFinal, pg8::StaticOrder, true, true>(F.lds, g, S, E, F.wave);
    }
#undef SEAM
}

extern "C" void kernel_launch(void* const* d_in, const int* in_sizes, int n_in, void* d_out, int out_size, void* d_ws, size_t ws_size, hipStream_t stream) {
    static int grid = 0;
    if (grid == 0) {
        if (n_in != 19 || in_sizes[0] != MTOK * DM || out_size != MTOK * DM || ws_size < WS_END) { fprintf(stderr, "kernel_launch: unexpected shapes (n_in %d, in0 %d, out %d, ws %zu); nothing launched\n", n_in, n_in > 0 ? in_sizes[0] : -1, out_size, ws_size); grid = -1; return; }
        int dev = 0, cus = 0, per_cu = 0;
        if (hipGetDevice(&dev) != hipSuccess || hipDeviceGetAttribute(&cus, hipDeviceAttributeMultiprocessorCount, dev) != hipSuccess) { grid = -1; return; }
        if (hipFuncSetAttribute((const void*)mk_fwd, hipFuncAttributeMaxDynamicSharedMemorySize, LDS_BYTES) != hipSuccess) { fprintf(stderr, "kernel_launch: hipFuncSetAttribute failed\n"); grid = -1; return; }
        if (hipOccupancyMaxActiveBlocksPerMultiprocessor(&per_cu, (const void*)mk_fwd, NWAVES * 64, LDS_BYTES) != hipSuccess || per_cu < 1) { fprintf(stderr, "kernel_launch: occupancy query says %d\n", per_cu); per_cu = 1; }
        (void)hipGetLastError();
        grid = cus;
    }
    if (grid < 0) return;
    Args a{};
    for (int i = 0; i < 19; ++i) a.in[i] = (const float*)d_in[i];
    a.out = (float*)d_out; a.ws = (unsigned char*)d_ws;
    a.ph_lo = 0; a.ph_hi = N_PHASES;
    void* params[] = {&a};
    hipError_t e = hipLaunchCooperativeKernel((const void*)mk_fwd, dim3(grid), dim3(NWAVES * 64), params, LDS_BYTES, stream);
    if (e != hipSuccess) fprintf(stderr, "kernel_launch: cooperative launch failed: %s (grid %d)\n", hipGetErrorString(e), grid);
}
```

```cpp
#include <hip/hip_runtime.h>
#include <hip/hip_cooperative_groups.h>
#include <cstdio>
#include <cstdint>
namespace cg = cooperative_groups;
namespace pg8 {
#define PG8_LAS __attribute__((address_space(3)))
typedef unsigned short bf16_t;
typedef short bf16x8 __attribute__((ext_vector_type(8)));
typedef float f32x4 __attribute__((ext_vector_type(4)));
typedef unsigned u32x4 __attribute__((ext_vector_type(4)));
constexpr int BM = 256, BK = 64, HALF = 128, HTB = HALF * BK * 2  , STAGE_BYTES = 8 * HTB, NXCD = 8, WGM = 8;

__host__ __device__ __forceinline__ int lds_byte(int r, int c) { const int st = (r >> 4) * 2 + (c >> 5), rr = r & 15, cc = c & 31, ob = rr * 64 + cc * 2; return st * 1024 + (ob ^ (((ob >> 9) & 1) << 5)); }
__host__ __device__ __forceinline__ void stage_rc(int b, int& R, int& C) { const int st = b / 1024, sb = b % 1024, swz = sb ^ (((sb >> 9) & 1) << 5); R = (st >> 1) * 16 + swz / 64; C = (st & 1) * 32 + (swz % 64) / 2; }
__host__ __device__ __forceinline__ int perm32(int rho) { const int n = rho >> 4, i = rho & 15; return 8 * (i >> 2) + 4 * n + (i & 3); }

struct Unit { int pm, pn; };
struct Gemm { const bf16_t* A; const bf16_t* Bt; int M, N, K; };

struct StaticOrder {
    int nM, nN, nwg, G, c;
    __host__ __device__ void init(int M, int N, int G_, int c_) { nM = M / BM; nN = N / BM; nwg = nM * nN; G = G_; c = c_; }
    __host__ __device__ bool next(int i, Unit& u) const {
        const long L = (long)i * G + c; if (L >= nwg) return false;
        int wgid = (int)L; { const int q = nwg / NXCD, r = nwg % NXCD, xcd = wgid % NXCD, off = wgid / NXCD; wgid = (xcd < r ? xcd * (q + 1) : r * (q + 1) + (xcd - r) * q) + off; }
        const int nig = WGM * nN, gid = wgid / nig, fm = gid * WGM, gsz = (nM - fm) < WGM ? (nM - fm) : WGM;
        u.pm = fm + ((wgid % nig) % gsz); u.pn = (wgid % nig) / gsz; return true;
    }
    __device__ __forceinline__ void a_ready(const Unit&) const {}
    __device__ __forceinline__ void done(const Unit&) const {}
};

__device__ __forceinline__ unsigned cvt_pk_bf16(float lo, float hi) { unsigned r; asm volatile("v_cvt_pk_bf16_f32 %0, %1, %2" : "=v"(r) : "v"(lo), "v"(hi)); return r; }
typedef unsigned u32x2 __attribute__((ext_vector_type(2)));
__device__ __forceinline__ int lane_id_asm() { int l; asm volatile("v_mbcnt_lo_u32_b32 %0, -1, 0\n\tv_mbcnt_hi_u32_b32 %0, -1, %0" : "=v"(l)); return l; }
__device__ __forceinline__ float gelu_tanh(float x) {
    const float u = 0.7978845608028654f * (x + 0.044715f * x * x * x);
    const float e = __builtin_amdgcn_exp2f(-2.885390081777927f * u);
    return x * __builtin_amdgcn_rcpf(1.0f + e);
}
__device__ __forceinline__ float sigmoid_f(float x) { return __builtin_amdgcn_rcpf(1.0f + __builtin_amdgcn_exp2f(-1.4426950408889634f * x)); }

template <int MODE> struct EpiBf16M {
    static constexpr bool PERM = true, AFTER_DRAIN = false;
    bf16_t* O; int ldc; const float* ss;
    __device__ __forceinline__ void operator()(const f32x4 (&acc)[2][2][4][2], const Unit& u, int wr, int wc, int fr, int fq) const {
        const int row0 = u.pm * BM + wr * 64 + fr, col0 = u.pn * BM + wc * 32 + 8 * fq;
        const int mode = (MODE == 1) ? (u.pn < 2 ? 1 : (u.pn >= 6 ? 2 : 0)) : 0;
#pragma unroll
        for (int ai = 0; ai < 2; ++ai)
#pragma unroll
            for (int m = 0; m < 4; ++m) { const int row = row0 + ai * HALF + m * 16; bf16_t* rowp = O + (size_t)row * ldc + col0;
                float rs = 1.0f;
                if (MODE == 1) { rs = 1.0f / sqrtf(ss[row] * (1.0f / 1024.0f) + 1e-6f); if (mode == 1) rs *= 0.125f; }
#pragma unroll
                for (int bj = 0; bj < 2; ++bj) { f32x4 v0 = acc[ai][bj][m][0], v1 = acc[ai][bj][m][1];
                    if (MODE == 1) { v0 = v0 * rs; v1 = v1 * rs; }
                    if (false) { }
                    else if (mode == 2) {
#pragma unroll
                        for (int e = 0; e < 4; ++e) { v0[e] = gelu_tanh(v0[e]); v1[e] = gelu_tanh(v1[e]); } }
                    u32x4 w; w.x = cvt_pk_bf16(v0[0], v0[1]); w.y = cvt_pk_bf16(v0[2], v0[3]); w.z = cvt_pk_bf16(v1[0], v1[1]); w.w = cvt_pk_bf16(v1[2], v1[3]);
                    *(u32x4*)(rowp + bj * HALF) = w; } }
    }
};
struct EpiSwiglu {
    static constexpr bool PERM = true, AFTER_DRAIN = false;
    bf16_t* O; int ldc; const float* ss;
    __device__ __forceinline__ void operator()(const f32x4 (&acc)[2][2][4][2], const Unit& u, int wr, int wc, int fr, int fq) const {
        const int row0 = u.pm * BM + wr * 64 + fr, col0 = u.pn * HALF + wc * 32 + 8 * fq;
#pragma unroll
        for (int ai = 0; ai < 2; ++ai)
#pragma unroll
            for (int m = 0; m < 4; ++m) { const int row = row0 + ai * HALF + m * 16; bf16_t* rowp = O + (size_t)row * ldc + col0;
                const float r2 = 1.0f / sqrtf(ss[row] * (1.0f / 1024.0f) + 1e-6f);
                f32x4 r0, r1;
#pragma unroll
                for (int e = 0; e < 4; ++e) { const float g0 = acc[ai][0][m][0][e] * r2, g1 = acc[ai][0][m][1][e] * r2;
                    r0[e] = g0 * sigmoid_f(g0) * (acc[ai][1][m][0][e] * r2); r1[e] = g1 * sigmoid_f(g1) * (acc[ai][1][m][1][e] * r2); }
                u32x4 w; w.x = cvt_pk_bf16(r0[0], r0[1]); w.y = cvt_pk_bf16(r0[2], r0[3]); w.z = cvt_pk_bf16(r1[0], r1[1]); w.w = cvt_pk_bf16(r1[2], r1[3]);
                *(u32x4*)rowp = w; }
    }
};
template <bool SS2> struct EpiResNorm {
    static constexpr bool PERM = false, AFTER_DRAIN = false;
    bf16_t* HB; const float* gain; float* ss1; unsigned* cnt; float* ss2; int ldc;
    __device__ __forceinline__ void operator()(f32x4 (&acc)[2][2][4][2], const Unit& u, int wr, int wc, int fr, int fq) const {
        const int row0 = u.pm * BM + wr * 64 + fr, col0 = u.pn * BM + wc * 32 + 4 * fq;
        u32x2 pre[4][2][2];
#pragma unroll
        for (int m = 0; m < 4; ++m)
#pragma unroll
            for (int bj = 0; bj < 2; ++bj)
#pragma unroll
                for (int n = 0; n < 2; ++n) pre[m][bj][n] = *(const u32x2*)(HB + (size_t)(row0 + m * 16) * ldc + col0 + bj * HALF + n * 16);
#pragma unroll
        for (int ai = 0; ai < 2; ++ai)
#pragma unroll
            for (int m = 0; m < 4; ++m) { float q = 0.f;
#pragma unroll
                for (int bj = 0; bj < 2; ++bj)
#pragma unroll
                    for (int n = 0; n < 2; ++n) { const f32x4 x = acc[ai][bj][m][n]; q += (x[0] * x[0] + x[1] * x[1]) + (x[2] * x[2] + x[3] * x[3]); }
                q += __shfl_xor(q, 16); q += __shfl_xor(q, 32);
                if (fq == 0) unsafeAtomicAdd(ss1 + row0 + ai * HALF + m * 16, q); }
        asm volatile("s_waitcnt vmcnt(0)" ::: "memory");
        unsigned* c = cnt + 64 * u.pm;
        if (fr == 0 && fq == 0) __hip_atomic_fetch_add(c, 1u, __ATOMIC_RELAXED, __HIP_MEMORY_SCOPE_AGENT);
        f32x4 gv[2][2];
#pragma unroll
        for (int bj = 0; bj < 2; ++bj)
#pragma unroll
            for (int n = 0; n < 2; ++n) gv[bj][n] = *(const f32x4*)(gain + col0 + bj * HALF + n * 16);
        while (__hip_atomic_load(c, __ATOMIC_RELAXED, __HIP_MEMORY_SCOPE_AGENT) < 32u) __builtin_amdgcn_s_sleep(1);
        asm volatile("" ::: "memory");
        float r1[2][4];
#pragma unroll
        for (int ai = 0; ai < 2; ++ai)
#pragma unroll
            for (int m = 0; m < 4; ++m) r1[ai][m] = __hip_atomic_load(ss1 + row0 + ai * HALF + m * 16, __ATOMIC_RELAXED, __HIP_MEMORY_SCOPE_AGENT);
#pragma unroll
        for (int ai = 0; ai < 2; ++ai)
#pragma unroll
            for (int m = 0; m < 4; ++m) { const int row = row0 + ai * HALF + m * 16; const size_t off = (size_t)row * ldc + col0;
                const float rr = 1.0f / sqrtf(r1[ai][m] * (1.0f / 1024.0f) + 1e-6f);
                float q2 = 0.f;
#pragma unroll
                for (int bj = 0; bj < 2; ++bj)
#pragma unroll
                    for (int n = 0; n < 2; ++n) { const size_t o2 = off + bj * HALF + n * 16;
                        const u32x2 pw = (ai == 0) ? pre[m][bj][n] : *(const u32x2*)(HB + o2);
                        f32x4 b; b[0] = __uint_as_float(pw.x << 16); b[1] = __uint_as_float(pw.x & 0xffff0000u); b[2] = __uint_as_float(pw.y << 16); b[3] = __uint_as_float(pw.y & 0xffff0000u);
                        const f32x4 h = b + acc[ai][bj][m][n] * rr * gv[bj][n];
                        u32x2 w; w.x = cvt_pk_bf16(h[0], h[1]); w.y = cvt_pk_bf16(h[2], h[3]); *(u32x2*)(HB + o2) = w;
                        if (SS2) q2 += (h[0] * h[0] + h[1] * h[1]) + (h[2] * h[2] + h[3] * h[3]); }
                if (SS2) { q2 += __shfl_xor(q2, 16); q2 += __shfl_xor(q2, 32); if (fq == 0) unsafeAtomicAdd(ss2 + row, q2); }
                if (m & 1) asm volatile("" ::: "memory"); }
    }
};
struct EpiF32 {
    static constexpr bool PERM = false, AFTER_DRAIN = false;
    float* O; int ldc;
    __device__ __forceinline__ void operator()(const f32x4 (&acc)[2][2][4][2], const Unit& u, int wr, int wc, int fr, int fq) const {
        const int row0 = u.pm * BM + wr * 64 + fr, col0 = u.pn * BM + wc * 32 + 4 * fq;
#pragma unroll
        for (int ai = 0; ai < 2; ++ai)
#pragma unroll
            for (int m = 0; m < 4; ++m) { float* rowp = O + (size_t)(row0 + ai * HALF + m * 16) * ldc + col0;
#pragma unroll
                for (int bj = 0; bj < 2; ++bj)
#pragma unroll
                    for (int n = 0; n < 2; ++n) *(f32x4*)(rowp + bj * HALF + n * 16) = acc[ai][bj][m][n]; }
    }
};
struct EpiFinal {
    static constexpr bool PERM = false, AFTER_DRAIN = false;
    const bf16_t* H2; const bf16_t* PE; const float* bias; float* O; int ldc;
    __device__ __forceinline__ void operator()(const f32x4 (&acc)[2][2][4][2], const Unit& u, int wr, int wc, int fr, int fq) const {
        const int row0 = u.pm * BM + wr * 64 + fr, col0 = u.pn * BM + wc * 32 + 4 * fq;
        f32x4 bv[2][2];
#pragma unroll
        for (int bj = 0; bj < 2; ++bj)
#pragma unroll
            for (int n = 0; n < 2; ++n) bv[bj][n] = *(const f32x4*)(bias + col0 + bj * HALF + n * 16);
#pragma unroll
        for (int ai = 0; ai < 2; ++ai)
#pragma unroll
            for (int m = 0; m < 4; ++m) { const size_t off = (size_t)(row0 + ai * HALF + m * 16) * ldc + col0;
#pragma unroll
                for (int bj = 0; bj < 2; ++bj)
#pragma unroll
                    for (int n = 0; n < 2; ++n) { const size_t o2 = off + bj * HALF + n * 16;
                        const u32x2 hw = *(const u32x2*)(H2 + o2); const u32x2 pw = *(const u32x2*)(PE + o2);
                        f32x4 h; h[0] = __uint_as_float(hw.x << 16); h[1] = __uint_as_float(hw.x & 0xffff0000u); h[2] = __uint_as_float(hw.y << 16); h[3] = __uint_as_float(hw.y & 0xffff0000u);
                        f32x4 pe; pe[0] = __uint_as_float(pw.x << 16); pe[1] = __uint_as_float(pw.x & 0xffff0000u); pe[2] = __uint_as_float(pw.y << 16); pe[3] = __uint_as_float(pw.y & 0xffff0000u);
                        const f32x4 a = acc[ai][bj][m][n] + bv[bj][n]; f32x4 o;
#pragma unroll
                        for (int e = 0; e < 4; ++e) o[e] = h[e] + sigmoid_f(a[e]) * pe[e];
                        *(f32x4*)(O + o2) = o; } }
    }
};

template <class Epi, class Sched, bool ALIGN_EPI = false, bool SP2 = false>
__device__ __forceinline__ void gemm_phase(PG8_LAS unsigned char* lds, const Gemm g, const Sched& S, const Epi& E, const int wave_id) {
    const int wid = wave_id, lane = lane_id_asm(), tid = wid * 64 + lane, wr = wid >> 2, wc = wid & 3, fr = lane & 15, fq = lane >> 4;
    const int K = g.K, nt = K / BK;
    unsigned voffA[2], voffB[2];
#pragma unroll
    for (int i = 0; i < 2; ++i) { int R, C; stage_rc(tid * 16 + i * 8192, R, C); const int Rb = Epi::PERM ? ((R & ~31) + perm32(R & 31)) : R;
        voffA[i] = (unsigned)(R * K + C) * 2u; voffB[i] = (unsigned)(Rb * K + C) * 2u; }
    const size_t kstep = (size_t)(BK * 2);
    const size_t hstep = (size_t)HALF * K * 2;
    const size_t tstep = 2 * hstep;
    const unsigned ldsw = (unsigned)wid * 1024u;
    const int aoff = lds_byte(wr * 64 + fr, fq * 8), boff = lds_byte(wc * 32 + fr, fq * 8);
#define PG8_SA(b, h) (((b) * 2 + (h)) * HTB)
#define PG8_SB(b, h) ((4 + (b) * 2 + (h)) * HTB)
#define PG8_STAGE(bufoff, gbase, voff) do { _Pragma("unroll") for (int _i = 0; _i < 2; ++_i) \
        __builtin_amdgcn_global_load_lds((const unsigned*)((const char*)(gbase) + (voff)[_i]), (PG8_LAS unsigned*)(lds + (bufoff) + ldsw + _i * 8192), 16, 0, 0); } while (0)
#define PG8_LDA(dst, b, h) do { _Pragma("unroll") for (int m = 0; m < 4; ++m) _Pragma("unroll") for (int k = 0; k < 2; ++k) dst[m][k] = *(const PG8_LAS bf16x8*)(lds + PG8_SA(b, h) + aoff + m * 2048 + k * 1024); } while (0)
#define PG8_LDB(dst, b, h) do { _Pragma("unroll") for (int n = 0; n < 2; ++n) _Pragma("unroll") for (int k = 0; k < 2; ++k) dst[n][k] = *(const PG8_LAS bf16x8*)(lds + PG8_SB(b, h) + boff + n * 2048 + k * 1024); } while (0)
#define PG8_MMA(ai, bj, At, Bt) do { __builtin_amdgcn_s_setprio(1); _Pragma("unroll") for (int m = 0; m < 4; ++m) _Pragma("unroll") for (int n = 0; n < 2; ++n) _Pragma("unroll") for (int k = 0; k < 2; ++k) \
        acc[ai][bj][m][n] = __builtin_amdgcn_mfma_f32_16x16x32_bf16(Bt[n][k], At[m][k], acc[ai][bj][m][n], 0, 0, 0); __builtin_amdgcn_s_setprio(0); } while (0)
#define PG8_WAIT_V(n) asm volatile("s_waitcnt vmcnt(" #n ")" ::: "memory")
#define PG8_WAIT_L(n) asm volatile("s_waitcnt lgkmcnt(" #n ")" ::: "memory")
#define PG8_BAR __builtin_amdgcn_s_barrier()
#define PG8_SCHED __builtin_amdgcn_sched_barrier(0)
    Unit cur, nxt; int ui = 0;
    if (!S.next(0, cur)) return;
    f32x4 acc[2][2][4][2];
#pragma unroll
    for (int a = 0; a < 2; ++a)
#pragma unroll
        for (int b = 0; b < 2; ++b)
#pragma unroll
            for (int m = 0; m < 4; ++m)
#pragma unroll
                for (int n = 0; n < 2; ++n) acc[a][b][m][n] = (f32x4){0.f, 0.f, 0.f, 0.f};
    bf16x8 At[4][2], B0[2][2], B1[2][2];
    const char* cA = (const char*)g.A + (size_t)cur.pm * tstep; const char* cB = (const char*)g.Bt + (size_t)cur.pn * tstep;
    S.a_ready(cur);
    if constexpr (SP2) {
        PG8_STAGE(PG8_SB(0, 0), cB, voffB); PG8_STAGE(PG8_SB(0, 1), cB + hstep, voffB); PG8_STAGE(PG8_SA(0, 0), cA, voffA); PG8_STAGE(PG8_SA(0, 1), cA + hstep, voffA);
        if (wr == 1) PG8_BAR;
        PG8_WAIT_V(2); PG8_BAR;
        PG8_STAGE(PG8_SB(1, 0), cB + kstep, voffB); PG8_STAGE(PG8_SA(1, 0), cA + kstep, voffA); PG8_STAGE(PG8_SB(1, 1), cB + hstep + kstep, voffB);
        PG8_WAIT_V(6); PG8_BAR;
    } else {
        PG8_STAGE(PG8_SB(0, 0), cB, voffB); PG8_STAGE(PG8_SA(0, 0), cA, voffA); PG8_STAGE(PG8_SB(0, 1), cB + hstep, voffB); PG8_STAGE(PG8_SA(0, 1), cA + hstep, voffA);
        if (wr == 1) PG8_BAR;
        PG8_WAIT_V(4); PG8_BAR;
        PG8_STAGE(PG8_SB(1, 0), cB + kstep, voffB); PG8_STAGE(PG8_SA(1, 0), cA + kstep, voffA); PG8_STAGE(PG8_SB(1, 1), cB + hstep + kstep, voffB);
        PG8_WAIT_V(6); PG8_BAR;
    }
    for (;;) {
        const bool has_next = S.next(ui + 1, nxt);
        const char* nA = has_next ? (const char*)g.A + (size_t)nxt.pm * tstep : cA; const char* nB = has_next ? (const char*)g.Bt + (size_t)nxt.pn * tstep : cB;
        for (int t = 0; t < nt; t += 2) {
            const bool last = (t == nt - 2);
            const char* a1 = cA + (size_t)(t + 1) * kstep;
            const char* a2 = last ? nA : cA + (size_t)(t + 2) * kstep; const char* b2 = last ? nB : cB + (size_t)(t + 2) * kstep;
            const char* a3 = a2 + kstep; const char* b3 = b2 + kstep;
            if (last && has_next) S.a_ready(nxt);
            if constexpr (SP2) {
            PG8_LDB(B0, 0, 0); PG8_LDB(B1, 0, 1); PG8_SCHED; PG8_LDA(At, 0, 0); PG8_STAGE(PG8_SA(1, 1), a1 + hstep, voffA);
            PG8_WAIT_V(8); PG8_WAIT_L(0); PG8_BAR; PG8_MMA(0, 0, At, B0); PG8_MMA(0, 1, At, B1); PG8_BAR; PG8_SCHED;
            PG8_LDA(At, 0, 1); PG8_STAGE(PG8_SB(0, 0), b2, voffB); PG8_STAGE(PG8_SB(0, 1), b2 + hstep, voffB); PG8_STAGE(PG8_SA(0, 0), a2, voffA);
            PG8_WAIT_V(8); PG8_WAIT_L(0); PG8_BAR; PG8_MMA(1, 0, At, B0); PG8_MMA(1, 1, At, B1); PG8_BAR; PG8_SCHED;
            PG8_LDB(B0, 1, 0); PG8_LDB(B1, 1, 1); PG8_SCHED; PG8_LDA(At, 1, 0); PG8_STAGE(PG8_SA(0, 1), a2 + hstep, voffA);
            PG8_WAIT_V(8); PG8_WAIT_L(0); PG8_BAR; PG8_MMA(0, 0, At, B0); PG8_MMA(0, 1, At, B1); PG8_BAR; PG8_SCHED;
            PG8_LDA(At, 1, 1); PG8_STAGE(PG8_SB(1, 0), b3, voffB); PG8_STAGE(PG8_SB(1, 1), b3 + hstep, voffB); PG8_STAGE(PG8_SA(1, 0), a3, voffA);
            PG8_WAIT_V(8); PG8_WAIT_L(0); PG8_BAR; PG8_MMA(1, 0, At, B0); PG8_MMA(1, 1, At, B1); PG8_BAR; PG8_SCHED;
            } else {
            PG8_LDB(B0, 0, 0); PG8_SCHED; PG8_LDA(At, 0, 0); PG8_STAGE(PG8_SA(1, 1), a1 + hstep, voffA);
            PG8_WAIT_L(8); PG8_BAR; PG8_WAIT_L(0); PG8_MMA(0, 0, At, B0); PG8_BAR; PG8_SCHED;
            PG8_LDB(B1, 0, 1); PG8_STAGE(PG8_SB(0, 0), b2, voffB);
            PG8_BAR; PG8_WAIT_L(0); PG8_MMA(0, 1, At, B1); PG8_BAR;
            PG8_LDA(At, 0, 1); PG8_STAGE(PG8_SA(0, 0), a2, voffA);
            PG8_BAR; PG8_WAIT_L(0); PG8_MMA(1, 0, At, B0); PG8_BAR; PG8_SCHED;
            PG8_STAGE(PG8_SB(0, 1), b2 + hstep, voffB);
            PG8_WAIT_V(6); PG8_BAR; PG8_MMA(1, 1, At, B1); PG8_BAR;
            PG8_LDB(B0, 1, 0); PG8_SCHED; PG8_LDA(At, 1, 0); PG8_STAGE(PG8_SA(0, 1), a2 + hstep, voffA);
            PG8_WAIT_L(8); PG8_BAR; PG8_WAIT_L(0); PG8_MMA(0, 0, At, B0); PG8_BAR; PG8_SCHED;
            PG8_LDB(B1, 1, 1); PG8_STAGE(PG8_SB(1, 0), b3, voffB);
            PG8_BAR; PG8_WAIT_L(0); PG8_MMA(0, 1, At, B1); PG8_BAR;
            PG8_LDA(At, 1, 1); PG8_STAGE(PG8_SA(1, 0), a3, voffA);
            PG8_BAR; PG8_WAIT_L(0); PG8_MMA(1, 0, At, B0); PG8_BAR; PG8_SCHED;
            PG8_STAGE(PG8_SB(1, 1), b3 + hstep, voffB);
            PG8_WAIT_V(6); PG8_BAR; PG8_MMA(1, 1, At, B1); PG8_BAR;
            }
        }
        if constexpr (ALIGN_EPI) { if (wr == 0) PG8_BAR; }
        if constexpr (!Epi::AFTER_DRAIN) { E(acc, cur, wr, wc, fr, fq); S.done(cur); }
        if (!has_next) break;
#pragma unroll
        for (int a = 0; a < 2; ++a)
#pragma unroll
            for (int b = 0; b < 2; ++b)
#pragma unroll
                for (int m = 0; m < 4; ++m)
#pragma unroll
                    for (int n = 0; n < 2; ++n) acc[a][b][m][n] = (f32x4){0.f, 0.f, 0.f, 0.f};
        cur = nxt; cA = nA; cB = nB; ++ui;
        if constexpr (ALIGN_EPI) { if (wr == 1) PG8_BAR; }
    }
    PG8_WAIT_V(0);
    if constexpr (!ALIGN_EPI) { if (wr == 0) PG8_BAR; }
    PG8_BAR;
    if constexpr (Epi::AFTER_DRAIN) { E.fused(acc, cur, wr, wc, fr, fq, lds, wid, lane); S.done(cur); }
#undef PG8_SA
#undef PG8_SB
#undef PG8_STAGE
#undef PG8_LDA
#undef PG8_LDB
#undef PG8_MMA
#undef PG8_WAIT_V
#undef PG8_WAIT_L
#undef PG8_BAR
#undef PG8_SCHED
}
}

constexpr int NWAVES = 8;
constexpr int BATCH = 4, SEQ = 8192, DM = 1024, MTOK = BATCH * SEQ, PLE = 256, AW = 512, SW = 512, HD = 64, NH = 8, NG = 4, GD = 128, CHUNK = 128, DFF = 2816, PC = 2560;
constexpr float EPS = 1e-6f;
#ifndef MK_N_LAUNCHES
#define MK_N_LAUNCHES 1
#endif
constexpr int N_PHASES = 10;

constexpr size_t MiB = 1u << 20;
constexpr size_t WS_W1 = 2 * MiB, WS_W2 = 8 * MiB, WS_W3 = 10 * MiB, WS_W4 = 22 * MiB, WS_W5 = 28 * MiB, WS_W6 = 30 * MiB;
constexpr size_t WS_XN = 32 * MiB;
constexpr size_t WS_PE = 96 * MiB;
constexpr size_t WS_PB = 160 * MiB;
constexpr size_t WS_PROJ = 176 * MiB;
constexpr size_t WS_AO = 336 * MiB;
constexpr size_t WS_LSE = 432 * MiB;
constexpr size_t WS_SG = 436 * MiB;
constexpr size_t WS_GROUPS = 176 * MiB;
constexpr size_t WS_MIXED = 240 * MiB;
constexpr size_t WS_H1 = 368 * MiB;
constexpr size_t WS_ACT = 176 * MiB;
constexpr size_t WS_END = 496 * MiB;
static_assert(WS_ACT + (size_t)MTOK * DFF * 2 <= WS_H1 && WS_MIXED + (size_t)MTOK * DM * 4 <= WS_H1 && WS_H1 + (size_t)MTOK * DM * 4 <= WS_END, "ws map");
static_assert(WS_PROJ + (size_t)MTOK * PC * 2 <= WS_AO && WS_AO + 3 * (size_t)MTOK * AW * 2 <= WS_LSE && WS_SG + (size_t)MTOK * SW * 2 <= WS_END, "ws map 2");

constexpr size_t CT_ZERO_LO = 4096, CT_SS1 = 4096, CT_SS2 = CT_SS1 + 131072, CT_SS3 = CT_SS2 + 131072, CT_CNT1 = 524288, CT_CNT3 = CT_CNT1 + 32768, CT_ZERO_HI = CT_CNT3 + 32768, CT_SS0 = 1048576;
static_assert(CT_SS3 + 131072 <= CT_CNT1 && CT_ZERO_HI <= 2 * MiB && (MTOK / 256) * 256 <= 32768, "control map");
constexpr int RING_BYTES = 131072;
constexpr int LDS_BYTES = 147456;

#define GAS __attribute__((address_space(1)))
#define LAS __attribute__((address_space(3)))
typedef unsigned short bf16;
typedef unsigned v4u __attribute__((ext_vector_type(4)));
typedef unsigned v2u __attribute__((ext_vector_type(2)));
typedef float f32x4 __attribute__((ext_vector_type(4)));
typedef short bf16x8 __attribute__((ext_vector_type(8)));
typedef short v4i16_t __attribute__((ext_vector_type(4)));
typedef float f32x2_t __attribute__((ext_vector_type(2)));
typedef __bf16 bf16x2_t __attribute__((ext_vector_type(2)));
#define LDS_WAIT() asm volatile("s_waitcnt lgkmcnt(0)" ::: "memory")
__device__ __forceinline__ unsigned pk2(float lo, float hi) { f32x2_t v = {lo, hi}; bf16x2_t b = __builtin_convertvector(v, bf16x2_t); return __builtin_bit_cast(unsigned, b); }
__device__ __forceinline__ float bflo(unsigned w) { return __uint_as_float(w << 16); }
__device__ __forceinline__ float bfhi(unsigned w) { return __uint_as_float(w & 0xffff0000u); }
__device__ __forceinline__ float wave_sum(float v) {
#pragma unroll
    for (int o = 1; o < 64; o <<= 1) v += __shfl_xor(v, o);
    return v;
}
__device__ __forceinline__ v4i16_t tr_read(LAS unsigned char* p) { return __builtin_amdgcn_ds_read_tr16_b64_v4i16((LAS v4i16_t*)p); }

struct Args { const float* in[19]; float* out; unsigned char* ws; int ph_lo, ph_hi; };
#define CAS __attribute__((address_space(4)))
__device__ __forceinline__ const float* arg_in(int i) {
    const CAS unsigned char* kp = (const CAS unsigned char*)__builtin_amdgcn_kernarg_segment_ptr();
    asm volatile("" : "+s"(kp));
    typedef const float* cfp_t;
    return *(const CAS cfp_t*)(kp + 8 * i);
}
struct Frame {
    LAS unsigned char* lds;
    int wave, vcu, G;
    float* out; unsigned char* ws;
};

__device__ __forceinline__ void p0_transpose_item(const float* W, int K, int N, bf16* WT, int mode, const float* ks0, const float* ks1, LAS float* scr, int item, int lane) {
    const int nblk = N / 32, kb = item / nblk, nb = item % nblk, k0 = 64 * kb, n0 = 32 * nb;
#pragma unroll 8
    for (int i = 0; i < 32; ++i) { const int kk = 2 * i + (lane >> 5); const int kg = k0 + kk;
        const float sc = ks0 ? (kg < 512 ? ks0[kg] : ks1[kg - 512]) : 1.0f;
        scr[kk * 33 + (lane & 31)] = W[(size_t)kg * N + n0 + (lane & 31)] * sc; }
    LDS_WAIT(); asm volatile("" ::: "memory");
    int d0 = n0;
    if (mode == 1) { d0 = (n0 < DFF) ? ((n0 / 128) * 256 + (n0 % 128)) : (((n0 - DFF) / 128) * 256 + 128 + ((n0 - DFF) % 128)); }
    const int c = lane & 7;
#pragma unroll
    for (int j = 0; j < 4; ++j) { const int n = (lane >> 3) + 8 * j; const LAS float* s = scr + (8 * c) * 33 + n;
        v4u o; o.x = pk2(s[0 * 33], s[1 * 33]); o.y = pk2(s[2 * 33], s[3 * 33]); o.z = pk2(s[4 * 33], s[5 * 33]); o.w = pk2(s[6 * 33], s[7 * 33]);
        *(GAS v4u*)(WT + (size_t)(d0 + n) * K + k0 + 8 * c) = o; }
    LDS_WAIT(); asm volatile("" ::: "memory");
}
__device__ __forceinline__ void p0_prologue(Frame& F, const Args& A) {
    const int lane_ = pg8::lane_id_asm();
    LAS float* scr = (LAS float*)(F.lds + F.wave * 16384);
    const int gw = F.vcu * NWAVES + F.wave, NGW = F.G * NWAVES;
    bf16* W1t = (bf16*)(F.ws + WS_W1); bf16* W2t = (bf16*)(F.ws + WS_W2); bf16* W3t = (bf16*)(F.ws + WS_W3);
    bf16* W4t = (bf16*)(F.ws + WS_W4); bf16* W5t = (bf16*)(F.ws + WS_W5); bf16* W6t = (bf16*)(F.ws + WS_W6);
    constexpr int I1 = (DM / 64) * (PC / 32), I2 = (DM / 64) * (DM / 32), I3 = (DM / 64) * (2 * DFF / 32), I4 = (DFF / 64) * (DM / 32), I5 = I2, I6 = (PLE / 64) * (DM / 32);
    constexpr int NITEMS = I1 + I2 + I3 + I4 + I5 + I6;
    for (int it = gw; it < NITEMS; it += NGW) {
        int r = it;
        if (r < I1) { p0_transpose_item(arg_in(3), DM, PC, W1t, 0, arg_in(2), arg_in(2) + 512, scr, r, lane_); continue; } r -= I1;
        if (r < I2) { p0_transpose_item(arg_in(10), DM, DM, W2t, 0, arg_in(8), arg_in(9), scr, r, lane_); continue; } r -= I2;
        if (r < I3) { p0_transpose_item(arg_in(13), DM, 2 * DFF, W3t, 1, arg_in(12), arg_in(12) + 512, scr, r, lane_); continue; } r -= I3;
        if (r < I4) { p0_transpose_item(arg_in(14), DFF, DM, W4t, 0, nullptr, nullptr, scr, r, lane_); continue; } r -= I4;
        if (r < I5) { p0_transpose_item(arg_in(16), DM, DM, W5t, 0, nullptr, nullptr, scr, r, lane_); continue; } r -= I5;
        p0_transpose_item(arg_in(18), PLE, DM, W6t, 0, nullptr, nullptr, scr, r, lane_);
    }
    { const v4u z = {0u, 0u, 0u, 0u}; GAS v4u* zp = (GAS v4u*)(F.ws + CT_ZERO_LO);
      for (int i = gw * 64 + lane_; i < (int)((CT_ZERO_HI - CT_ZERO_LO) / 16); i += NGW * 64) zp[i] = z; }
    bf16* XN = (bf16*)(F.ws + WS_XN); bf16* PB = (bf16*)(F.ws + WS_PB);
    for (int m = gw; m < MTOK; m += NGW) {
        const GAS f32x4* xr = (const GAS f32x4*)(arg_in(0) + (size_t)m * DM) + lane_;
        f32x4 v[4]; float s = 0.f;
#pragma unroll
        for (int j = 0; j < 4; ++j) { v[j] = xr[64 * j]; s += (v[j].x * v[j].x + v[j].y * v[j].y) + (v[j].z * v[j].z + v[j].w * v[j].w); }
        const f32x4 pv = *((const GAS f32x4*)(arg_in(1) + (size_t)m * PLE) + lane_);
        const float ssum = wave_sum(s);
        if (lane_ == 0) ((float*)(F.ws + CT_SS0))[m] = ssum;
        GAS v2u* o8 = (GAS v2u*)(XN + (size_t)m * DM) + lane_;
#pragma unroll
        for (int j = 0; j < 4; ++j) { v2u o; o.x = pk2(v[j].x, v[j].y); o.y = pk2(v[j].z, v[j].w); o8[64 * j] = o; }
        v2u po; po.x = pk2(pv.x, pv.y); po.y = pk2(pv.z, pv.w);
        *((GAS v2u*)(PB + (size_t)m * PLE) + lane_) = po;
    }
}

constexpr int KP = 144;
constexpr int ATT_LDS_K = 0, ATT_LDS_V = 256 * KP;
constexpr int ATT_ITEMS = 3 * BATCH * NH * 64;
struct AttItem { int br, b, h, d, tok_cur, tok_prev; bool first; };
__device__ __forceinline__ AttItem att_decode(int id) {
    AttItem I; I.br = id / 2048; int rem = id % 2048; I.b = rem / 512; rem %= 512; I.h = rem / 64; const int s = rem % 64;
    I.d = 1 << (2 * I.br); const int nb = 64 >> (2 * I.br); const int r = s / nb, n = s % nb;
    I.first = (n == 0);
    I.tok_cur = I.b * SEQ + r + I.d * (128 * n); I.tok_prev = I.first ? I.tok_cur : I.tok_cur - I.d * 128;
    return I;
}
__device__ __forceinline__ void att_load(const AttItem& I, const bf16* PROJ, int tid, v4u (&kr)[4], v4u (&vr)[4]) {
#pragma unroll
    for (int i = 0; i < 4; ++i) { const int c = tid + 512 * i, row = c >> 3, ch = c & 7;
        const int tok = (row < 128) ? (I.tok_prev + I.d * row) : (I.tok_cur + I.d * (row - 128));
        const bf16* src = PROJ + (size_t)tok * PC + AW + I.h * HD + ch * 8;
        kr[i] = *(const GAS v4u*)src; vr[i] = *(const GAS v4u*)(src + AW); }
}
__device__ __forceinline__ void att_phase(Frame& F, const Args& A, int first_item, int n_items) {
    const bf16* PROJ = (const bf16*)(F.ws + WS_PROJ);
    bf16* AO = (bf16*)(F.ws + WS_AO); float* LSE = (float*)(F.ws + WS_LSE);
    LAS unsigned char* lds = F.lds;
    const int lane = pg8::lane_id_asm(), w = F.wave, tid = w * 64 + lane, l15 = lane & 15, fq = lane >> 4;
    v4u kr[4], vr[4]; bf16x8 qn0, qn1;
    AttItem I = att_decode(first_item);
    att_load(I, PROJ, tid, kr, vr);
    { const bf16* qp = PROJ + (size_t)(I.tok_cur + I.d * (16 * w + l15)) * PC + I.h * HD + 8 * fq; qn0 = *(const GAS bf16x8*)qp; qn1 = *(const GAS bf16x8*)(qp + 32); }
#define LDS_BARRIER() do { asm volatile("s_waitcnt lgkmcnt(0)" ::: "memory"); __builtin_amdgcn_s_barrier(); asm volatile("" ::: "memory"); } while (0)
    for (int it = 0; it < n_items; ++it) {
#pragma unroll
        for (int i = 0; i < 4; ++i) { const int c = tid + 512 * i, row = c >> 3, ch = c & 7;
            *(LAS v4u*)(lds + ATT_LDS_K + row * KP + ch * 16) = kr[i]; *(LAS v4u*)(lds + ATT_LDS_V + row * KP + ch * 16) = vr[i]; }
        const AttItem C = I; const bf16x8 q0 = qn0, q1 = qn1;
        LDS_BARRIER();
        if (it + 1 < n_items) { I = att_decode(first_item + it + 1); att_load(I, PROJ, tid, kr, vr);
            const bf16* qp = PROJ + (size_t)(I.tok_cur + I.d * (16 * w + l15)) * PC + I.h * HD + 8 * fq; qn0 = *(const GAS bf16x8*)qp; qn1 = *(const GAS bf16x8*)(qp + 32); }
        const int qtok = C.tok_cur + C.d * (16 * w + l15);
        f32x4 s[9];
#pragma unroll
        for (int kk = 0; kk < 9; ++kk) {
            LAS unsigned char* kp = lds + ATT_LDS_K + (16 * (w + kk) + l15) * KP + 16 * fq;
            const bf16x8 a0 = *(const LAS bf16x8*)kp, a1 = *(const LAS bf16x8*)(kp + 64);
            f32x4 z = {0.f, 0.f, 0.f, 0.f};
            z = __builtin_amdgcn_mfma_f32_16x16x32_bf16(a0, q0, z, 0, 0, 0);
            s[kk] = __builtin_amdgcn_mfma_f32_16x16x32_bf16(a1, q1, z, 0, 0, 0);
        }
        const float LOG2E = 1.4426950408889634f, NEGBIG = -3.0e38f;
        const float c2 = LOG2E * (float)C.d * __builtin_amdgcn_exp2f(-(float)(C.h + 1));
        const int t = l15 - 4 * fq; const float ft = (float)t;
        float mx = NEGBIG;
#pragma unroll
        for (int kk = 0; kk < 9; ++kk) {
            const bool blk_dead = C.first && (w + kk < 8);
#pragma unroll
            for (int j = 0; j < 4; ++j) {
                float v = s[kk][j] * LOG2E - c2 * ((float)(128 - 16 * kk - j) + ft);
                if (kk == 0) v = (t > j) ? NEGBIG : v;
                if (kk == 8) v = (t < j) ? NEGBIG : v;
                v = blk_dead ? NEGBIG : v;
                s[kk][j] = v; mx = fmaxf(mx, v); }
        }
        mx = fmaxf(mx, __shfl_xor(mx, 16)); mx = fmaxf(mx, __shfl_xor(mx, 32));
        float sum = 0.f;
#pragma unroll
        for (int kk = 0; kk < 9; ++kk)
#pragma unroll
            for (int j = 0; j < 4; ++j) { const float p = __builtin_amdgcn_exp2f(s[kk][j] - mx); s[kk][j] = p; sum += p; }
        sum += __shfl_xor(sum, 16); sum += __shfl_xor(sum, 32);
        f32x4 o[4];
#pragma unroll
        for (int d0 = 0; d0 < 4; ++d0) o[d0] = (f32x4){0.f, 0.f, 0.f, 0.f};
#pragma unroll
        for (int pp = 0; pp < 5; ++pp) {
            const int kA = 2 * pp, kB = (pp < 4) ? 2 * pp + 1 : 2 * pp;
            v4u pw; pw.x = pk2(s[kA][0], s[kA][1]); pw.y = pk2(s[kA][2], s[kA][3]);
            if (pp < 4) { pw.z = pk2(s[kB][0], s[kB][1]); pw.w = pk2(s[kB][2], s[kB][3]); } else { pw.z = 0u; pw.w = 0u; }
            const bf16x8 pf = __builtin_bit_cast(bf16x8, pw);
            LAS unsigned char* va = lds + ATT_LDS_V + (16 * (w + kA) + 4 * fq + (l15 >> 2)) * KP + 8 * (l15 & 3);
            LAS unsigned char* vb = lds + ATT_LDS_V + (16 * (w + kB) + 4 * fq + (l15 >> 2)) * KP + 8 * (l15 & 3);
#pragma unroll
            for (int d0 = 0; d0 < 4; ++d0) {
                const v4i16_t lo = tr_read(va + 32 * d0), hi = tr_read(vb + 32 * d0);
                const bf16x8 vf = {lo[0], lo[1], lo[2], lo[3], hi[0], hi[1], hi[2], hi[3]};
                o[d0] = __builtin_amdgcn_mfma_f32_16x16x32_bf16(vf, pf, o[d0], 0, 0, 0);
            }
        }
        const float inv = 1.0f / sum;
        bf16* op = AO + (size_t)C.br * MTOK * AW + (size_t)qtok * AW + C.h * HD + 4 * fq;
#pragma unroll
        for (int d0 = 0; d0 < 4; ++d0) { v2u ow; ow.x = pk2(o[d0][0] * inv, o[d0][1] * inv); ow.y = pk2(o[d0][2] * inv, o[d0][3] * inv); *(GAS v2u*)(op + 16 * d0) = ow; }
        if (fq == 0) LSE[(size_t)C.br * MTOK * NH + (size_t)qtok * NH + C.h] = mx + __builtin_amdgcn_logf(sum);
        LDS_BARRIER();
    }
}

constexpr int ZP = 272;
constexpr int SGU_ITEMS = BATCH * (SEQ / CHUNK) * NG;
__device__ __forceinline__ void sgu_phase(Frame& F, const Args& A, int first_item, int n_items) {
    const bf16* PROJ = (const bf16*)(F.ws + WS_PROJ); bf16* SG = (bf16*)(F.ws + WS_SG);
    const float* lng = arg_in(4); const float* lnb = arg_in(5); const float* wsp = arg_in(6); const float* bsp = arg_in(7);
    LAS unsigned char* lds = F.lds;
    const int lane = pg8::lane_id_asm(), w = F.wave, tid = w * 64 + lane, l15 = lane & 15, fq = lane >> 4;
    const int c8 = tid & 15, i_loc = 16 * w + l15, nks = (w >> 1) + 1;
    const f32x4 g0 = *(const GAS f32x4*)(lng + c8 * 8), g1 = *(const GAS f32x4*)(lng + c8 * 8 + 4), b0 = *(const GAS f32x4*)(lnb + c8 * 8), b1 = *(const GAS f32x4*)(lnb + c8 * 8 + 4);
    v4u zr[4];
    { const int id = first_item, b = id / 256, n = (id % 256) / 4, g = id % 4, t0 = b * SEQ + n * CHUNK;
#pragma unroll
      for (int i = 0; i < 4; ++i) zr[i] = *(const GAS v4u*)(PROJ + (size_t)(t0 + 32 * i + (tid >> 4)) * PC + 2048 + g * GD + c8 * 8); }
    for (int it = 0; it < n_items; ++it) {
        const int id = first_item + it, b = id / 256, n = (id % 256) / 4, g = id % 4;
        const int t0 = b * SEQ + n * CHUNK;
        const float* wrow = wsp + ((size_t)g * CHUNK + i_loc) * CHUNK + 8 * fq;
        f32x4 wa[4], wb[4];
#pragma unroll
        for (int ks = 0; ks < 4; ++ks) if (ks < nks) { wa[ks] = *(const GAS f32x4*)(wrow + 32 * ks); wb[ks] = *(const GAS f32x4*)(wrow + 32 * ks + 4); }
        const bf16* up = PROJ + (size_t)(t0 + i_loc) * PC + 1536 + g * GD + 4 * fq;
        v2u uw[8];
#pragma unroll
        for (int cb = 0; cb < 8; ++cb) uw[cb] = *(const GAS v2u*)(up + 16 * cb);
        const float bs = bsp[g * CHUNK + i_loc];
#pragma unroll
        for (int i = 0; i < 4; ++i) { const int j = 32 * i + (tid >> 4);
            const v4u zw = zr[i];
            float x[8] = {bflo(zw.x), bfhi(zw.x), bflo(zw.y), bfhi(zw.y), bflo(zw.z), bfhi(zw.z), bflo(zw.w), bfhi(zw.w)};
            float s = ((x[0] + x[1]) + (x[2] + x[3])) + ((x[4] + x[5]) + (x[6] + x[7]));
            s += __shfl_xor(s, 1); s += __shfl_xor(s, 2); s += __shfl_xor(s, 4); s += __shfl_xor(s, 8);
            const float mean = s * (1.0f / GD); float q = 0.f;
#pragma unroll
            for (int e = 0; e < 8; ++e) { x[e] -= mean; q += x[e] * x[e]; }
            q += __shfl_xor(q, 1); q += __shfl_xor(q, 2); q += __shfl_xor(q, 4); q += __shfl_xor(q, 8);
            const float rstd = 1.0f / sqrtf(q * (1.0f / GD) + EPS);
            v4u o; o.x = pk2(x[0] * rstd * g0.x + b0.x, x[1] * rstd * g0.y + b0.y); o.y = pk2(x[2] * rstd * g0.z + b0.z, x[3] * rstd * g0.w + b0.w);
            o.z = pk2(x[4] * rstd * g1.x + b1.x, x[5] * rstd * g1.y + b1.y); o.w = pk2(x[6] * rstd * g1.z + b1.z, x[7] * rstd * g1.w + b1.w);
            *(LAS v4u*)(lds + j * ZP + c8 * 16) = o; }
        LDS_BARRIER();
        if (it + 1 < n_items) { const int id2 = id + 1, b2 = id2 / 256, n2 = (id2 % 256) / 4, g2 = id2 % 4, t2 = b2 * SEQ + n2 * CHUNK;
#pragma unroll
            for (int i = 0; i < 4; ++i) zr[i] = *(const GAS v4u*)(PROJ + (size_t)(t2 + 32 * i + (tid >> 4)) * PC + 2048 + g2 * GD + c8 * 8); }
        f32x4 acc[8];
#pragma unroll
        for (int cb = 0; cb < 8; ++cb) acc[cb] = (f32x4){0.f, 0.f, 0.f, 0.f};
#pragma unroll
        for (int ks = 0; ks < 4; ++ks) if (ks < nks) {
            const int j0 = 32 * ks + 8 * fq;
            const f32x4 va = wa[ks], vb = wb[ks];
            v4u ww; ww.x = pk2(j0 + 0 <= i_loc ? va.x : 0.f, j0 + 1 <= i_loc ? va.y : 0.f); ww.y = pk2(j0 + 2 <= i_loc ? va.z : 0.f, j0 + 3 <= i_loc ? va.w : 0.f);
            ww.z = pk2(j0 + 4 <= i_loc ? vb.x : 0.f, j0 + 5 <= i_loc ? vb.y : 0.f); ww.w = pk2(j0 + 6 <= i_loc ? vb.z : 0.f, j0 + 7 <= i_loc ? vb.w : 0.f);
            const bf16x8 wf = __builtin_bit_cast(bf16x8, ww);
            LAS unsigned char* zp = lds + (32 * ks + 8 * fq + (l15 >> 2)) * ZP + 8 * (l15 & 3);
#pragma unroll
            for (int cb = 0; cb < 8; ++cb) {
                const v4i16_t lo = tr_read(zp + 32 * cb), hi = tr_read(zp + 4 * ZP + 32 * cb);
                const bf16x8 zf = {lo[0], lo[1], lo[2], lo[3], hi[0], hi[1], hi[2], hi[3]};
                acc[cb] = __builtin_amdgcn_mfma_f32_16x16x32_bf16(zf, wf, acc[cb], 0, 0, 0);
            }
        }
        bf16* op = SG + (size_t)(t0 + i_loc) * SW + g * GD + 4 * fq;
#pragma unroll
        for (int cb = 0; cb < 8; ++cb) { const v2u u2 = uw[cb];
            v2u ow; ow.x = pk2(bflo(u2.x) * (acc[cb][0] + bs), bfhi(u2.x) * (acc[cb][1] + bs)); ow.y = pk2(bflo(u2.y) * (acc[cb][2] + bs), bfhi(u2.y) * (acc[cb][3] + bs));
            *(GAS v2u*)(op + 16 * cb) = ow; }
        LDS_BARRIER();
    }
}

__device__ __forceinline__ void merge_phase(Frame& F, const Args& A) {
    const bf16* AO = (const bf16*)(F.ws + WS_AO); const float* LSE = (const float*)(F.ws + WS_LSE); const bf16* SG = (const bf16*)(F.ws + WS_SG);
    bf16* GR = (bf16*)(F.ws + WS_GROUPS);
    const int gw = F.vcu * NWAVES + F.wave, NGW = F.G * NWAVES, lane = pg8::lane_id_asm(), h = lane >> 3;
    for (int m = gw; m < MTOK; m += NGW) {
        float l0 = LSE[(size_t)m * NH + h], l1 = LSE[(size_t)MTOK * NH + (size_t)m * NH + h], l2 = LSE[(size_t)2 * MTOK * NH + (size_t)m * NH + h];
        const v4u a0 = *((const GAS v4u*)(AO + (size_t)m * AW) + lane), a1 = *((const GAS v4u*)(AO + (size_t)MTOK * AW + (size_t)m * AW) + lane), a2 = *((const GAS v4u*)(AO + (size_t)2 * MTOK * AW + (size_t)m * AW) + lane);
        const v4u sg = *((const GAS v4u*)(SG + (size_t)m * SW) + lane);
        const float lm = fmaxf(l0, fmaxf(l1, l2));
        float w0 = __builtin_amdgcn_exp2f(l0 - lm), w1 = __builtin_amdgcn_exp2f(l1 - lm), w2 = __builtin_amdgcn_exp2f(l2 - lm);
        const float wi = 1.0f / (w0 + w1 + w2); w0 *= wi; w1 *= wi; w2 *= wi;
        float o[8], sv[8];
        o[0] = w0 * bflo(a0.x) + w1 * bflo(a1.x) + w2 * bflo(a2.x); o[1] = w0 * bfhi(a0.x) + w1 * bfhi(a1.x) + w2 * bfhi(a2.x);
        o[2] = w0 * bflo(a0.y) + w1 * bflo(a1.y) + w2 * bflo(a2.y); o[3] = w0 * bfhi(a0.y) + w1 * bfhi(a1.y) + w2 * bfhi(a2.y);
        o[4] = w0 * bflo(a0.z) + w1 * bflo(a1.z) + w2 * bflo(a2.z); o[5] = w0 * bfhi(a0.z) + w1 * bfhi(a1.z) + w2 * bfhi(a2.z);
        o[6] = w0 * bflo(a0.w) + w1 * bflo(a1.w) + w2 * bflo(a2.w); o[7] = w0 * bfhi(a0.w) + w1 * bfhi(a1.w) + w2 * bfhi(a2.w);
        sv[0] = bflo(sg.x); sv[1] = bfhi(sg.x); sv[2] = bflo(sg.y); sv[3] = bfhi(sg.y); sv[4] = bflo(sg.z); sv[5] = bfhi(sg.z); sv[6] = bflo(sg.w); sv[7] = bfhi(sg.w);
        float sa = 0.f, ss = 0.f;
#pragma unroll
        for (int e = 0; e < 8; ++e) { sa += o[e] * o[e]; ss += sv[e] * sv[e]; }
        const float ra = 1.0f / sqrtf(wave_sum(sa) * (1.0f / AW) + EPS), rs = 1.0f / sqrtf(wave_sum(ss) * (1.0f / SW) + EPS);
        v4u oa, os;
        oa.x = pk2(o[0] * ra, o[1] * ra); oa.y = pk2(o[2] * ra, o[3] * ra); oa.z = pk2(o[4] * ra, o[5] * ra); oa.w = pk2(o[6] * ra, o[7] * ra);
        os.x = pk2(sv[0] * rs, sv[1] * rs); os.y = pk2(sv[2] * rs, sv[3] * rs); os.z = pk2(sv[4] * rs, sv[5] * rs); os.w = pk2(sv[6] * rs, sv[7] * rs);
        *((GAS v4u*)(GR + (size_t)m * DM) + lane) = oa; *((GAS v4u*)(GR + (size_t)m * DM + AW) + lane) = os;
    }
}

__device__ __forceinline__ void rowpass_mix(Frame& F, const Args& A) {
    const float* MIX = (const float*)(F.ws + WS_MIXED); float* H1 = (float*)(F.ws + WS_H1); bf16* FB = (bf16*)(F.ws + WS_XN);
    const float* gpost = arg_in(11);
    const int gw = F.vcu * NWAVES + F.wave, NGW = F.G * NWAVES, lane = pg8::lane_id_asm();
    f32x4 gv[4];
#pragma unroll
    for (int j = 0; j < 4; ++j) gv[j] = *((const GAS f32x4*)gpost + lane + 64 * j);
    for (int m = gw; m < MTOK; m += NGW) {
        const GAS f32x4* mr = (const GAS f32x4*)(MIX + (size_t)m * DM) + lane; const GAS f32x4* xr = (const GAS f32x4*)(arg_in(0) + (size_t)m * DM) + lane;
        f32x4 v[4], xv[4]; float s = 0.f;
#pragma unroll
        for (int j = 0; j < 4; ++j) { v[j] = mr[64 * j]; xv[j] = xr[64 * j]; s += (v[j].x * v[j].x + v[j].y * v[j].y) + (v[j].z * v[j].z + v[j].w * v[j].w); }
        const float r1 = 1.0f / sqrtf(wave_sum(s) * (1.0f / DM) + EPS); float s2 = 0.f;
        GAS f32x4* hr = (GAS f32x4*)(H1 + (size_t)m * DM) + lane;
#pragma unroll
        for (int j = 0; j < 4; ++j) { v[j] = xv[j] + v[j] * r1 * gv[j]; hr[64 * j] = v[j]; s2 += (v[j].x * v[j].x + v[j].y * v[j].y) + (v[j].z * v[j].z + v[j].w * v[j].w); }
        const float r2 = 1.0f / sqrtf(wave_sum(s2) * (1.0f / DM) + EPS);
        GAS v2u* o8 = (GAS v2u*)(FB + (size_t)m * DM) + lane;
#pragma unroll
        for (int j = 0; j < 4; ++j) { v2u o; o.x = pk2(v[j].x * r2, v[j].y * r2); o.y = pk2(v[j].z * r2, v[j].w * r2); o8[64 * j] = o; }
    }
}
__device__ __forceinline__ void rowpass_ffn(Frame& F, const Args& A) {
    const float* Y = F.out; float* H1 = (float*)(F.ws + WS_H1); bf16* HB = (bf16*)(F.ws + WS_XN);
    const float* gpost = arg_in(15);
    const int gw = F.vcu * NWAVES + F.wave, NGW = F.G * NWAVES, lane = pg8::lane_id_asm();
    f32x4 gv[4];
#pragma unroll
    for (int j = 0; j < 4; ++j) gv[j] = *((const GAS f32x4*)gpost + lane + 64 * j);
    for (int m = gw; m < MTOK; m += NGW) {
        const GAS f32x4* yr = (const GAS f32x4*)(Y + (size_t)m * DM) + lane; GAS f32x4* hr = (GAS f32x4*)(H1 + (size_t)m * DM) + lane;
        f32x4 v[4], hv[4]; float s = 0.f;
#pragma unroll
        for (int j = 0; j < 4; ++j) { v[j] = yr[64 * j]; hv[j] = hr[64 * j]; s += (v[j].x * v[j].x + v[j].y * v[j].y) + (v[j].z * v[j].z + v[j].w * v[j].w); }
        const float r1 = 1.0f / sqrtf(wave_sum(s) * (1.0f / DM) + EPS);
        GAS v2u* o8 = (GAS v2u*)(HB + (size_t)m * DM) + lane;
#pragma unroll
        for (int j = 0; j < 4; ++j) { v[j] = hv[j] + v[j] * r1 * gv[j]; hr[64 * j] = v[j]; v2u o; o.x = pk2(v[j].x, v[j].y); o.y = pk2(v[j].z, v[j].w); o8[64 * j] = o; }
    }
}

__device__ __forceinline__ void grid_bar(unsigned* ctr, unsigned target, int wave) {
    asm volatile("s_waitcnt vmcnt(0)" ::: "memory");
    __syncthreads();
    if (wave == 0) {
        if (pg8::lane_id_asm() == 0) {
            __builtin_amdgcn_fence(__ATOMIC_RELEASE, "agent");
            asm volatile("s_waitcnt vmcnt(0)" ::: "memory");
            __hip_atomic_fetch_add(ctr, 1u, __ATOMIC_RELAXED, __HIP_MEMORY_SCOPE_AGENT);
            while (__hip_atomic_load(ctr, __ATOMIC_RELAXED, __HIP_MEMORY_SCOPE_AGENT) < target) __builtin_amdgcn_s_sleep(2);
            __builtin_amdgcn_fence(__ATOMIC_ACQUIRE, "agent");
            asm volatile("s_waitcnt vmcnt(0)" ::: "memory");
        }
    }
    __syncthreads();
}

__global__ void __launch_bounds__(NWAVES * 64, 2) mk_fwd(Args args) {
    extern __shared__ __attribute__((aligned(16))) unsigned char lds_raw[];
    cg::grid_group grid = cg::this_grid();
    Frame F;
    F.lds = (LAS unsigned char*)lds_raw;
    F.wave = __builtin_amdgcn_readfirstlane(threadIdx.x >> 6);
    F.G = gridDim.x; { const int bx = blockIdx.x; F.vcu = (F.G % 8 == 0) ? (bx % 8) * (F.G / 8) + bx / 8 : bx; }
    F.out = args.out; F.ws = args.ws;
#ifndef REPEAT_MASK
#define REPEAT_MASK 0
#endif
#define REPS(k) ((((REPEAT_MASK) >> (k)) & 1) ? 2 : 1)
    unsigned* const bar_ctr = (unsigned*)F.ws;
    unsigned epoch = 0;
#define SEAM() do { ++epoch; if (epoch == 1) grid.sync(); else grid_bar(bar_ctr, (unsigned)F.G * (epoch - 1), F.wave); } while (0)
    const pg8::bf16_t* XN = (const pg8::bf16_t*)(F.ws + WS_XN);

#ifndef NPASS
#define NPASS 1
#endif
    for (int pass_ = 0; pass_ < NPASS; ++pass_) {
    if (pass_ > 0) SEAM();
    for (int rep_ = 0; rep_ < REPS(0); ++rep_) { if (pass_ == 0 && blockIdx.x == 0 && threadIdx.x == 0) __hip_atomic_store(bar_ctr, 0u, __ATOMIC_RELAXED, __HIP_MEMORY_SCOPE_AGENT); p0_prologue(F, args); }
    SEAM();
    for (int rep_ = 0; rep_ < REPS(1); ++rep_) {
        { pg8::Gemm g{XN, (const pg8::bf16_t*)(F.ws + WS_W1), MTOK, PC, DM}; pg8::StaticOrder S; S.init(MTOK, PC, F.G, (int)blockIdx.x);
          pg8::EpiBf16M<1> E{(pg8::bf16_t*)(F.ws + WS_PROJ), PC, (const float*)(F.ws + CT_SS0)};
          pg8::gemm_phase<pg8::EpiBf16M<1>, pg8::StaticOrder, true, true>(F.lds, g, S, E, F.wave); }
        { pg8::Gemm g{(const pg8::bf16_t*)(F.ws + WS_PB), (const pg8::bf16_t*)(F.ws + WS_W6), MTOK, DM, PLE}; pg8::StaticOrder S; S.init(MTOK, DM, F.G, (int)blockIdx.x);
          pg8::EpiBf16M<0> E{(pg8::bf16_t*)(F.ws + WS_PE), DM, nullptr};
          pg8::gemm_phase<pg8::EpiBf16M<0>, pg8::StaticOrder, true, true>(F.lds, g, S, E, F.wave); }
    }
    SEAM();
    for (int rep_ = 0; rep_ < REPS(2); ++rep_) {
        { const int per = (ATT_ITEMS + F.G - 1) / F.G; const int f0 = F.vcu * per; int n = ATT_ITEMS - f0; n = n < 0 ? 0 : (n > per ? per : n); if (n > 0) att_phase(F, args, f0, n); }
        __syncthreads();
        { const int per = (SGU_ITEMS + F.G - 1) / F.G; const int f0 = F.vcu * per; int n = SGU_ITEMS - f0; n = n < 0 ? 0 : (n > per ? per : n); if (n > 0) sgu_phase(F, args, f0, n); }
    }
    SEAM();
    for (int rep_ = 0; rep_ < REPS(3); ++rep_) { merge_phase(F, args); }
    SEAM();
    {
        pg8::Gemm g{(const pg8::bf16_t*)(F.ws + WS_GROUPS), (const pg8::bf16_t*)(F.ws + WS_W2), MTOK, DM, DM}; pg8::StaticOrder S; S.init(MTOK, DM, F.G, (int)blockIdx.x);
        pg8::EpiResNorm<true> E{(pg8::bf16_t*)(F.ws + WS_XN), arg_in(11), (float*)(F.ws + CT_SS1), (unsigned*)(F.ws + CT_CNT1), (float*)(F.ws + CT_SS2), DM};
        pg8::gemm_phase<pg8::EpiResNorm<true>, pg8::StaticOrder, true, true>(F.lds, g, S, E, F.wave);
    }
    SEAM();
    for (int rep_ = 0; rep_ < REPS(6); ++rep_) {
        pg8::Gemm g{XN, (const pg8::bf16_t*)(F.ws + WS_W3), MTOK, 2 * DFF, DM}; pg8::StaticOrder S; S.init(MTOK, 2 * DFF, F.G, (int)blockIdx.x);
        pg8::EpiSwiglu E{(pg8::bf16_t*)(F.ws + WS_ACT), DFF, (const float*)(F.ws + CT_SS2)};
        pg8::gemm_phase<pg8::EpiSwiglu, pg8::StaticOrder, true, true>(F.lds, g, S, E, F.wave);
    }
    SEAM();
    {
        pg8::Gemm g{(const pg8::bf16_t*)(F.ws + WS_ACT), (const pg8::bf16_t*)(F.ws + WS_W4), MTOK, DM, DFF}; pg8::StaticOrder S; S.init(MTOK, DM, F.G, (int)blockIdx.x);
        pg8::EpiResNorm<false> E{(pg8::bf16_t*)(F.ws + WS_XN), arg_in(15), (float*)(F.ws + CT_SS3), (unsigned*)(F.ws + CT_CNT3), nullptr, DM};
        pg8::gemm_phase<pg8::EpiResNorm<false>, pg8::StaticOrder, true, true>(F.lds, g, S, E, F.wave);
    }
    SEAM();
    for (int rep_ = 0; rep_ < REPS(9); ++rep_) {
        pg8::Gemm g{XN, (const pg8::bf16_t*)(F.ws + WS_W5), MTOK, DM, DM}; pg8::StaticOrder S; S.init(MTOK, DM, F.G, (int)blockIdx.x);
        pg8::EpiFinal E{XN, (const pg8::bf16_t*)(F.ws + WS_PE), arg_in(17), F.out, DM};
        pg8::gemm_phase<pg8::EpiFinal, pg8::StaticOrder, true, true>(F.lds, g, S, E, F.wave);
    }
    }
#undef SEAM
}

extern "C" void kernel_launch(void* const* d_in, const int* in_sizes, int n_in, void* d_out, int out_size, void* d_ws, size_t ws_size, hipStream_t stream) {
    static int grid = 0;
    if (grid == 0) {
        if (n_in != 19 || in_sizes[0] != MTOK * DM || out_size != MTOK * DM || ws_size < WS_END) { fprintf(stderr, "kernel_launch: unexpected shapes (n_in %d, in0 %d, out %d, ws %zu); nothing launched\n", n_in, n_in > 0 ? in_sizes[0] : -1, out_size, ws_size); grid = -1; return; }
        int dev = 0, cus = 0, per_cu = 0;
        if (hipGetDevice(&dev) != hipSuccess || hipDeviceGetAttribute(&cus, hipDeviceAttributeMultiprocessorCount, dev) != hipSuccess) { grid = -1; return; }
        if (hipFuncSetAttribute((const void*)mk_fwd, hipFuncAttributeMaxDynamicSharedMemorySize, LDS_BYTES) != hipSuccess) { fprintf(stderr, "kernel_launch: hipFuncSetAttribute failed\n"); grid = -1; return; }
        if (hipOccupancyMaxActiveBlocksPerMultiprocessor(&per_cu, (const void*)mk_fwd, NWAVES * 64, LDS_BYTES) != hipSuccess || per_cu < 1) { fprintf(stderr, "kernel_launch: occupancy query says %d\n", per_cu); per_cu = 1; }
        (void)hipGetLastError();
        grid = cus;
    }
    if (grid < 0) return;
    Args a{};
    for (int i = 0; i < 19; ++i) a.in[i] = (const float*)d_in[i];
    a.out = (float*)d_out; a.ws = (unsigned char*)d_ws;
    a.ph_lo = 0; a.ph_hi = N_PHASES;
    void* params[] = {&a};
    hipError_t e = hipLaunchCooperativeKernel((const void*)mk_fwd, dim3(grid), dim3(NWAVES * 64), params, LDS_BYTES, stream);
    if (e != hipSuccess) fprintf(stderr, "kernel_launch: cooperative launch failed: %s (grid %d)\n", hipGetErrorString(e), grid);
}
```

```cpp
#include <hip/hip_runtime.h>
#include <hip/hip_cooperative_groups.h>
#include <cstdio>
#include <cstdint>
namespace cg = cooperative_groups;
namespace pg8 {
#define PG8_LAS __attribute__((address_space(3)))
typedef unsigned short bf16_t;
typedef short bf16x8 __attribute__((ext_vector_type(8)));
typedef float f32x4 __attribute__((ext_vector_type(4)));
typedef unsigned u32x4 __attribute__((ext_vector_type(4)));
constexpr int BM = 256, BK = 64, HALF = 128, HTB = HALF * BK * 2  , STAGE_BYTES = 8 * HTB, NXCD = 8, WGM = 8;

__host__ __device__ __forceinline__ int lds_byte(int r, int c) { const int st = (r >> 4) * 2 + (c >> 5), rr = r & 15, cc = c & 31, ob = rr * 64 + cc * 2; return st * 1024 + (ob ^ (((ob >> 9) & 1) << 5)); }
__host__ __device__ __forceinline__ void stage_rc(int b, int& R, int& C) { const int st = b / 1024, sb = b % 1024, swz = sb ^ (((sb >> 9) & 1) << 5); R = (st >> 1) * 16 + swz / 64; C = (st & 1) * 32 + (swz % 64) / 2; }
__host__ __device__ __forceinline__ int perm32(int rho) { const int n = rho >> 4, i = rho & 15; return 8 * (i >> 2) + 4 * n + (i & 3); }

struct Unit { int pm, pn; };
struct Gemm { const bf16_t* A; const bf16_t* Bt; int M, N, K; };

struct StaticOrder {
    int nM, nN, nwg, G, c;
    __host__ __device__ void init(int M, int N, int G_, int c_) { nM = M / BM; nN = N / BM; nwg = nM * nN; G = G_; c = c_; }
    __host__ __device__ bool next(int i, Unit& u) const {
        const long L = (long)i * G + c; if (L >= nwg) return false;
        int wgid = (int)L; { const int q = nwg / NXCD, r = nwg % NXCD, xcd = wgid % NXCD, off = wgid / NXCD; wgid = (xcd < r ? xcd * (q + 1) : r * (q + 1) + (xcd - r) * q) + off; }
        const int nig = WGM * nN, gid = wgid / nig, fm = gid * WGM, gsz = (nM - fm) < WGM ? (nM - fm) : WGM;
        u.pm = fm + ((wgid % nig) % gsz); u.pn = (wgid % nig) / gsz; return true;
    }
    __device__ __forceinline__ void a_ready(const Unit&) const {}
    __device__ __forceinline__ void done(const Unit&) const {}
};

__device__ __forceinline__ unsigned cvt_pk_bf16(float lo, float hi) { unsigned r; asm volatile("v_cvt_pk_bf16_f32 %0, %1, %2" : "=v"(r) : "v"(lo), "v"(hi)); return r; }
typedef unsigned u32x2 __attribute__((ext_vector_type(2)));
__device__ __forceinline__ int lane_id_asm() { int l; asm volatile("v_mbcnt_lo_u32_b32 %0, -1, 0\n\tv_mbcnt_hi_u32_b32 %0, -1, %0" : "=v"(l)); return l; }
__device__ __forceinline__ float gelu_tanh(float x) {
    const float u = 0.7978845608028654f * (x + 0.044715f * x * x * x);
    const float e = __builtin_amdgcn_exp2f(-2.885390081777927f * u);
    return x * __builtin_amdgcn_rcpf(1.0f + e);
}
__device__ __forceinline__ float rows_sum4(float q) {
    auto a = __builtin_amdgcn_permlane16_swap(__float_as_uint(q), __float_as_uint(q), false, false); q = __uint_as_float(a[0]) + __uint_as_float(a[1]);
    auto b = __builtin_amdgcn_permlane32_swap(__float_as_uint(q), __float_as_uint(q), false, false); return __uint_as_float(b[0]) + __uint_as_float(b[1]);
}
__device__ __forceinline__ float rows_max4(float q) {
    auto a = __builtin_amdgcn_permlane16_swap(__float_as_uint(q), __float_as_uint(q), false, false); q = __builtin_fmaxf(__uint_as_float(a[0]), __uint_as_float(a[1]));
    auto b = __builtin_amdgcn_permlane32_swap(__float_as_uint(q), __float_as_uint(q), false, false); return __builtin_fmaxf(__uint_as_float(b[0]), __uint_as_float(b[1]));
}
typedef float f32x2 __attribute__((ext_vector_type(2)));
__device__ __forceinline__ f32x2 sigmoid_pk(f32x2 x) { const f32x2 t = x * -1.4426950408889634f; f32x2 e; e.x = __builtin_amdgcn_exp2f(t.x); e.y = __builtin_amdgcn_exp2f(t.y);
    const f32x2 d = e + 1.0f; f32x2 r; r.x = __builtin_amdgcn_rcpf(d.x); r.y = __builtin_amdgcn_rcpf(d.y); return r; }
__device__ __forceinline__ f32x2 gelu_tanh_pk(f32x2 x) { const f32x2 x2 = x * x; const f32x2 u = x * (x2 * (0.044715f * 0.7978845608028654f) + 0.7978845608028654f);
    const f32x2 t = u * -2.885390081777927f; f32x2 e; e.x = __builtin_amdgcn_exp2f(t.x); e.y = __builtin_amdgcn_exp2f(t.y);
    const f32x2 d = e + 1.0f; f32x2 r; r.x = __builtin_amdgcn_rcpf(d.x); r.y = __builtin_amdgcn_rcpf(d.y); return x * r; }
__device__ __forceinline__ float sigmoid_f(float x) { return __builtin_amdgcn_rcpf(1.0f + __builtin_amdgcn_exp2f(-1.4426950408889634f * x)); }

constexpr int ROWTAB_OFF = 8 * HTB;
template <int MODE> struct EpiBf16M {
    static constexpr bool PERM = true, AFTER_DRAIN = false, MIDSCALE = false, ROWTAB = (MODE == 1);
    __device__ __forceinline__ float row_prefetch(const Unit& u, int tid) const { return (tid < 256) ? ss[u.pm * BM + tid] : 0.f; }
    __device__ __forceinline__ void row_commit(float v, PG8_LAS unsigned char* lds, int tid, int ui) const { if (tid < 256) *(PG8_LAS float*)(lds + ROWTAB_OFF + (ui & 1) * 1024 + tid * 4) = __builtin_amdgcn_rsqf(v * (1.0f / 1024.0f) + 1e-6f); }
    __device__ __forceinline__ void epi(const f32x4 (&acc)[2][2][4][2], const Unit& u, int wr, int wc, int fr, int fq, PG8_LAS unsigned char* lds, int ui) const { run(acc, u, wr, wc, fr, fq, lds + ROWTAB_OFF + (ui & 1) * 1024 + (wr * 64 + fr) * 4); }
    __device__ __forceinline__ void operator()(const f32x4 (&acc)[2][2][4][2], const Unit& u, int wr, int wc, int fr, int fq) const { run(acc, u, wr, wc, fr, fq, nullptr); }
    bf16_t* O; int ldc; const float* ss;
    __device__ __forceinline__ void run(const f32x4 (&acc)[2][2][4][2], const Unit& u, int wr, int wc, int fr, int fq, PG8_LAS unsigned char* tab) const {
        const int row0 = u.pm * BM + wr * 64 + fr, col0 = u.pn * BM + wc * 32 + 8 * fq;
        const int mode = (MODE == 1) ? (u.pn < 2 ? 1 : (u.pn >= 6 ? 2 : 0)) : 0;
#pragma unroll
        for (int ai = 0; ai < 2; ++ai)
#pragma unroll
            for (int m = 0; m < 4; ++m) { const int row = row0 + ai * HALF + m * 16; bf16_t* rowp = O + (size_t)row * ldc + col0; size_t bjstep = HALF;
                if (MODE == 1) {
                    if (u.pn < 6) { const int kind = u.pn >> 1, ck = (u.pn & 1) * 256 + wc * 32 + 8 * fq, b = row >> 13, t = row & 8191;
                        rowp = O + ((size_t)(((kind * 4 + b) * 8 + (ck >> 6))) * 8192 + t) * 64 + (ck & 63); bjstep = (size_t)2 * 8192 * 64; }
                    else rowp = O + (size_t)48 * 1048576 + (size_t)row * 1024 + (u.pn - 6) * 256 + wc * 32 + 8 * fq; }
                float rs = 1.0f;
                if (MODE == 1) { rs = *(const PG8_LAS float*)(tab + (ai * HALF + m * 16) * 4); if (mode == 1) rs *= 0.125f * 1.4426950408889634f; }
#pragma unroll
                for (int bj = 0; bj < 2; ++bj) { f32x4 v0 = acc[ai][bj][m][0], v1 = acc[ai][bj][m][1];
                    if (MODE == 1) { v0 = v0 * rs; v1 = v1 * rs; }
                    if (false) { }
                    else if (mode == 2) {
#pragma unroll
                        for (int e = 0; e < 4; e += 2) { const f32x2 a = gelu_tanh_pk((f32x2){v0[e], v0[e + 1]}), b = gelu_tanh_pk((f32x2){v1[e], v1[e + 1]}); v0[e] = a.x; v0[e + 1] = a.y; v1[e] = b.x; v1[e + 1] = b.y; } }
                    u32x4 w; w.x = cvt_pk_bf16(v0[0], v0[1]); w.y = cvt_pk_bf16(v0[2], v0[3]); w.z = cvt_pk_bf16(v1[0], v1[1]); w.w = cvt_pk_bf16(v1[2], v1[3]);
                    *(u32x4*)(rowp + bj * bjstep) = w; } }
    }
};
struct EpiSwiglu {
    static constexpr bool PERM = true, AFTER_DRAIN = false, MIDSCALE = false, ROWTAB = true;
    __device__ __forceinline__ float row_prefetch(const Unit& u, int tid) const { return (tid < 256) ? ss[u.pm * BM + tid] : 0.f; }
    __device__ __forceinline__ void row_commit(float v, PG8_LAS unsigned char* lds, int tid, int ui) const { if (tid < 256) *(PG8_LAS float*)(lds + ROWTAB_OFF + (ui & 1) * 1024 + tid * 4) = __builtin_amdgcn_rsqf(v * (1.0f / 1024.0f) + 1e-6f); }
    bf16_t* O; int ldc; const float* ss;
    __device__ __forceinline__ void epi(const f32x4 (&acc)[2][2][4][2], const Unit& u, int wr, int wc, int fr, int fq, PG8_LAS unsigned char* lds, int ui) const {
        PG8_LAS unsigned char* tab = lds + ROWTAB_OFF + (ui & 1) * 1024 + (wr * 64 + fr) * 4;
        const int row0 = u.pm * BM + wr * 64 + fr, col0 = u.pn * HALF + wc * 32 + 8 * fq;
#pragma unroll
        for (int ai = 0; ai < 2; ++ai)
#pragma unroll
            for (int m = 0; m < 4; ++m) { const int row = row0 + ai * HALF + m * 16; bf16_t* rowp = O + (size_t)row * ldc + col0;
                const float r2 = *(const PG8_LAS float*)(tab + (ai * HALF + m * 16) * 4);
                f32x4 r0, r1;
#pragma unroll
                for (int e = 0; e < 4; e += 2) { const f32x2 g0 = (f32x2){acc[ai][0][m][0][e], acc[ai][0][m][0][e + 1]} * r2, g1 = (f32x2){acc[ai][0][m][1][e], acc[ai][0][m][1][e + 1]} * r2;
                    const f32x2 u0 = (f32x2){acc[ai][1][m][0][e], acc[ai][1][m][0][e + 1]} * r2, u1 = (f32x2){acc[ai][1][m][1][e], acc[ai][1][m][1][e + 1]} * r2;
                    const f32x2 o0 = (g0 * u0) * sigmoid_pk(g0), o1 = (g1 * u1) * sigmoid_pk(g1);
                    r0[e] = o0.x; r0[e + 1] = o0.y; r1[e] = o1.x; r1[e + 1] = o1.y; }
                u32x4 w; w.x = cvt_pk_bf16(r0[0], r0[1]); w.y = cvt_pk_bf16(r0[2], r0[3]); w.z = cvt_pk_bf16(r1[0], r1[1]); w.w = cvt_pk_bf16(r1[2], r1[3]);
                *(u32x4*)rowp = w; }
    }
};
template <bool SS2> struct EpiResNorm {
    static constexpr bool PERM = true, AFTER_DRAIN = false, MIDSCALE = SS2, ROWTAB = false;
    bf16_t* HB; const float* gain; float* ss1; unsigned* cnt; float* ss2; int ldc; const float* ssa; const float* sss;
    static constexpr int RATIO_OFF = 8 * HTB;
    __device__ __forceinline__ void unit_begin(const Unit& u, PG8_LAS unsigned char* lds, int tid, int ui) const {
        if (tid < 256) { const int row = u.pm * BM + tid;
            const float ra = __builtin_amdgcn_rsqf(ssa[row] * (1.0f / 512.0f) + 1e-6f), rs = __builtin_amdgcn_rsqf(sss[row] * (1.0f / 512.0f) + 1e-6f);
            *(PG8_LAS float*)(lds + RATIO_OFF + (ui & 1) * 1024 + tid * 4) = ra * __builtin_amdgcn_rcpf(rs); }
    }
    __device__ __forceinline__ void midscale(f32x4 (&acc)[2][2][4][2], PG8_LAS unsigned char* lds, int wr, int fr, int ui) const {
        PG8_LAS unsigned char* tp = lds + RATIO_OFF + (ui & 1) * 1024 + (wr * 64 + fr) * 4;
#pragma unroll
        for (int ai = 0; ai < 2; ++ai)
#pragma unroll
            for (int m = 0; m < 4; ++m) { const float ratio = *(const PG8_LAS float*)(tp + (ai * HALF + m * 16) * 4);
#pragma unroll
                for (int bj = 0; bj < 2; ++bj)
#pragma unroll
                    for (int n = 0; n < 2; ++n) acc[ai][bj][m][n] = acc[ai][bj][m][n] * ratio;
                asm volatile("" ::: "memory"); }
    }
    __device__ __forceinline__ void operator()(f32x4 (&acc)[2][2][4][2], const Unit& u, int wr, int wc, int fr, int fq) const {
        const int row0 = u.pm * BM + wr * 64 + fr, col0 = u.pn * BM + wc * 32 + 8 * fq;
        if (SS2) {
#pragma unroll
            for (int ai = 0; ai < 2; ++ai)
#pragma unroll
                for (int m = 0; m < 4; ++m) { const float rs = __builtin_amdgcn_rsqf(sss[row0 + ai * HALF + m * 16] * (1.0f / 512.0f) + 1e-6f);
#pragma unroll
                    for (int bj = 0; bj < 2; ++bj)
#pragma unroll
                        for (int n = 0; n < 2; ++n) acc[ai][bj][m][n] = acc[ai][bj][m][n] * rs; }
        }
        u32x4 pre[4][2];
#pragma unroll
        for (int m = 0; m < 4; ++m)
#pragma unroll
            for (int bj = 0; bj < 2; ++bj) pre[m][bj] = *(const u32x4*)(HB + (size_t)(row0 + m * 16) * ldc + col0 + bj * HALF);
#pragma unroll
        for (int ai = 0; ai < 2; ++ai)
#pragma unroll
            for (int m = 0; m < 4; ++m) { float q = 0.f;
#pragma unroll
                for (int bj = 0; bj < 2; ++bj)
#pragma unroll
                    for (int n = 0; n < 2; ++n) { const f32x4 x = acc[ai][bj][m][n]; q += (x[0] * x[0] + x[1] * x[1]) + (x[2] * x[2] + x[3] * x[3]); }
                q = rows_sum4(q);
                if (fq == 0) unsafeAtomicAdd(ss1 + row0 + ai * HALF + m * 16, q); }
        asm volatile("s_waitcnt vmcnt(0)" ::: "memory");
        unsigned* c = cnt + 64 * u.pm;
        if (fr == 0 && fq == 0) __hip_atomic_fetch_add(c, 1u, __ATOMIC_RELAXED, __HIP_MEMORY_SCOPE_AGENT);
        f32x4 gv[2][2];
#pragma unroll
        for (int bj = 0; bj < 2; ++bj)
#pragma unroll
            for (int n = 0; n < 2; ++n) gv[bj][n] = *(const f32x4*)(gain + col0 + bj * HALF + n * 4);
        while (__hip_atomic_load(c, __ATOMIC_RELAXED, __HIP_MEMORY_SCOPE_AGENT) < 32u) __builtin_amdgcn_s_sleep(1);
        asm volatile("" ::: "memory");
        float r1[2][4];
#pragma unroll
        for (int ai = 0; ai < 2; ++ai)
#pragma unroll
            for (int m = 0; m < 4; ++m) r1[ai][m] = __hip_atomic_load(ss1 + row0 + ai * HALF + m * 16, __ATOMIC_RELAXED, __HIP_MEMORY_SCOPE_AGENT);
#pragma unroll
        for (int ai = 0; ai < 2; ++ai)
#pragma unroll
            for (int m = 0; m < 4; ++m) { const int row = row0 + ai * HALF + m * 16; const size_t off = (size_t)row * ldc + col0;
                const float rr = __builtin_amdgcn_rsqf(r1[ai][m] * (1.0f / 1024.0f) + 1e-6f);
                float q2 = 0.f;
#pragma unroll
                for (int bj = 0; bj < 2; ++bj) { const size_t o2 = off + bj * HALF;
                    const u32x4 pw = (ai == 0) ? pre[m][bj] : *(const u32x4*)(HB + o2);
                    f32x4 b0, b1; b0[0] = __uint_as_float(pw.x << 16); b0[1] = __uint_as_float(pw.x & 0xffff0000u); b0[2] = __uint_as_float(pw.y << 16); b0[3] = __uint_as_float(pw.y & 0xffff0000u);
                    b1[0] = __uint_as_float(pw.z << 16); b1[1] = __uint_as_float(pw.z & 0xffff0000u); b1[2] = __uint_as_float(pw.w << 16); b1[3] = __uint_as_float(pw.w & 0xffff0000u);
                    const f32x4 h0 = b0 + acc[ai][bj][m][0] * rr * gv[bj][0], h1 = b1 + acc[ai][bj][m][1] * rr * gv[bj][1];
                    u32x4 w; w.x = cvt_pk_bf16(h0[0], h0[1]); w.y = cvt_pk_bf16(h0[2], h0[3]); w.z = cvt_pk_bf16(h1[0], h1[1]); w.w = cvt_pk_bf16(h1[2], h1[3]); *(u32x4*)(HB + o2) = w;
                    if (SS2) q2 += ((h0[0] * h0[0] + h0[1] * h0[1]) + (h0[2] * h0[2] + h0[3] * h0[3])) + ((h1[0] * h1[0] + h1[1] * h1[1]) + (h1[2] * h1[2] + h1[3] * h1[3])); }
                if (SS2) { q2 = rows_sum4(q2); if (fq == 0) unsafeAtomicAdd(ss2 + row, q2); }
                if (m & 1) asm volatile("" ::: "memory"); }
    }
};
struct EpiF32 {
    static constexpr bool PERM = false, AFTER_DRAIN = false, MIDSCALE = false, ROWTAB = false;
    float* O; int ldc;
    __device__ __forceinline__ void operator()(const f32x4 (&acc)[2][2][4][2], const Unit& u, int wr, int wc, int fr, int fq) const {
        const int row0 = u.pm * BM + wr * 64 + fr, col0 = u.pn * BM + wc * 32 + 4 * fq;
#pragma unroll
        for (int ai = 0; ai < 2; ++ai)
#pragma unroll
            for (int m = 0; m < 4; ++m) { float* rowp = O + (size_t)(row0 + ai * HALF + m * 16) * ldc + col0;
#pragma unroll
                for (int bj = 0; bj < 2; ++bj)
#pragma unroll
                    for (int n = 0; n < 2; ++n) *(f32x4*)(rowp + bj * HALF + n * 16) = acc[ai][bj][m][n]; }
    }
};
struct EpiFinal {
    static constexpr bool PERM = true, AFTER_DRAIN = false, MIDSCALE = false, ROWTAB = false;
    const bf16_t* H2; const bf16_t* PE; const float* bias; float* O; int ldc;
    __device__ __forceinline__ void operator()(const f32x4 (&acc)[2][2][4][2], const Unit& u, int wr, int wc, int fr, int fq) const {
        const int row0 = u.pm * BM + wr * 64 + fr, col0 = u.pn * BM + wc * 32 + 8 * fq;
        f32x4 bv[2][2];
#pragma unroll
        for (int bj = 0; bj < 2; ++bj)
#pragma unroll
            for (int n = 0; n < 2; ++n) bv[bj][n] = *(const f32x4*)(bias + col0 + bj * HALF + n * 4);
#pragma unroll
        for (int ai = 0; ai < 2; ++ai)
#pragma unroll
            for (int m = 0; m < 4; ++m) { const size_t off = (size_t)(row0 + ai * HALF + m * 16) * ldc + col0;
#pragma unroll
                for (int bj = 0; bj < 2; ++bj) { const size_t o2 = off + bj * HALF;
                    const u32x4 hw = *(const u32x4*)(H2 + o2), pw = *(const u32x4*)(PE + o2);
                    const unsigned hh[4] = {hw.x, hw.y, hw.z, hw.w}, pp[4] = {pw.x, pw.y, pw.z, pw.w};
#pragma unroll
                    for (int n = 0; n < 2; ++n) { const f32x4 a = acc[ai][bj][m][n] + bv[bj][n]; f32x4 o;
                        const f32x2 s0 = sigmoid_pk((f32x2){a[0], a[1]}), s1 = sigmoid_pk((f32x2){a[2], a[3]});
                        const f32x2 h0 = {__uint_as_float(hh[2 * n] << 16), __uint_as_float(hh[2 * n] & 0xffff0000u)}, h1 = {__uint_as_float(hh[2 * n + 1] << 16), __uint_as_float(hh[2 * n + 1] & 0xffff0000u)};
                        const f32x2 p0 = {__uint_as_float(pp[2 * n] << 16), __uint_as_float(pp[2 * n] & 0xffff0000u)}, p1 = {__uint_as_float(pp[2 * n + 1] << 16), __uint_as_float(pp[2 * n + 1] & 0xffff0000u)};
                        const f32x2 o0 = h0 + s0 * p0, o1 = h1 + s1 * p1; o[0] = o0.x; o[1] = o0.y; o[2] = o1.x; o[3] = o1.y;
                        *(f32x4*)(O + o2 + 4 * n) = o; } } }
    }
};

template <class Epi, class Sched, bool ALIGN_EPI = false, bool SP2 = false>
__device__ __forceinline__ void gemm_phase(PG8_LAS unsigned char* lds, const Gemm g, const Sched& S, const Epi& E, const int wave_id) {
    const int wid = wave_id, lane = lane_id_asm(), tid = wid * 64 + lane, wr = wid >> 2, wc = wid & 3, fr = lane & 15, fq = lane >> 4;
    const int K = g.K, nt = K / BK;
    unsigned voffA[2], voffB[2];
#pragma unroll
    for (int i = 0; i < 2; ++i) { int R, C; stage_rc(tid * 16 + i * 8192, R, C); const int Rb = Epi::PERM ? ((R & ~31) + perm32(R & 31)) : R;
        voffA[i] = (unsigned)(R * K + C) * 2u; voffB[i] = (unsigned)(Rb * K + C) * 2u; }
    const size_t kstep = (size_t)(BK * 2);
    const size_t hstep = (size_t)HALF * K * 2;
    const size_t tstep = 2 * hstep;
    const unsigned ldsw = (unsigned)wid * 1024u;
    const int aoff = lds_byte(wr * 64 + fr, fq * 8), boff = lds_byte(wc * 32 + fr, fq * 8);
#define PG8_SA(b, h) (((b) * 2 + (h)) * HTB)
#define PG8_SB(b, h) ((4 + (b) * 2 + (h)) * HTB)
#define PG8_STAGE(bufoff, gbase, voff) do { _Pragma("unroll") for (int _i = 0; _i < 2; ++_i) \
        __builtin_amdgcn_global_load_lds((const unsigned*)((const char*)(gbase) + (voff)[_i]), (PG8_LAS unsigned*)(lds + (bufoff) + ldsw + _i * 8192), 16, 0, 0); } while (0)
#define PG8_LDA(dst, b, h) do { _Pragma("unroll") for (int m = 0; m < 4; ++m) _Pragma("unroll") for (int k = 0; k < 2; ++k) dst[m][k] = *(const PG8_LAS bf16x8*)(lds + PG8_SA(b, h) + aoff + m * 2048 + k * 1024); } while (0)
#define PG8_LDB(dst, b, h) do { _Pragma("unroll") for (int n = 0; n < 2; ++n) _Pragma("unroll") for (int k = 0; k < 2; ++k) dst[n][k] = *(const PG8_LAS bf16x8*)(lds + PG8_SB(b, h) + boff + n * 2048 + k * 1024); } while (0)
#define PG8_MMA(ai, bj, At, Bt) do { __builtin_amdgcn_s_setprio(1); _Pragma("unroll") for (int m = 0; m < 4; ++m) _Pragma("unroll") for (int n = 0; n < 2; ++n) _Pragma("unroll") for (int k = 0; k < 2; ++k) \
        acc[ai][bj][m][n] = __builtin_amdgcn_mfma_f32_16x16x32_bf16(Bt[n][k], At[m][k], acc[ai][bj][m][n], 0, 0, 0); __builtin_amdgcn_s_setprio(0); } while (0)
#define PG8_WAIT_V(n) asm volatile("s_waitcnt vmcnt(" #n ")" ::: "memory")
#define PG8_WAIT_L(n) asm volatile("s_waitcnt lgkmcnt(" #n ")" ::: "memory")
#define PG8_BAR __builtin_amdgcn_s_barrier()
#define PG8_SCHED __builtin_amdgcn_sched_barrier(0)
    Unit cur, nxt; int ui = 0;
    if (!S.next(0, cur)) return;
    f32x4 acc[2][2][4][2];
#pragma unroll
    for (int a = 0; a < 2; ++a)
#pragma unroll
        for (int b = 0; b < 2; ++b)
#pragma unroll
            for (int m = 0; m < 4; ++m)
#pragma unroll
                for (int n = 0; n < 2; ++n) acc[a][b][m][n] = (f32x4){0.f, 0.f, 0.f, 0.f};
    bf16x8 At[4][2], B0[2][2], B1[2][2];
    const char* cA = (const char*)g.A + (size_t)cur.pm * tstep; const char* cB = (const char*)g.Bt + (size_t)cur.pn * tstep;
    S.a_ready(cur);
    if constexpr (Epi::MIDSCALE) E.unit_begin(cur, lds, tid, 0);
    if constexpr (Epi::ROWTAB) { const float v0_ = E.row_prefetch(cur, tid); E.row_commit(v0_, lds, tid, 0); }
    if constexpr (SP2) {
        PG8_STAGE(PG8_SB(0, 0), cB, voffB); PG8_STAGE(PG8_SB(0, 1), cB + hstep, voffB); PG8_STAGE(PG8_SA(0, 0), cA, voffA); PG8_STAGE(PG8_SA(0, 1), cA + hstep, voffA);
        if (wr == 1) PG8_BAR;
        PG8_WAIT_V(2); PG8_BAR;
        PG8_STAGE(PG8_SB(1, 0), cB + kstep, voffB); PG8_STAGE(PG8_SA(1, 0), cA + kstep, voffA); PG8_STAGE(PG8_SB(1, 1), cB + hstep + kstep, voffB);
        PG8_WAIT_V(6); PG8_BAR;
    } else {
        PG8_STAGE(PG8_SB(0, 0), cB, voffB); PG8_STAGE(PG8_SA(0, 0), cA, voffA); PG8_STAGE(PG8_SB(0, 1), cB + hstep, voffB); PG8_STAGE(PG8_SA(0, 1), cA + hstep, voffA);
        if (wr == 1) PG8_BAR;
        PG8_WAIT_V(4); PG8_BAR;
        PG8_STAGE(PG8_SB(1, 0), cB + kstep, voffB); PG8_STAGE(PG8_SA(1, 0), cA + kstep, voffA); PG8_STAGE(PG8_SB(1, 1), cB + hstep + kstep, voffB);
        PG8_WAIT_V(6); PG8_BAR;
    }
    for (;;) {
        const bool has_next = S.next(ui + 1, nxt);
        const char* nA = has_next ? (const char*)g.A + (size_t)nxt.pm * tstep : cA; const char* nB = has_next ? (const char*)g.Bt + (size_t)nxt.pn * tstep : cB;
        for (int t = 0; t < nt; t += 2) {
            if constexpr (Epi::MIDSCALE) { if (t == (nt >> 1)) E.midscale(acc, lds, wr, fr, ui); }
            const bool last = (t == nt - 2);
            const char* a1 = cA + (size_t)(t + 1) * kstep;
            const char* a2 = last ? nA : cA + (size_t)(t + 2) * kstep; const char* b2 = last ? nB : cB + (size_t)(t + 2) * kstep;
            const char* a3 = a2 + kstep; const char* b3 = b2 + kstep;
            if (last && has_next) S.a_ready(nxt);
            if constexpr (SP2) {
            PG8_LDB(B0, 0, 0); PG8_LDB(B1, 0, 1); PG8_SCHED; PG8_LDA(At, 0, 0); PG8_STAGE(PG8_SA(1, 1), a1 + hstep, voffA);
            PG8_WAIT_V(8); PG8_WAIT_L(0); PG8_BAR; PG8_MMA(0, 0, At, B0); PG8_MMA(0, 1, At, B1); PG8_BAR; PG8_SCHED;
            PG8_LDA(At, 0, 1); PG8_STAGE(PG8_SB(0, 0), b2, voffB); PG8_STAGE(PG8_SB(0, 1), b2 + hstep, voffB); PG8_STAGE(PG8_SA(0, 0), a2, voffA);
            PG8_WAIT_V(8); PG8_WAIT_L(0); PG8_BAR; PG8_MMA(1, 0, At, B0); PG8_MMA(1, 1, At, B1); PG8_BAR; PG8_SCHED;
            PG8_LDB(B0, 1, 0); PG8_LDB(B1, 1, 1); PG8_SCHED; PG8_LDA(At, 1, 0); PG8_STAGE(PG8_SA(0, 1), a2 + hstep, voffA);
            PG8_WAIT_V(8); PG8_WAIT_L(0); PG8_BAR; PG8_MMA(0, 0, At, B0); PG8_MMA(0, 1, At, B1); PG8_BAR; PG8_SCHED;
            PG8_LDA(At, 1, 1); PG8_STAGE(PG8_SB(1, 0), b3, voffB); PG8_STAGE(PG8_SB(1, 1), b3 + hstep, voffB); PG8_STAGE(PG8_SA(1, 0), a3, voffA);
            PG8_WAIT_V(8); PG8_WAIT_L(0); PG8_BAR; PG8_MMA(1, 0, At, B0); PG8_MMA(1, 1, At, B1); PG8_BAR; PG8_SCHED;
            } else {
            PG8_LDB(B0, 0, 0); PG8_SCHED; PG8_LDA(At, 0, 0); PG8_STAGE(PG8_SA(1, 1), a1 + hstep, voffA);
            PG8_WAIT_L(8); PG8_BAR; PG8_WAIT_L(0); PG8_MMA(0, 0, At, B0); PG8_BAR; PG8_SCHED;
            PG8_LDB(B1, 0, 1); PG8_STAGE(PG8_SB(0, 0), b2, voffB);
            PG8_BAR; PG8_WAIT_L(0); PG8_MMA(0, 1, At, B1); PG8_BAR;
            PG8_LDA(At, 0, 1); PG8_STAGE(PG8_SA(0, 0), a2, voffA);
            PG8_BAR; PG8_WAIT_L(0); PG8_MMA(1, 0, At, B0); PG8_BAR; PG8_SCHED;
            PG8_STAGE(PG8_SB(0, 1), b2 + hstep, voffB);
            PG8_WAIT_V(6); PG8_BAR; PG8_MMA(1, 1, At, B1); PG8_BAR;
            PG8_LDB(B0, 1, 0); PG8_SCHED; PG8_LDA(At, 1, 0); PG8_STAGE(PG8_SA(0, 1), a2 + hstep, voffA);
            PG8_WAIT_L(8); PG8_BAR; PG8_WAIT_L(0); PG8_MMA(0, 0, At, B0); PG8_BAR; PG8_SCHED;
            PG8_LDB(B1, 1, 1); PG8_STAGE(PG8_SB(1, 0), b3, voffB);
            PG8_BAR; PG8_WAIT_L(0); PG8_MMA(0, 1, At, B1); PG8_BAR;
            PG8_LDA(At, 1, 1); PG8_STAGE(PG8_SA(1, 0), a3, voffA);
            PG8_BAR; PG8_WAIT_L(0); PG8_MMA(1, 0, At, B0); PG8_BAR; PG8_SCHED;
            PG8_STAGE(PG8_SB(1, 1), b3 + hstep, voffB);
            PG8_WAIT_V(6); PG8_BAR; PG8_MMA(1, 1, At, B1); PG8_BAR;
            }
        }
        if constexpr (ALIGN_EPI) { if (wr == 0) PG8_BAR; }
        float rowtab_next_ = 0.f;
        if constexpr (Epi::ROWTAB) { if (has_next) rowtab_next_ = E.row_prefetch(nxt, tid); }
        if constexpr (!Epi::AFTER_DRAIN) { if constexpr (Epi::ROWTAB) E.epi(acc, cur, wr, wc, fr, fq, lds, ui); else E(acc, cur, wr, wc, fr, fq); S.done(cur); }
        if (!has_next) break;
#pragma unroll
        for (int a = 0; a < 2; ++a)
#pragma unroll
            for (int b = 0; b < 2; ++b)
#pragma unroll
                for (int m = 0; m < 4; ++m)
#pragma unroll
                    for (int n = 0; n < 2; ++n) acc[a][b][m][n] = (f32x4){0.f, 0.f, 0.f, 0.f};
        cur = nxt; cA = nA; cB = nB; ++ui;
        if constexpr (Epi::ROWTAB) E.row_commit(rowtab_next_, lds, tid, ui);
        if constexpr (Epi::MIDSCALE) E.unit_begin(cur, lds, tid, ui);
        if constexpr (ALIGN_EPI) { if (wr == 1) PG8_BAR; }
    }
    PG8_WAIT_V(0);
    if constexpr (!ALIGN_EPI) { if (wr == 0) PG8_BAR; }
    PG8_BAR;
    if constexpr (Epi::AFTER_DRAIN) { E.fused(acc, cur, wr, wc, fr, fq, lds, wid, lane); S.done(cur); }
#undef PG8_SA
#undef PG8_SB
#undef PG8_STAGE
#undef PG8_LDA
#undef PG8_LDB
#undef PG8_MMA
#undef PG8_WAIT_V
#undef PG8_WAIT_L
#undef PG8_BAR
#undef PG8_SCHED
}
}

constexpr int NWAVES = 8;
constexpr int BATCH = 4, SEQ = 8192, DM = 1024, MTOK = BATCH * SEQ, PLE = 256, AW = 512, SW = 512, HD = 64, NH = 8, NG = 4, GD = 128, CHUNK = 128, DFF = 2816, PC = 2560;
constexpr float EPS = 1e-6f;
#ifndef MK_N_LAUNCHES
#define MK_N_LAUNCHES 1
#endif
constexpr int N_PHASES = 10;

constexpr size_t MiB = 1u << 20;
constexpr size_t WS_W1 = 2 * MiB, WS_W2 = 8 * MiB, WS_W3 = 10 * MiB, WS_W4 = 22 * MiB, WS_W5 = 28 * MiB, WS_W6 = 30 * MiB;
constexpr size_t WS_XN = 32 * MiB;
constexpr size_t WS_PE = 96 * MiB;
constexpr size_t WS_PB = 160 * MiB;
constexpr size_t WS_PROJ = 176 * MiB;
constexpr size_t WS_UZ = WS_PROJ + 96 * MiB;
constexpr size_t WS_AO = 336 * MiB;
constexpr size_t WS_LSE = 432 * MiB;
constexpr size_t WS_SG = 436 * MiB;
constexpr size_t WS_GROUPS = 436 * MiB;
constexpr size_t WS_ACT = 176 * MiB;
constexpr size_t WS_END = 500 * MiB;
static_assert(WS_ACT + (size_t)MTOK * DFF * 2 <= WS_LSE && WS_GROUPS + (size_t)MTOK * DM * 2 <= WS_END && WS_LSE + 3 * (size_t)MTOK * NH * 4 <= WS_GROUPS, "ws map");
static_assert(WS_PROJ + (size_t)MTOK * PC * 2 <= WS_AO && WS_AO + 3 * (size_t)MTOK * AW * 2 <= WS_LSE, "ws map 2");
constexpr size_t CT_ZERO_LO = 4096, CT_SS1 = 4096, CT_SS2 = CT_SS1 + 131072, CT_SS3 = CT_SS2 + 131072, CT_CNT1 = 524288, CT_CNT3 = CT_CNT1 + 32768, CT_SSA = CT_CNT3 + 32768, CT_SSS = CT_SSA + 131072, CT_ZERO_HI = CT_SSS + 131072, CT_SS0 = 1048576;
static_assert(CT_SS3 + 131072 <= CT_CNT1 && CT_ZERO_HI <= CT_SS0 && CT_SS0 + 131072 <= 2 * MiB && (MTOK / 256) * 256 <= 32768, "control map");
constexpr int RING_BYTES = 131072;
constexpr int LDS_BYTES = 147456 + 256;
constexpr int LDS_BARST_OFF = 147456;
constexpr size_t CT_XBAR = 1048576 + 262144;

#define GAS __attribute__((address_space(1)))
#define LAS __attribute__((address_space(3)))
typedef unsigned short bf16;
typedef unsigned v4u __attribute__((ext_vector_type(4)));
typedef unsigned v2u __attribute__((ext_vector_type(2)));
typedef float f32x4 __attribute__((ext_vector_type(4)));
typedef short bf16x8 __attribute__((ext_vector_type(8)));
typedef short v4i16_t __attribute__((ext_vector_type(4)));
typedef float f32x2_t __attribute__((ext_vector_type(2)));
typedef __bf16 bf16x2_t __attribute__((ext_vector_type(2)));
#define LDS_WAIT() asm volatile("s_waitcnt lgkmcnt(0)" ::: "memory")
__device__ __forceinline__ unsigned pk2(float lo, float hi) { f32x2_t v = {lo, hi}; bf16x2_t b = __builtin_convertvector(v, bf16x2_t); return __builtin_bit_cast(unsigned, b); }
__device__ __forceinline__ float bflo(unsigned w) { return __uint_as_float(w << 16); }
__device__ __forceinline__ float bfhi(unsigned w) { return __uint_as_float(w & 0xffff0000u); }
__device__ __forceinline__ float wave_sum(float v) {
#pragma unroll
    for (int o = 1; o < 64; o <<= 1) v += __shfl_xor(v, o);
    return v;
}
__device__ __forceinline__ v4i16_t tr_read(LAS unsigned char* p) { return __builtin_amdgcn_ds_read_tr16_b64_v4i16((LAS v4i16_t*)p); }

struct Args { const float* in[19]; float* out; unsigned char* ws; int ph_lo, ph_hi; };
#define CAS __attribute__((address_space(4)))
__device__ __forceinline__ const float* arg_in(int i) {
    const CAS unsigned char* kp = (const CAS unsigned char*)__builtin_amdgcn_kernarg_segment_ptr();
    asm volatile("" : "+s"(kp));
    typedef const float* cfp_t;
    return *(const CAS cfp_t*)(kp + 8 * i);
}
struct Frame {
    LAS unsigned char* lds;
    int wave, vcu, G;
    float* out; unsigned char* ws;
};

__device__ __forceinline__ void p0_transpose_item(const float* W, int K, int N, bf16* WT, int mode, const float* ks0, const float* ks1, LAS float* scr, int item, int lane) {
    const int nblk = N / 32, kb = item / nblk, nb = item % nblk, k0 = 64 * kb, n0 = 32 * nb;
    constexpr int TP = 36;
    f32x4 v[8]; float sc[8];
#pragma unroll
    for (int i = 0; i < 8; ++i) { const int kk = 8 * i + (lane >> 3), kg = k0 + kk;
        v[i] = __builtin_nontemporal_load((const GAS f32x4*)(W + (size_t)kg * N + n0 + 4 * (lane & 7)));
        sc[i] = ks0 ? (kg < 512 ? ks0[kg] : ks1[kg - 512]) : 1.0f; }
#pragma unroll
    for (int i = 0; i < 8; ++i) { const int kk = 8 * i + (lane >> 3); *(LAS f32x4*)(scr + kk * TP + 4 * (lane & 7)) = v[i] * sc[i]; }
    LDS_WAIT(); asm volatile("" ::: "memory");
    int d0 = n0;
    if (mode == 1) { d0 = (n0 < DFF) ? ((n0 / 128) * 256 + (n0 % 128)) : (((n0 - DFF) / 128) * 256 + 128 + ((n0 - DFF) % 128)); }
    const int c = lane & 7;
#pragma unroll
    for (int j = 0; j < 4; ++j) { const int n = (lane >> 3) + 8 * j; const LAS float* s = scr + (8 * c) * TP + n;
        v4u o; o.x = pk2(s[0 * TP], s[1 * TP]); o.y = pk2(s[2 * TP], s[3 * TP]); o.z = pk2(s[4 * TP], s[5 * TP]); o.w = pk2(s[6 * TP], s[7 * TP]);
        *(GAS v4u*)(WT + (size_t)(d0 + n) * K + k0 + 8 * c) = o; }
    LDS_WAIT(); asm volatile("" ::: "memory");
}
constexpr int TI1 = (DM / 64) * (PC / 32), TI6 = (PLE / 64) * (DM / 32), TI2 = (DM / 64) * (DM / 32), TI3 = (DM / 64) * (2 * DFF / 32), TI4 = (DFF / 64) * (DM / 32), TI5 = TI2;
constexpr int T_EARLY = TI1 + TI6, T_ALL = TI1 + TI6 + TI2 + TI3 + TI4 + TI5;
__device__ __forceinline__ void weight_copies(Frame& F, const int it_lo, const int it_hi) {
    const int lane_ = pg8::lane_id_asm();
    LAS float* scr = (LAS float*)(F.lds + F.wave * 16384);
    const int gw = F.vcu * NWAVES + F.wave, NGW = F.G * NWAVES;
    bf16* W1t = (bf16*)(F.ws + WS_W1); bf16* W2t = (bf16*)(F.ws + WS_W2); bf16* W3t = (bf16*)(F.ws + WS_W3);
    bf16* W4t = (bf16*)(F.ws + WS_W4); bf16* W5t = (bf16*)(F.ws + WS_W5); bf16* W6t = (bf16*)(F.ws + WS_W6);
    for (int it = it_lo + gw; it < it_hi; it += NGW) {
        int r = it;
        if (r < TI1) { p0_transpose_item(arg_in(3), DM, PC, W1t, 0, arg_in(2), arg_in(2) + 512, scr, r, lane_); continue; } r -= TI1;
        if (r < TI6) { p0_transpose_item(arg_in(18), PLE, DM, W6t, 0, nullptr, nullptr, scr, r, lane_); continue; } r -= TI6;
        if (r < TI2) { p0_transpose_item(arg_in(10), DM, DM, W2t, 0, arg_in(8), arg_in(9), scr, r, lane_); continue; } r -= TI2;
        if (r < TI3) { p0_transpose_item(arg_in(13), DM, 2 * DFF, W3t, 1, arg_in(12), arg_in(12) + 512, scr, r, lane_); continue; } r -= TI3;
        if (r < TI4) { p0_transpose_item(arg_in(14), DFF, DM, W4t, 0, nullptr, nullptr, scr, r, lane_); continue; } r -= TI4;
        p0_transpose_item(arg_in(16), DM, DM, W5t, 0, nullptr, nullptr, scr, r, lane_);
    }
}
__device__ __forceinline__ void p0_prologue(Frame& F, const Args& A, const int parts) {
    const int lane_ = pg8::lane_id_asm();
    const int gw = F.vcu * NWAVES + F.wave, NGW = F.G * NWAVES;
    if (parts & 1) weight_copies(F, 0, T_EARLY);
    { const v4u z = {0u, 0u, 0u, 0u}; GAS v4u* zp = (GAS v4u*)(F.ws + CT_ZERO_LO);
      for (int i = gw * 64 + lane_; i < (int)((CT_ZERO_HI - CT_ZERO_LO) / 16); i += NGW * 64) zp[i] = z; }
    bf16* XN = (bf16*)(F.ws + WS_XN); bf16* PB = (bf16*)(F.ws + WS_PB);
    const float* xin = arg_in(0); const float* pin = arg_in(1); float* ss0 = (float*)(F.ws + CT_SS0);
    if (parts & 2)
    for (int m0 = gw; m0 < MTOK; m0 += 4 * NGW) {
        f32x4 v[4][4], pv[4];
#pragma unroll
        for (int r = 0; r < 4; ++r) { const int m = m0 + r * NGW; if (m < MTOK) {
            const GAS f32x4* xr = (const GAS f32x4*)(xin + (size_t)m * DM) + lane_;
#pragma unroll
            for (int j = 0; j < 4; ++j) v[r][j] = __builtin_nontemporal_load(xr + 64 * j);
            pv[r] = __builtin_nontemporal_load((const GAS f32x4*)(pin + (size_t)m * PLE) + lane_); } }
#pragma unroll
        for (int r = 0; r < 4; ++r) { const int m = m0 + r * NGW; if (m < MTOK) {
            float s = 0.f;
#pragma unroll
            for (int j = 0; j < 4; ++j) s += (v[r][j].x * v[r][j].x + v[r][j].y * v[r][j].y) + (v[r][j].z * v[r][j].z + v[r][j].w * v[r][j].w);
            const float ssum = wave_sum(s);
            if (lane_ == 0) ss0[m] = ssum;
            GAS v2u* o8 = (GAS v2u*)(XN + (size_t)m * DM) + lane_;
#pragma unroll
            for (int j = 0; j < 4; ++j) { v2u o; o.x = pk2(v[r][j].x, v[r][j].y); o.y = pk2(v[r][j].z, v[r][j].w); o8[64 * j] = o; }
            v2u po; po.x = pk2(pv[r].x, pv[r].y); po.y = pk2(pv[r].z, pv[r].w);
            *((GAS v2u*)(PB + (size_t)m * PLE) + lane_) = po; } }
    }
}

constexpr int KP = 144;
constexpr int ATT_HALF = 128 * KP, ATT_SLOT = 2 * ATT_HALF;
static_assert(4 * ATT_SLOT == LDS_BARST_OFF, "attention ring");
constexpr int ATT_ITEMS = 3 * BATCH * NH * 64;
struct AttItem { int br, b, h, d, tok_cur; bool first; };
__device__ __forceinline__ AttItem att_decode(int id) {
    AttItem I; I.br = id / 2048; int rem = id % 2048; I.b = rem / 512; rem %= 512; I.h = rem / 64; const int s = rem % 64;
    I.d = 1 << (2 * I.br); const int nb = 64 >> (2 * I.br); const int r = s / nb, n = s % nb;
    I.first = (n == 0);
    I.tok_cur = I.b * SEQ + r + I.d * (128 * n);
    return I;
}
__device__ __forceinline__ size_t qkv_off(int kind, int tok, int h) { const int b = tok >> 13, t = tok & (SEQ - 1); return ((size_t)(((kind * BATCH + b) * NH + h)) * SEQ + t) * HD; }
static_assert(SEQ == 8192, "qkv_off uses SEQ = 2^13");
__device__ __forceinline__ void att_load_blk(const bf16* PROJ, int tok0, int d, int h, int tid, v4u (&kr)[2], v4u (&vr)[2]) {
    const bf16* kb = PROJ + qkv_off(1, tok0, h); const bf16* vb = PROJ + qkv_off(2, tok0, h);
#pragma unroll
    for (int i = 0; i < 2; ++i) { const int c = tid + 512 * i, row = c >> 3, ch = c & 7;
        kr[i] = *(const GAS v4u*)(kb + (size_t)(d * row) * HD + ch * 8); vr[i] = *(const GAS v4u*)(vb + (size_t)(d * row) * HD + ch * 8); }
}
__device__ __forceinline__ void att_stage_blk(LAS unsigned char* slot, int tid, const v4u (&kr)[2], const v4u (&vr)[2]) {
#pragma unroll
    for (int i = 0; i < 2; ++i) { const int c = tid + 512 * i, row = c >> 3, ch = c & 7;
        *(LAS v4u*)(slot + row * KP + ch * 16) = kr[i]; *(LAS v4u*)(slot + ATT_HALF + row * KP + ch * 16) = vr[i]; }
}
#define LDS_BARRIER() do { asm volatile("s_waitcnt lgkmcnt(0)" ::: "memory"); __builtin_amdgcn_s_barrier(); asm volatile("" ::: "memory"); } while (0)
struct AttPref { v4u k[2], v[2]; bf16x8 q0, q1; };
__device__ __forceinline__ void att_prefetch(AttPref& R, const bf16* PROJ, int id, int tid, int w, int l15, int fq) {
    const AttItem I = att_decode(id);
    att_load_blk(PROJ, I.tok_cur, I.d, I.h, tid, R.k, R.v);
    const bf16* qp = PROJ + qkv_off(0, I.tok_cur, I.h) + (size_t)(I.d * (16 * w + l15)) * HD + 8 * fq; R.q0 = *(const GAS bf16x8*)qp; R.q1 = *(const GAS bf16x8*)(qp + 32);
}
template <bool MERGE, bool FIRST> __device__ __forceinline__ void att_item(const AttItem& C, const bf16x8 q0, const bf16x8 q1, const int pos, LAS unsigned char* lds, bf16* AO, float* LSE, bf16* GR, float* SSA,
                                                             const int w, const int l15, const int fq) {
        const int qtok = C.tok_cur + C.d * (16 * w + l15);
        v4u p1[2], p2[2]; float l1 = 0.f, l2 = 0.f;
        if (MERGE) { const bf16* a1 = AO + (size_t)MTOK * AW + (size_t)qtok * AW + C.h * HD + 8 * fq; const bf16* a2 = a1 + (size_t)MTOK * AW;
#pragma unroll
            for (int P = 0; P < 2; ++P) { p1[P] = *(const GAS v4u*)(a1 + 32 * P); p2[P] = *(const GAS v4u*)(a2 + 32 * P); }
            l1 = LSE[(size_t)MTOK * NH + (size_t)qtok * NH + C.h]; l2 = LSE[(size_t)2 * MTOK * NH + (size_t)qtok * NH + C.h]; }
        const int Pb = ((pos - 1) & 3) * ATT_SLOT, Cb = (pos & 3) * ATT_SLOT;
        int kbase[9];
#pragma unroll
        for (int kk = 0; kk < 9; ++kk) { const int kb = w + kk; kbase[kk] = (kb < 8) ? (Pb + kb * 16 * KP) : (Cb + (kb - 8) * 16 * KP); }
        f32x4 s[9];
        {
            bf16x8 ka[9][2];
#pragma unroll
            for (int kk = 0; kk < 9; ++kk) { LAS unsigned char* kp = lds + kbase[kk] + l15 * KP + 16 * fq; ka[kk][0] = *(const LAS bf16x8*)kp; ka[kk][1] = *(const LAS bf16x8*)(kp + 64); }
            __builtin_amdgcn_s_setprio(1);
#pragma unroll
            for (int kk = 0; kk < 9; ++kk) s[kk] = __builtin_amdgcn_mfma_f32_16x16x32_bf16(ka[kk][0], q0, (f32x4){0.f, 0.f, 0.f, 0.f}, 0, 0, 0);
#pragma unroll
            for (int kk = 0; kk < 9; ++kk) s[kk] = __builtin_amdgcn_mfma_f32_16x16x32_bf16(ka[kk][1], q1, s[kk], 0, 0, 0);
            __builtin_amdgcn_s_setprio(0);
        }
        const float LOG2E = 1.4426950408889634f, NEGBIG = -3.0e38f;
        const float nc2 = -LOG2E * (float)C.d * __builtin_amdgcn_exp2f(-(float)(C.h + 1));
        const int t = l15 - 4 * fq; const float bl = nc2 * (float)t;
#pragma unroll
        for (int kk = 0; kk < 9; ++kk)
#pragma unroll
            for (int j = 0; j < 4; ++j) {
                float v = __builtin_fmaf(nc2, (float)(128 - 16 * kk - j), s[kk][j] + bl);
                if (kk == 0) v = (t > j) ? NEGBIG : v;
                if (kk == 8) v = (t < j) ? NEGBIG : v;
                s[kk][j] = v; }
        if (FIRST) {
#pragma unroll
            for (int kk = 0; kk < 8; ++kk) if (w + kk < 8) s[kk] = (f32x4){NEGBIG, NEGBIG, NEGBIG, NEGBIG};
        }
        float mx = NEGBIG;
#pragma unroll
        for (int kk = 0; kk < 9; ++kk) { mx = __builtin_fmaxf(__builtin_fmaxf(mx, s[kk][0]), s[kk][1]); mx = __builtin_fmaxf(__builtin_fmaxf(mx, s[kk][2]), s[kk][3]); }
        mx = pg8::rows_max4(mx);
        float sum = 0.f;
#pragma unroll
        for (int kk = 0; kk < 9; ++kk)
#pragma unroll
            for (int j = 0; j < 4; ++j) { const float p = __builtin_amdgcn_exp2f(s[kk][j] - mx); s[kk][j] = p; sum += p; }
        sum = pg8::rows_sum4(sum);
        f32x4 o[4];
#pragma unroll
        for (int d0 = 0; d0 < 4; ++d0) o[d0] = (f32x4){0.f, 0.f, 0.f, 0.f};
#pragma unroll
        for (int pp = 0; pp < 5; ++pp) {
            const int kA = 2 * pp, kB = (pp < 4) ? 2 * pp + 1 : 2 * pp;
            const bool deadA = FIRST && (w + kA < 8), deadB = FIRST && (w + kB < 8);
            if (deadB) continue;
            v4u pw; pw.x = pk2(s[kA][0], s[kA][1]); pw.y = pk2(s[kA][2], s[kA][3]);
            if (pp < 4) { pw.z = pk2(s[kB][0], s[kB][1]); pw.w = pk2(s[kB][2], s[kB][3]); } else { pw.z = 0u; pw.w = 0u; }
            const bf16x8 pf = __builtin_bit_cast(bf16x8, pw);
            const int vrow = (4 * fq + (l15 >> 2)) * KP + 16 * (l15 & 3) + ATT_HALF;
            LAS unsigned char* vb = lds + kbase[kB] + vrow;
            LAS unsigned char* va = deadA ? vb : lds + kbase[kA] + vrow;
#pragma unroll
            for (int d0 = 0; d0 < 4; ++d0) {
                const v4i16_t lo = tr_read(va + 64 * (d0 >> 1) + 8 * (d0 & 1)), hi = tr_read(vb + 64 * (d0 >> 1) + 8 * (d0 & 1));
                const bf16x8 vf = {lo[0], lo[1], lo[2], lo[3], hi[0], hi[1], hi[2], hi[3]};
                __builtin_amdgcn_s_setprio(1); o[d0] = __builtin_amdgcn_mfma_f32_16x16x32_bf16(vf, pf, o[d0], 0, 0, 0); __builtin_amdgcn_s_setprio(0);
            }
        }
        const float inv = __builtin_amdgcn_rcpf(sum), l0 = mx + __builtin_amdgcn_logf(sum);
        if (!MERGE) {
            bf16* op = AO + (size_t)C.br * MTOK * AW + (size_t)qtok * AW + C.h * HD + 8 * fq;
#pragma unroll
            for (int P = 0; P < 2; ++P) { v4u ow; ow.x = pk2(o[2 * P][0] * inv, o[2 * P][1] * inv); ow.y = pk2(o[2 * P][2] * inv, o[2 * P][3] * inv);
                ow.z = pk2(o[2 * P + 1][0] * inv, o[2 * P + 1][1] * inv); ow.w = pk2(o[2 * P + 1][2] * inv, o[2 * P + 1][3] * inv); *(GAS v4u*)(op + 32 * P) = ow; }
            if (fq == 0) LSE[(size_t)C.br * MTOK * NH + (size_t)qtok * NH + C.h] = l0;
        } else {
            const float lm = fmaxf(l0, fmaxf(l1, l2));
            float w0 = __builtin_amdgcn_exp2f(l0 - lm), w1 = __builtin_amdgcn_exp2f(l1 - lm), w2 = __builtin_amdgcn_exp2f(l2 - lm);
            const float wi = __builtin_amdgcn_rcpf(w0 + w1 + w2); w0 *= wi * inv; w1 *= wi; w2 *= wi;
            bf16* op = GR + (size_t)qtok * DM + C.h * HD + 8 * fq; float sq = 0.f;
#pragma unroll
            for (int P = 0; P < 2; ++P) { const unsigned x1[4] = {p1[P].x, p1[P].y, p1[P].z, p1[P].w}, x2[4] = {p2[P].x, p2[P].y, p2[P].z, p2[P].w}; unsigned wv[4];
#pragma unroll
                for (int hh = 0; hh < 2; ++hh) { const int d0 = 2 * P + hh;
                    const float m0 = w0 * o[d0][0] + w1 * bflo(x1[2 * hh]) + w2 * bflo(x2[2 * hh]), m1 = w0 * o[d0][1] + w1 * bfhi(x1[2 * hh]) + w2 * bfhi(x2[2 * hh]);
                    const float m2 = w0 * o[d0][2] + w1 * bflo(x1[2 * hh + 1]) + w2 * bflo(x2[2 * hh + 1]), m3 = w0 * o[d0][3] + w1 * bfhi(x1[2 * hh + 1]) + w2 * bfhi(x2[2 * hh + 1]);
                    sq += (m0 * m0 + m1 * m1) + (m2 * m2 + m3 * m3);
                    wv[2 * hh] = pk2(m0, m1); wv[2 * hh + 1] = pk2(m2, m3); }
                v4u ow; ow.x = wv[0]; ow.y = wv[1]; ow.z = wv[2]; ow.w = wv[3]; *(GAS v4u*)(op + 32 * P) = ow; }
            sq = pg8::rows_sum4(sq);
            if (fq == 0) unsafeAtomicAdd(SSA + qtok, sq);
        }
}
template <bool MERGE> __device__ __forceinline__ void att_phase(Frame& F, const Args& A, int first_item, int n_items) {
    const bf16* PROJ = (const bf16*)(F.ws + WS_PROJ);
    bf16* AO = (bf16*)(F.ws + WS_AO); float* LSE = (float*)(F.ws + WS_LSE);
    bf16* GR = (bf16*)(F.ws + WS_GROUPS); float* SSA = (float*)(F.ws + CT_SSA);
    LAS unsigned char* lds = F.lds;
    const int lane = pg8::lane_id_asm(), w = F.wave, tid = w * 64 + lane, l15 = lane & 15, fq = lane >> 4;
    AttPref RA, RB; bf16x8 cq0, cq1;
    int pos = 1;
    { const AttItem I = att_decode(first_item);
      if (!I.first) { att_load_blk(PROJ, I.tok_cur - I.d * 128, I.d, I.h, tid, RA.k, RA.v); att_stage_blk(lds, tid, RA.k, RA.v); }
      att_prefetch(RA, PROJ, first_item, tid, w, l15, fq);
      att_stage_blk(lds + ATT_SLOT, tid, RA.k, RA.v); cq0 = RA.q0; cq1 = RA.q1; }
    if (1 < n_items) att_prefetch(RA, PROJ, first_item + 1, tid, w, l15, fq);
    if (2 < n_items) att_prefetch(RB, PROJ, first_item + 2, tid, w, l15, fq);
#define ATT_STEP(i, R) do { const AttItem C = att_decode(first_item + (i)); LDS_BARRIER(); \
        if (C.first) att_item<MERGE, true>(C, cq0, cq1, pos, lds, AO, LSE, GR, SSA, w, l15, fq); else att_item<MERGE, false>(C, cq0, cq1, pos, lds, AO, LSE, GR, SSA, w, l15, fq); \
        if ((i) + 1 < n_items) { ++pos; att_stage_blk(lds + (pos & 3) * ATT_SLOT, tid, R.k, R.v); cq0 = R.q0; cq1 = R.q1; \
            if ((i) + 3 < n_items) att_prefetch(R, PROJ, first_item + (i) + 3, tid, w, l15, fq); } } while (0)
    for (int it = 0; it < n_items; it += 2) {
        ATT_STEP(it, RA);
        if (it + 1 < n_items) ATT_STEP(it + 1, RB);
    }
#undef ATT_STEP
    LDS_BARRIER();
}

constexpr int ZP = 272;
constexpr int SGU_ITEMS = BATCH * (SEQ / CHUNK) * NG;
struct SguPref { v4u z[4]; f32x4 wa[4], wb[4]; v4u u[4]; float bs; };
__device__ __forceinline__ void sgu_prefetch(SguPref& R, const bf16* PROJ, const float* wsp, const float* bsp, int id, int tid, int w, int l15, int fq) {
    const int b = id / 256, n = (id % 256) / 4, g = id % 4, t0 = b * SEQ + n * CHUNK, c8 = tid & 15, i_loc = 16 * w + l15, nks = (w >> 1) + 1;
#pragma unroll
    for (int i = 0; i < 4; ++i) R.z[i] = *(const GAS v4u*)(PROJ + (size_t)(t0 + 32 * i + (tid >> 4)) * DM + SW + g * GD + c8 * 8);
    const float* wrow = wsp + ((size_t)g * CHUNK + i_loc) * CHUNK + 8 * fq;
#pragma unroll
    for (int ks = 0; ks < 4; ++ks) if (ks < nks) { R.wa[ks] = *(const GAS f32x4*)(wrow + 32 * ks); R.wb[ks] = *(const GAS f32x4*)(wrow + 32 * ks + 4); }
    const bf16* up = PROJ + (size_t)(t0 + i_loc) * DM + g * GD + 8 * fq;
#pragma unroll
    for (int P = 0; P < 4; ++P) R.u[P] = *(const GAS v4u*)(up + 32 * P);
    R.bs = bsp[g * CHUNK + i_loc];
}
__device__ __forceinline__ void sgu_item(const SguPref& R, int id, LAS unsigned char* lds, bf16* GR, float* SSS, const f32x4 g0, const f32x4 g1, const f32x4 b0, const f32x4 b1, int tid, int w, int l15, int fq) {
        const int b = id / 256, n = (id % 256) / 4, g = id % 4, t0 = b * SEQ + n * CHUNK, c8 = tid & 15, i_loc = 16 * w + l15, nks = (w >> 1) + 1;
#pragma unroll
        for (int i = 0; i < 4; ++i) { const int j = 32 * i + (tid >> 4);
            const v4u zw = R.z[i];
            float x[8] = {bflo(zw.x), bfhi(zw.x), bflo(zw.y), bfhi(zw.y), bflo(zw.z), bfhi(zw.z), bflo(zw.w), bfhi(zw.w)};
            float s = ((x[0] + x[1]) + (x[2] + x[3])) + ((x[4] + x[5]) + (x[6] + x[7]));
            s += __shfl_xor(s, 1); s += __shfl_xor(s, 2); s += __shfl_xor(s, 4); s += __shfl_xor(s, 8);
            const float mean = s * (1.0f / GD); float q = 0.f;
#pragma unroll
            for (int e = 0; e < 8; ++e) { x[e] -= mean; q += x[e] * x[e]; }
            q += __shfl_xor(q, 1); q += __shfl_xor(q, 2); q += __shfl_xor(q, 4); q += __shfl_xor(q, 8);
            const float rstd = __builtin_amdgcn_rsqf(q * (1.0f / GD) + EPS);
            v4u o; o.x = pk2(x[0] * rstd * g0.x + b0.x, x[1] * rstd * g0.y + b0.y); o.y = pk2(x[2] * rstd * g0.z + b0.z, x[3] * rstd * g0.w + b0.w);
            o.z = pk2(x[4] * rstd * g1.x + b1.x, x[5] * rstd * g1.y + b1.y); o.w = pk2(x[6] * rstd * g1.z + b1.z, x[7] * rstd * g1.w + b1.w);
            *(LAS v4u*)(lds + j * ZP + c8 * 16) = o; }
        LDS_BARRIER();
        f32x4 acc[8];
#pragma unroll
        for (int cb = 0; cb < 8; ++cb) acc[cb] = (f32x4){0.f, 0.f, 0.f, 0.f};
#pragma unroll
        for (int ks = 0; ks < 4; ++ks) if (ks < nks) {
            const int j0 = 32 * ks + 8 * fq;
            const f32x4 va = R.wa[ks], vb = R.wb[ks];
            v4u ww; ww.x = pk2(j0 + 0 <= i_loc ? va.x : 0.f, j0 + 1 <= i_loc ? va.y : 0.f); ww.y = pk2(j0 + 2 <= i_loc ? va.z : 0.f, j0 + 3 <= i_loc ? va.w : 0.f);
            ww.z = pk2(j0 + 4 <= i_loc ? vb.x : 0.f, j0 + 5 <= i_loc ? vb.y : 0.f); ww.w = pk2(j0 + 6 <= i_loc ? vb.z : 0.f, j0 + 7 <= i_loc ? vb.w : 0.f);
            const bf16x8 wf = __builtin_bit_cast(bf16x8, ww);
            LAS unsigned char* zp = lds + (32 * ks + 8 * fq + (l15 >> 2)) * ZP + 16 * (l15 & 3);
#pragma unroll
            for (int cb = 0; cb < 8; ++cb) {
                const v4i16_t lo = tr_read(zp + 64 * (cb >> 1) + 8 * (cb & 1)), hi = tr_read(zp + 4 * ZP + 64 * (cb >> 1) + 8 * (cb & 1));
                const bf16x8 zf = {lo[0], lo[1], lo[2], lo[3], hi[0], hi[1], hi[2], hi[3]};
                acc[cb] = __builtin_amdgcn_mfma_f32_16x16x32_bf16(zf, wf, acc[cb], 0, 0, 0);
            }
        }
        const float bs = R.bs;
        bf16* op = GR + (size_t)(t0 + i_loc) * DM + AW + g * GD + 8 * fq; float sq = 0.f;
#pragma unroll
        for (int P = 0; P < 4; ++P) { const unsigned ux[4] = {R.u[P].x, R.u[P].y, R.u[P].z, R.u[P].w}; unsigned wv[4];
#pragma unroll
            for (int hh = 0; hh < 2; ++hh) { const int cb = 2 * P + hh;
                const float r0 = bflo(ux[2 * hh]) * (acc[cb][0] + bs), r1 = bfhi(ux[2 * hh]) * (acc[cb][1] + bs), r2 = bflo(ux[2 * hh + 1]) * (acc[cb][2] + bs), r3 = bfhi(ux[2 * hh + 1]) * (acc[cb][3] + bs);
                sq += (r0 * r0 + r1 * r1) + (r2 * r2 + r3 * r3);
                wv[2 * hh] = pk2(r0, r1); wv[2 * hh + 1] = pk2(r2, r3); }
            v4u ow; ow.x = wv[0]; ow.y = wv[1]; ow.z = wv[2]; ow.w = wv[3]; *(GAS v4u*)(op + 32 * P) = ow; }
        sq = pg8::rows_sum4(sq);
        if (fq == 0) unsafeAtomicAdd(SSS + t0 + i_loc, sq);
        LDS_BARRIER();
}
__device__ __forceinline__ void sgu_phase(Frame& F, const Args& A, int first_item, int n_items) {
    const bf16* PROJ = (const bf16*)(F.ws + WS_UZ); bf16* GR = (bf16*)(F.ws + WS_GROUPS); float* SSS = (float*)(F.ws + CT_SSS);
    const float* lng = arg_in(4); const float* lnb = arg_in(5); const float* wsp = arg_in(6); const float* bsp = arg_in(7);
    LAS unsigned char* lds = F.lds;
    const int lane = pg8::lane_id_asm(), w = F.wave, tid = w * 64 + lane, l15 = lane & 15, fq = lane >> 4, c8 = tid & 15;
    const f32x4 g0 = *(const GAS f32x4*)(lng + c8 * 8), g1 = *(const GAS f32x4*)(lng + c8 * 8 + 4), b0 = *(const GAS f32x4*)(lnb + c8 * 8), b1 = *(const GAS f32x4*)(lnb + c8 * 8 + 4);
    SguPref RA, RB;
    sgu_prefetch(RA, PROJ, wsp, bsp, first_item, tid, w, l15, fq);
    for (int it = 0; it < n_items; it += 2) {
        if (it + 1 < n_items) sgu_prefetch(RB, PROJ, wsp, bsp, first_item + it + 1, tid, w, l15, fq);
        sgu_item(RA, first_item + it, lds, GR, SSS, g0, g1, b0, b1, tid, w, l15, fq);
        if (it + 1 < n_items) {
            if (it + 2 < n_items) sgu_prefetch(RA, PROJ, wsp, bsp, first_item + it + 2, tid, w, l15, fq);
            sgu_item(RB, first_item + it + 1, lds, GR, SSS, g0, g1, b0, b1, tid, w, l15, fq);
        }
    }
}

#define XB_TMO      128
#define XB_XCNT(j)  (256  + 64 * (j))
#define XB_XSUB(j)  (1280 + 64 * (j))
#define XB_XGEN(j)  (2304 + 64 * (j))
#define XB_TOP      3328
#define XB_TOPGEN   3392
#define XCD_BAR_WORDS 3456
#define XB_SPIN_CAP (1u << 18)

__device__ __forceinline__ unsigned xb_ld(unsigned* p)              { return __hip_atomic_load(p, __ATOMIC_RELAXED, __HIP_MEMORY_SCOPE_AGENT); }
__device__ __forceinline__ unsigned xb_add(unsigned* p, unsigned v) { return __hip_atomic_fetch_add(p, v, __ATOMIC_RELAXED, __HIP_MEMORY_SCOPE_AGENT); }
__device__ __forceinline__ unsigned xb_xcc_id() { return (unsigned)__builtin_amdgcn_s_getreg((3 << 11) | 20) & 0xFu; }
#define XB_SPIN(cond, bar) do { unsigned _sp = 0; while (cond) { __builtin_amdgcn_s_sleep(1); \
    if ((++_sp & 255u) == 0u) { if (xb_ld(&(bar)[XB_TMO])) break; if (_sp > XB_SPIN_CAP) { atomicAdd(&(bar)[XB_TMO], 1u); break; } } } } while (0)

struct XcdBarrier {
    unsigned* bar; unsigned x;
    volatile LAS unsigned* st;
};

__device__ __forceinline__ XcdBarrier xcd_barrier_post(unsigned* bar, volatile LAS unsigned* st, bool leader) {
    XcdBarrier b; b.bar = bar; b.x = xb_xcc_id(); b.st = st;
    if (leader) (void)xb_add(&bar[XB_XCNT(b.x)], 1u);
    return b;
}
__device__ __forceinline__ void xcd_barrier_complete(unsigned* bar, unsigned x, unsigned& nloc, unsigned& nx) {
    const unsigned G = gridDim.x * gridDim.y * gridDim.z;
    unsigned sum, cnt, mine, sp = 0u;
    for (;;) {
        sum = 0u; cnt = 0u; mine = 0u;
#pragma unroll
        for (unsigned j = 0; j < 16; ++j) { const unsigned c = xb_ld(&bar[XB_XCNT(j)]); sum += c; cnt += (c > 0u) ? 1u : 0u; mine = (j == x) ? c : mine; }
        if (sum == G) break;
        __builtin_amdgcn_s_sleep(1);
        if ((++sp & 255u) == 0u) { if (xb_ld(&bar[XB_TMO])) break; if (sp > XB_SPIN_CAP) { atomicAdd(&bar[XB_TMO], 1u); break; } }
    }
    nloc = mine > 0u ? mine : 1u; nx = cnt > 0u ? cnt : 1u;
}

__device__ __forceinline__ void xcd_barrier(const XcdBarrier& b, const int wave) {
    asm volatile("s_waitcnt vmcnt(0)" ::: "memory");
    __syncthreads();
    bool leader_ = false; if (wave == 0) leader_ = (pg8::lane_id_asm() == 0);
    if (leader_) {
        unsigned* bar = b.bar;
        __builtin_amdgcn_s_waitcnt(0);
        unsigned nloc = b.st[0], nx = b.st[1];
        if (nloc == 0u) { xcd_barrier_complete(bar, b.x, nloc, nx); b.st[0] = nloc; b.st[1] = nx; }
        const unsigned old = xb_add(&bar[XB_XSUB(b.x)], 1u);
        const unsigned gen = old / nloc;
        if (old + 1u == (gen + 1u) * nloc) {
            __builtin_amdgcn_fence(__ATOMIC_RELEASE, "agent");
            asm volatile("s_waitcnt vmcnt(0)" ::: "memory");
            const unsigned og = xb_add(&bar[XB_TOP], 1u);
            const unsigned tg = og / nx;
            if (og + 1u == (tg + 1u) * nx) xb_add(&bar[XB_TOPGEN], 1u);
            else XB_SPIN(xb_ld(&bar[XB_TOPGEN]) == tg, bar);
            __builtin_amdgcn_fence(__ATOMIC_ACQUIRE, "agent");
            xb_add(&bar[XB_XGEN(b.x)], 1u);
            asm volatile("s_waitcnt vmcnt(0)" ::: "memory");
        } else {
            XB_SPIN(xb_ld(&bar[XB_XGEN(b.x)]) == gen, bar);
            __builtin_amdgcn_fence(__ATOMIC_ACQUIRE, "agent");
            asm volatile("s_waitcnt vmcnt(0)" ::: "memory");
        }
    }
    __syncthreads();
}


struct RangeOrder {
    pg8::StaticOrder b; int lo, n;
    __device__ __forceinline__ bool next(int i, pg8::Unit& u) const { return i < n && b.next(i + lo, u); }
    __device__ __forceinline__ void a_ready(const pg8::Unit&) const {}
    __device__ __forceinline__ void done(const pg8::Unit&) const {}
};
__device__ __forceinline__ void grid_bar(unsigned* ctr, unsigned target, int wave) {
    asm volatile("s_waitcnt vmcnt(0)" ::: "memory");
    __syncthreads();
    if (wave == 0) {
        if (pg8::lane_id_asm() == 0) {
            __builtin_amdgcn_fence(__ATOMIC_RELEASE, "agent");
            asm volatile("s_waitcnt vmcnt(0)" ::: "memory");
            __hip_atomic_fetch_add(ctr, 1u, __ATOMIC_RELAXED, __HIP_MEMORY_SCOPE_AGENT);
            while (__hip_atomic_load(ctr, __ATOMIC_RELAXED, __HIP_MEMORY_SCOPE_AGENT) < target) __builtin_amdgcn_s_sleep(2);
            __builtin_amdgcn_fence(__ATOMIC_ACQUIRE, "agent");
            asm volatile("s_waitcnt vmcnt(0)" ::: "memory");
        }
    }
    __syncthreads();
}

__global__ void __launch_bounds__(NWAVES * 64, 2) mk_fwd(Args args) {
    extern __shared__ __attribute__((aligned(16))) unsigned char lds_raw[];
    cg::grid_group grid = cg::this_grid();
    Frame F;
    F.lds = (LAS unsigned char*)lds_raw;
    F.wave = __builtin_amdgcn_readfirstlane(threadIdx.x >> 6);
    F.G = gridDim.x; { const int bx = blockIdx.x; F.vcu = (F.G % 8 == 0) ? (bx % 8) * (F.G / 8) + bx / 8 : bx; }
    F.out = args.out; F.ws = args.ws;
#ifndef REPEAT_MASK
#define REPEAT_MASK 0
#endif
#define REPS(k) ((((REPEAT_MASK) >> (k)) & 1) ? 2 : 1)
    unsigned* const bar_ctr = (unsigned*)F.ws;
    unsigned epoch = 0;
    volatile LAS unsigned* barst = (volatile LAS unsigned*)(F.lds + LDS_BARST_OFF);
    if (threadIdx.x < 2) barst[threadIdx.x] = 0u;
    if (blockIdx.x == 0) { unsigned* xw = (unsigned*)(F.ws + CT_XBAR); for (int i = threadIdx.x; i < XCD_BAR_WORDS; i += NWAVES * 64) __hip_atomic_store(xw + i, 0u, __ATOMIC_RELAXED, __HIP_MEMORY_SCOPE_AGENT); }
    grid.sync();
    XcdBarrier xbar; { bool ld_ = false; if (F.wave == 0) ld_ = (pg8::lane_id_asm() == 0); xbar = xcd_barrier_post((unsigned*)(F.ws + CT_XBAR), barst, ld_); }
#ifndef PROBE_PHASE
#define PROBE_PHASE -1
#endif
#ifndef P0_SPLIT
#define P0_SPLIT 0
#endif
    unsigned long long tp0 = 0;
#define PROBE_MARK(k) do { if (PROBE_PHASE == (k)) tp0 = __builtin_amdgcn_s_memrealtime(); \
        if (PROBE_PHASE >= 0 && PROBE_PHASE + 1 == (k)) { const unsigned long long t1_ = __builtin_amdgcn_s_memrealtime(), d_ = (t1_ - tp0) * 4; while (__builtin_amdgcn_s_memrealtime() - t1_ < d_) __builtin_amdgcn_s_sleep(8); } } while (0)
#define SEAM() do { ++epoch; xcd_barrier(xbar, F.wave); } while (0)
    const pg8::bf16_t* XN = (const pg8::bf16_t*)(F.ws + WS_XN);

    PROBE_MARK(0);
    for (int rep_ = 0; rep_ < REPS(0); ++rep_) { if (blockIdx.x == 0 && threadIdx.x == 0) __hip_atomic_store(bar_ctr, 0u, __ATOMIC_RELAXED, __HIP_MEMORY_SCOPE_AGENT); p0_prologue(F, args, P0_SPLIT ? 1 : 3); }
    SEAM();
    if (P0_SPLIT) { PROBE_MARK(9); p0_prologue(F, args, 2); SEAM(); PROBE_MARK(10); }
    PROBE_MARK(1);
    {
        weight_copies(F, T_EARLY, T_EARLY + TI2); __syncthreads();
        const pg8::Gemm g1{XN, (const pg8::bf16_t*)(F.ws + WS_W1), MTOK, PC, DM}; pg8::StaticOrder S1; S1.init(MTOK, PC, F.G, (int)blockIdx.x);
        const pg8::EpiBf16M<1> E1{(pg8::bf16_t*)(F.ws + WS_PROJ), PC, (const float*)(F.ws + CT_SS0)};
        pg8::gemm_phase<pg8::EpiBf16M<1>, pg8::StaticOrder, true, true>(F.lds, g1, S1, E1, F.wave);
    }
    SEAM();
    PROBE_MARK(2);
    for (int rep_ = 0; rep_ < REPS(2); ++rep_) {
        constexpr int N2A = ATT_ITEMS - 2048; const int per = (N2A + F.G - 1) / F.G; const int f0 = F.vcu * per; int n = N2A - f0; n = n < 0 ? 0 : (n > per ? per : n);
        if (n > 0) att_phase<false>(F, args, 2048 + f0, n);
    }
    SEAM();
    PROBE_MARK(3);
    {
        { const int per = (2048 + F.G - 1) / F.G; const int f0 = F.vcu * per; int n = 2048 - f0; n = n < 0 ? 0 : (n > per ? per : n); PROBE_MARK(13); if (n > 0) att_phase<true>(F, args, f0, n); }
        __syncthreads();
        PROBE_MARK(14);
        { const int per = (SGU_ITEMS + F.G - 1) / F.G; const int f0 = F.vcu * per; int n = SGU_ITEMS - f0; n = n < 0 ? 0 : (n > per ? per : n); if (n > 0) sgu_phase(F, args, f0, n); }
    }
    SEAM();
    PROBE_MARK(4);
    {
        pg8::Gemm g{(const pg8::bf16_t*)(F.ws + WS_GROUPS), (const pg8::bf16_t*)(F.ws + WS_W2), MTOK, DM, DM}; pg8::StaticOrder S; S.init(MTOK, DM, F.G, (int)blockIdx.x);
        pg8::EpiResNorm<true> E{(pg8::bf16_t*)(F.ws + WS_XN), arg_in(11), (float*)(F.ws + CT_SS1), (unsigned*)(F.ws + CT_CNT1), (float*)(F.ws + CT_SS2), DM, (const float*)(F.ws + CT_SSA), (const float*)(F.ws + CT_SSS)};
        pg8::gemm_phase<pg8::EpiResNorm<true>, pg8::StaticOrder, true, true>(F.lds, g, S, E, F.wave);
        weight_copies(F, T_EARLY + TI2, T_ALL);
    }
    SEAM();
    PROBE_MARK(5);
    {
        const pg8::Gemm g3{XN, (const pg8::bf16_t*)(F.ws + WS_W3), MTOK, 2 * DFF, DM}; pg8::StaticOrder S3; S3.init(MTOK, 2 * DFF, F.G, (int)blockIdx.x);
        const pg8::EpiSwiglu E3{(pg8::bf16_t*)(F.ws + WS_ACT), DFF, (const float*)(F.ws + CT_SS2)};
        pg8::gemm_phase<pg8::EpiSwiglu, pg8::StaticOrder, true, true>(F.lds, g3, S3, E3, F.wave);
    }
    SEAM();
    PROBE_MARK(6);
    {
        pg8::Gemm g{(const pg8::bf16_t*)(F.ws + WS_ACT), (const pg8::bf16_t*)(F.ws + WS_W4), MTOK, DM, DFF}; pg8::StaticOrder S; S.init(MTOK, DM, F.G, (int)blockIdx.x);
        pg8::EpiResNorm<false> E{(pg8::bf16_t*)(F.ws + WS_XN), arg_in(15), (float*)(F.ws + CT_SS3), (unsigned*)(F.ws + CT_CNT3), nullptr, DM, nullptr, nullptr};
        pg8::gemm_phase<pg8::EpiResNorm<false>, pg8::StaticOrder, true, true>(F.lds, g, S, E, F.wave);
    }
    {
        const pg8::Gemm g2{(const pg8::bf16_t*)(F.ws + WS_PB), (const pg8::bf16_t*)(F.ws + WS_W6), MTOK, DM, PLE}; pg8::StaticOrder S2; S2.init(MTOK, DM, F.G, (int)blockIdx.x);
        const pg8::EpiBf16M<0> E2{(pg8::bf16_t*)(F.ws + WS_PE), DM, nullptr};
        pg8::gemm_phase<pg8::EpiBf16M<0>, pg8::StaticOrder, true, true>(F.lds, g2, S2, E2, F.wave);
    }
    SEAM();
    PROBE_MARK(7);
    for (int rep_ = 0; rep_ < REPS(9); ++rep_) {
        pg8::Gemm g{XN, (const pg8::bf16_t*)(F.ws + WS_W5), MTOK, DM, DM}; pg8::StaticOrder S; S.init(MTOK, DM, F.G, (int)blockIdx.x);
        pg8::EpiFinal E{XN, (const pg8::bf16_t*)(F.ws + WS_PE), arg_in(17), F.out, DM};
        pg8::gemm_phase<pg8::EpiFinal, pg8::StaticOrder, true, true>(F.lds, g, S, E, F.wave);
    }
    PROBE_MARK(8);
#undef SEAM
}

extern "C" void kernel_launch(void* const* d_in, const int* in_sizes, int n_in, void* d_out, int out_size, void* d_ws, size_t ws_size, hipStream_t stream) {
    static int grid = 0;
    if (grid == 0) {
        if (n_in != 19 || in_sizes[0] != MTOK * DM || out_size != MTOK * DM || ws_size < WS_END) { fprintf(stderr, "kernel_launch: unexpected shapes (n_in %d, in0 %d, out %d, ws %zu); nothing launched\n", n_in, n_in > 0 ? in_sizes[0] : -1, out_size, ws_size); grid = -1; return; }
        int dev = 0, cus = 0, per_cu = 0;
        if (hipGetDevice(&dev) != hipSuccess || hipDeviceGetAttribute(&cus, hipDeviceAttributeMultiprocessorCount, dev) != hipSuccess) { grid = -1; return; }
        if (hipFuncSetAttribute((const void*)mk_fwd, hipFuncAttributeMaxDynamicSharedMemorySize, LDS_BYTES) != hipSuccess) { fprintf(stderr, "kernel_launch: hipFuncSetAttribute failed\n"); grid = -1; return; }
        if (hipOccupancyMaxActiveBlocksPerMultiprocessor(&per_cu, (const void*)mk_fwd, NWAVES * 64, LDS_BYTES) != hipSuccess || per_cu < 1) { fprintf(stderr, "kernel_launch: occupancy query says %d\n", per_cu); per_cu = 1; }
        (void)hipGetLastError();
        grid = cus;
    }
    if (grid < 0) return;
    Args a{};
    for (int i = 0; i < 19; ++i) a.in[i] = (const float*)d_in[i];
    a.out = (float*)d_out; a.ws = (unsigned char*)d_ws;
    a.ph_lo = 0; a.ph_hi = N_PHASES;
    void* params[] = {&a};
    hipError_t e = hipLaunchCooperativeKernel((const void*)mk_fwd, dim3(grid), dim3(NWAVES * 64), params, LDS_BYTES, stream);
    if (e != hipSuccess) fprintf(stderr, "kernel_launch: cooperative launch failed: %s (grid %d)\n", hipGetErrorString(e), grid);
}
```

```cpp
#include <hip/hip_runtime.h>
#include <hip/hip_cooperative_groups.h>
#include <cstdio>
#include <cstdint>
namespace cg = cooperative_groups;
namespace pg8 {
#define PG8_LAS __attribute__((address_space(3)))
typedef unsigned short bf16_t;
typedef short bf16x8 __attribute__((ext_vector_type(8)));
typedef float f32x4 __attribute__((ext_vector_type(4)));
typedef unsigned u32x4 __attribute__((ext_vector_type(4)));
constexpr int BM = 256, BK = 64, HALF = 128, HTB = HALF * BK * 2  , STAGE_BYTES = 8 * HTB, NXCD = 8, WGM = 8;

__host__ __device__ __forceinline__ int lds_byte(int r, int c) { const int st = (r >> 4) * 2 + (c >> 5), rr = r & 15, cc = c & 31, ob = rr * 64 + cc * 2; return st * 1024 + (ob ^ (((ob >> 9) & 1) << 5)); }
__host__ __device__ __forceinline__ void stage_rc(int b, int& R, int& C) { const int st = b / 1024, sb = b % 1024, swz = sb ^ (((sb >> 9) & 1) << 5); R = (st >> 1) * 16 + swz / 64; C = (st & 1) * 32 + (swz % 64) / 2; }
__host__ __device__ __forceinline__ int perm32(int rho) { const int n = rho >> 4, i = rho & 15; return 8 * (i >> 2) + 4 * n + (i & 3); }

struct Unit { int pm, pn; };
struct Gemm { const bf16_t* A; const bf16_t* Bt; int M, N, K; };

struct StaticOrder {
    int nM, nN, nwg, G, c;
    __host__ __device__ void init(int M, int N, int G_, int c_) { nM = M / BM; nN = N / BM; nwg = nM * nN; G = G_; c = c_; }
    __host__ __device__ bool next(int i, Unit& u) const {
        const long L = (long)i * G + c; if (L >= nwg) return false;
        int wgid = (int)L; { const int q = nwg / NXCD, r = nwg % NXCD, xcd = wgid % NXCD, off = wgid / NXCD; wgid = (xcd < r ? xcd * (q + 1) : r * (q + 1) + (xcd - r) * q) + off; }
        const int nig = WGM * nN, gid = wgid / nig, fm = gid * WGM, gsz = (nM - fm) < WGM ? (nM - fm) : WGM;
        u.pm = fm + ((wgid % nig) % gsz); u.pn = (wgid % nig) / gsz; return true;
    }
    __device__ __forceinline__ void a_ready(const Unit&) const {}
    __device__ __forceinline__ void done(const Unit&) const {}
};

__device__ __forceinline__ unsigned cvt_pk_bf16(float lo, float hi) { unsigned r; asm volatile("v_cvt_pk_bf16_f32 %0, %1, %2" : "=v"(r) : "v"(lo), "v"(hi)); return r; }
typedef unsigned u32x2 __attribute__((ext_vector_type(2)));
__device__ __forceinline__ int lane_id_asm() { int l; asm volatile("v_mbcnt_lo_u32_b32 %0, -1, 0\n\tv_mbcnt_hi_u32_b32 %0, -1, %0" : "=v"(l)); return l; }
__device__ __forceinline__ float gelu_tanh(float x) {
    const float u = 0.7978845608028654f * (x + 0.044715f * x * x * x);
    const float e = __builtin_amdgcn_exp2f(-2.885390081777927f * u);
    return x * __builtin_amdgcn_rcpf(1.0f + e);
}
__device__ __forceinline__ float rows_sum4(float q) {
    auto a = __builtin_amdgcn_permlane16_swap(__float_as_uint(q), __float_as_uint(q), false, false); q = __uint_as_float(a[0]) + __uint_as_float(a[1]);
    auto b = __builtin_amdgcn_permlane32_swap(__float_as_uint(q), __float_as_uint(q), false, false); return __uint_as_float(b[0]) + __uint_as_float(b[1]);
}
__device__ __forceinline__ float rows_max4(float q) {
    auto a = __builtin_amdgcn_permlane16_swap(__float_as_uint(q), __float_as_uint(q), false, false); q = __builtin_fmaxf(__uint_as_float(a[0]), __uint_as_float(a[1]));
    auto b = __builtin_amdgcn_permlane32_swap(__float_as_uint(q), __float_as_uint(q), false, false); return __builtin_fmaxf(__uint_as_float(b[0]), __uint_as_float(b[1]));
}
typedef float f32x2 __attribute__((ext_vector_type(2)));
__device__ __forceinline__ f32x2 sigmoid_pk(f32x2 x) { const f32x2 t = x * -1.4426950408889634f; f32x2 e; e.x = __builtin_amdgcn_exp2f(t.x); e.y = __builtin_amdgcn_exp2f(t.y);
    const f32x2 d = e + 1.0f; f32x2 r; r.x = __builtin_amdgcn_rcpf(d.x); r.y = __builtin_amdgcn_rcpf(d.y); return r; }
__device__ __forceinline__ f32x2 gelu_tanh_pk(f32x2 x) { const f32x2 x2 = x * x; const f32x2 u = x * (x2 * (0.044715f * 0.7978845608028654f) + 0.7978845608028654f);
    const f32x2 t = u * -2.885390081777927f; f32x2 e; e.x = __builtin_amdgcn_exp2f(t.x); e.y = __builtin_amdgcn_exp2f(t.y);
    const f32x2 d = e + 1.0f; f32x2 r; r.x = __builtin_amdgcn_rcpf(d.x); r.y = __builtin_amdgcn_rcpf(d.y); return x * r; }
__device__ __forceinline__ float sigmoid_f(float x) { return __builtin_amdgcn_rcpf(1.0f + __builtin_amdgcn_exp2f(-1.4426950408889634f * x)); }

constexpr int ROWTAB_OFF = 8 * HTB;
template <int MODE> struct EpiBf16M {
    static constexpr bool PERM = true, AFTER_DRAIN = false, MIDSCALE = false, ROWTAB = (MODE == 1);
    __device__ __forceinline__ float row_prefetch(const Unit& u, int tid) const { return (tid < 256) ? ss[u.pm * BM + tid] : 0.f; }
    __device__ __forceinline__ void row_commit(float v, PG8_LAS unsigned char* lds, int tid, int ui) const { if (tid < 256) *(PG8_LAS float*)(lds + ROWTAB_OFF + (ui & 1) * 1024 + tid * 4) = __builtin_amdgcn_rsqf(v * (1.0f / 1024.0f) + 1e-6f); }
    __device__ __forceinline__ void epi(const f32x4 (&acc)[2][2][4][2], const Unit& u, int wr, int wc, int fr, int fq, PG8_LAS unsigned char* lds, int ui) const { run(acc, u, wr, wc, fr, fq, lds + ROWTAB_OFF + (ui & 1) * 1024 + (wr * 64 + fr) * 4); }
    __device__ __forceinline__ void operator()(const f32x4 (&acc)[2][2][4][2], const Unit& u, int wr, int wc, int fr, int fq) const { run(acc, u, wr, wc, fr, fq, nullptr); }
    bf16_t* O; int ldc; const float* ss;
    __device__ __forceinline__ void run(const f32x4 (&acc)[2][2][4][2], const Unit& u, int wr, int wc, int fr, int fq, PG8_LAS unsigned char* tab) const {
        const int row0 = u.pm * BM + wr * 64 + fr, col0 = u.pn * BM + wc * 32 + 8 * fq;
        const int mode = (MODE == 1) ? (u.pn < 2 ? 1 : (u.pn >= 6 ? 2 : 0)) : 0;
#pragma unroll
        for (int ai = 0; ai < 2; ++ai)
#pragma unroll
            for (int m = 0; m < 4; ++m) { const int row = row0 + ai * HALF + m * 16; bf16_t* rowp = O + (size_t)row * ldc + col0; size_t bjstep = HALF;
                if (MODE == 1) {
                    if (u.pn < 6) { const int kind = u.pn >> 1, ck = (u.pn & 1) * 256 + wc * 32 + 8 * fq, b = row >> 13, t = row & 8191;
                        rowp = O + ((size_t)(((kind * 4 + b) * 8 + (ck >> 6))) * 8192 + t) * 64 + (ck & 63); bjstep = (size_t)2 * 8192 * 64; }
                    else rowp = O + (size_t)48 * 1048576 + (size_t)row * 1024 + (u.pn - 6) * 256 + wc * 32 + 8 * fq; }
                float rs = 1.0f;
                if (MODE == 1) { rs = *(const PG8_LAS float*)(tab + (ai * HALF + m * 16) * 4); if (mode == 1) rs *= 0.125f * 1.4426950408889634f; }
#pragma unroll
                for (int bj = 0; bj < 2; ++bj) { f32x4 v0 = acc[ai][bj][m][0], v1 = acc[ai][bj][m][1];
                    if (MODE == 1) { v0 = v0 * rs; v1 = v1 * rs; }
                    if (false) { }
                    else if (mode == 2) {
#pragma unroll
                        for (int e = 0; e < 4; e += 2) { const f32x2 a = gelu_tanh_pk((f32x2){v0[e], v0[e + 1]}), b = gelu_tanh_pk((f32x2){v1[e], v1[e + 1]}); v0[e] = a.x; v0[e + 1] = a.y; v1[e] = b.x; v1[e + 1] = b.y; } }
                    u32x4 w; w.x = cvt_pk_bf16(v0[0], v0[1]); w.y = cvt_pk_bf16(v0[2], v0[3]); w.z = cvt_pk_bf16(v1[0], v1[1]); w.w = cvt_pk_bf16(v1[2], v1[3]);
                    *(u32x4*)(rowp + bj * bjstep) = w; } }
    }
};
struct EpiSwiglu {
    static constexpr bool PERM = true, AFTER_DRAIN = false, MIDSCALE = false, ROWTAB = true;
    __device__ __forceinline__ float row_prefetch(const Unit& u, int tid) const { return (tid < 256) ? ss[u.pm * BM + tid] : 0.f; }
    __device__ __forceinline__ void row_commit(float v, PG8_LAS unsigned char* lds, int tid, int ui) const { if (tid < 256) *(PG8_LAS float*)(lds + ROWTAB_OFF + (ui & 1) * 1024 + tid * 4) = __builtin_amdgcn_rsqf(v * (1.0f / 1024.0f) + 1e-6f); }
    bf16_t* O; int ldc; const float* ss;
    __device__ __forceinline__ void epi(const f32x4 (&acc)[2][2][4][2], const Unit& u, int wr, int wc, int fr, int fq, PG8_LAS unsigned char* lds, int ui) const {
        PG8_LAS unsigned char* tab = lds + ROWTAB_OFF + (ui & 1) * 1024 + (wr * 64 + fr) * 4;
        const int row0 = u.pm * BM + wr * 64 + fr, col0 = u.pn * HALF + wc * 32 + 8 * fq;
#pragma unroll
        for (int ai = 0; ai < 2; ++ai)
#pragma unroll
            for (int m = 0; m < 4; ++m) { const int row = row0 + ai * HALF + m * 16; bf16_t* rowp = O + (size_t)row * ldc + col0;
                const float r2 = *(const PG8_LAS float*)(tab + (ai * HALF + m * 16) * 4);
                f32x4 r0, r1;
#pragma unroll
                for (int e = 0; e < 4; e += 2) { const f32x2 g0 = (f32x2){acc[ai][0][m][0][e], acc[ai][0][m][0][e + 1]} * r2, g1 = (f32x2){acc[ai][0][m][1][e], acc[ai][0][m][1][e + 1]} * r2;
                    const f32x2 u0 = (f32x2){acc[ai][1][m][0][e], acc[ai][1][m][0][e + 1]} * r2, u1 = (f32x2){acc[ai][1][m][1][e], acc[ai][1][m][1][e + 1]} * r2;
                    const f32x2 o0 = (g0 * u0) * sigmoid_pk(g0), o1 = (g1 * u1) * sigmoid_pk(g1);
                    r0[e] = o0.x; r0[e + 1] = o0.y; r1[e] = o1.x; r1[e + 1] = o1.y; }
                u32x4 w; w.x = cvt_pk_bf16(r0[0], r0[1]); w.y = cvt_pk_bf16(r0[2], r0[3]); w.z = cvt_pk_bf16(r1[0], r1[1]); w.w = cvt_pk_bf16(r1[2], r1[3]);
                *(u32x4*)rowp = w; }
    }
};
template <bool SS2> struct EpiResNorm {
    static constexpr bool PERM = true, AFTER_DRAIN = false, MIDSCALE = SS2, ROWTAB = false;
    bf16_t* HB; const float* gain; float* ss1; unsigned* cnt; float* ss2; int ldc; const float* ssa; const float* sss;
    static constexpr int RATIO_OFF = 8 * HTB;
    __device__ __forceinline__ void unit_begin(const Unit& u, PG8_LAS unsigned char* lds, int tid, int ui) const {
        if (tid < 256) { const int row = u.pm * BM + tid;
            const float ra = __builtin_amdgcn_rsqf(ssa[row] * (1.0f / 512.0f) + 1e-6f), rs = __builtin_amdgcn_rsqf(sss[row] * (1.0f / 512.0f) + 1e-6f);
            *(PG8_LAS float*)(lds + RATIO_OFF + (ui & 1) * 1024 + tid * 4) = ra * __builtin_amdgcn_rcpf(rs); }
    }
    __device__ __forceinline__ void midscale(f32x4 (&acc)[2][2][4][2], PG8_LAS unsigned char* lds, int wr, int fr, int ui) const {
        PG8_LAS unsigned char* tp = lds + RATIO_OFF + (ui & 1) * 1024 + (wr * 64 + fr) * 4;
#pragma unroll
        for (int ai = 0; ai < 2; ++ai)
#pragma unroll
            for (int m = 0; m < 4; ++m) { const float ratio = *(const PG8_LAS float*)(tp + (ai * HALF + m * 16) * 4);
#pragma unroll
                for (int bj = 0; bj < 2; ++bj)
#pragma unroll
                    for (int n = 0; n < 2; ++n) acc[ai][bj][m][n] = acc[ai][bj][m][n] * ratio;
                asm volatile("" ::: "memory"); }
    }
    __device__ __forceinline__ void operator()(f32x4 (&acc)[2][2][4][2], const Unit& u, int wr, int wc, int fr, int fq) const {
        const int row0 = u.pm * BM + wr * 64 + fr, col0 = u.pn * BM + wc * 32 + 8 * fq;
        if (SS2) {
#pragma unroll
            for (int ai = 0; ai < 2; ++ai)
#pragma unroll
                for (int m = 0; m < 4; ++m) { const float rs = __builtin_amdgcn_rsqf(sss[row0 + ai * HALF + m * 16] * (1.0f / 512.0f) + 1e-6f);
#pragma unroll
                    for (int bj = 0; bj < 2; ++bj)
#pragma unroll
                        for (int n = 0; n < 2; ++n) acc[ai][bj][m][n] = acc[ai][bj][m][n] * rs; }
        }
        u32x4 pre[4][2];
#pragma unroll
        for (int m = 0; m < 4; ++m)
#pragma unroll
            for (int bj = 0; bj < 2; ++bj) pre[m][bj] = *(const u32x4*)(HB + (size_t)(row0 + m * 16) * ldc + col0 + bj * HALF);
#pragma unroll
        for (int ai = 0; ai < 2; ++ai)
#pragma unroll
            for (int m = 0; m < 4; ++m) { float q = 0.f;
#pragma unroll
                for (int bj = 0; bj < 2; ++bj)
#pragma unroll
                    for (int n = 0; n < 2; ++n) { const f32x4 x = acc[ai][bj][m][n]; q += (x[0] * x[0] + x[1] * x[1]) + (x[2] * x[2] + x[3] * x[3]); }
                q = rows_sum4(q);
                if (fq == 0) unsafeAtomicAdd(ss1 + row0 + ai * HALF + m * 16, q); }
        asm volatile("s_waitcnt vmcnt(0)" ::: "memory");
        unsigned* c = cnt + 64 * u.pm;
        if (fr == 0 && fq == 0) __hip_atomic_fetch_add(c, 1u, __ATOMIC_RELAXED, __HIP_MEMORY_SCOPE_AGENT);
        f32x4 gv[2][2];
#pragma unroll
        for (int bj = 0; bj < 2; ++bj)
#pragma unroll
            for (int n = 0; n < 2; ++n) gv[bj][n] = *(const f32x4*)(gain + col0 + bj * HALF + n * 4);
        while (__hip_atomic_load(c, __ATOMIC_RELAXED, __HIP_MEMORY_SCOPE_AGENT) < 32u) __builtin_amdgcn_s_sleep(1);
        asm volatile("" ::: "memory");
        float r1[2][4];
#pragma unroll
        for (int ai = 0; ai < 2; ++ai)
#pragma unroll
            for (int m = 0; m < 4; ++m) r1[ai][m] = __hip_atomic_load(ss1 + row0 + ai * HALF + m * 16, __ATOMIC_RELAXED, __HIP_MEMORY_SCOPE_AGENT);
#pragma unroll
        for (int ai = 0; ai < 2; ++ai)
#pragma unroll
            for (int m = 0; m < 4; ++m) { const int row = row0 + ai * HALF + m * 16; const size_t off = (size_t)row * ldc + col0;
                const float rr = __builtin_amdgcn_rsqf(r1[ai][m] * (1.0f / 1024.0f) + 1e-6f);
                float q2 = 0.f;
#pragma unroll
                for (int bj = 0; bj < 2; ++bj) { const size_t o2 = off + bj * HALF;
                    const u32x4 pw = (ai == 0) ? pre[m][bj] : *(const u32x4*)(HB + o2);
                    f32x4 b0, b1; b0[0] = __uint_as_float(pw.x << 16); b0[1] = __uint_as_float(pw.x & 0xffff0000u); b0[2] = __uint_as_float(pw.y << 16); b0[3] = __uint_as_float(pw.y & 0xffff0000u);
                    b1[0] = __uint_as_float(pw.z << 16); b1[1] = __uint_as_float(pw.z & 0xffff0000u); b1[2] = __uint_as_float(pw.w << 16); b1[3] = __uint_as_float(pw.w & 0xffff0000u);
                    const f32x4 h0 = b0 + acc[ai][bj][m][0] * rr * gv[bj][0], h1 = b1 + acc[ai][bj][m][1] * rr * gv[bj][1];
                    u32x4 w; w.x = cvt_pk_bf16(h0[0], h0[1]); w.y = cvt_pk_bf16(h0[2], h0[3]); w.z = cvt_pk_bf16(h1[0], h1[1]); w.w = cvt_pk_bf16(h1[2], h1[3]); *(u32x4*)(HB + o2) = w;
                    if (SS2) q2 += ((h0[0] * h0[0] + h0[1] * h0[1]) + (h0[2] * h0[2] + h0[3] * h0[3])) + ((h1[0] * h1[0] + h1[1] * h1[1]) + (h1[2] * h1[2] + h1[3] * h1[3])); }
                if (SS2) { q2 = rows_sum4(q2); if (fq == 0) unsafeAtomicAdd(ss2 + row, q2); }
                if (m & 1) asm volatile("" ::: "memory"); }
    }
};
struct EpiF32 {
    static constexpr bool PERM = false, AFTER_DRAIN = false, MIDSCALE = false, ROWTAB = false;
    float* O; int ldc;
    __device__ __forceinline__ void operator()(const f32x4 (&acc)[2][2][4][2], const Unit& u, int wr, int wc, int fr, int fq) const {
        const int row0 = u.pm * BM + wr * 64 + fr, col0 = u.pn * BM + wc * 32 + 4 * fq;
#pragma unroll
        for (int ai = 0; ai < 2; ++ai)
#pragma unroll
            for (int m = 0; m < 4; ++m) { float* rowp = O + (size_t)(row0 + ai * HALF + m * 16) * ldc + col0;
#pragma unroll
                for (int bj = 0; bj < 2; ++bj)
#pragma unroll
                    for (int n = 0; n < 2; ++n) *(f32x4*)(rowp + bj * HALF + n * 16) = acc[ai][bj][m][n]; }
    }
};
struct EpiFinal {
    static constexpr bool PERM = true, AFTER_DRAIN = false, MIDSCALE = false, ROWTAB = false;
    const bf16_t* H2; const bf16_t* PE; const float* bias; float* O; int ldc;
    __device__ __forceinline__ void operator()(const f32x4 (&acc)[2][2][4][2], const Unit& u, int wr, int wc, int fr, int fq) const {
        const int row0 = u.pm * BM + wr * 64 + fr, col0 = u.pn * BM + wc * 32 + 8 * fq;
        f32x4 bv[2][2];
#pragma unroll
        for (int bj = 0; bj < 2; ++bj)
#pragma unroll
            for (int n = 0; n < 2; ++n) bv[bj][n] = *(const f32x4*)(bias + col0 + bj * HALF + n * 4);
#pragma unroll
        for (int ai = 0; ai < 2; ++ai)
#pragma unroll
            for (int m = 0; m < 4; ++m) { const size_t off = (size_t)(row0 + ai * HALF + m * 16) * ldc + col0;
#pragma unroll
                for (int bj = 0; bj < 2; ++bj) { const size_t o2 = off + bj * HALF;
                    const u32x4 hw = *(const u32x4*)(H2 + o2), pw = *(const u32x4*)(PE + o2);
                    const unsigned hh[4] = {hw.x, hw.y, hw.z, hw.w}, pp[4] = {pw.x, pw.y, pw.z, pw.w};
#pragma unroll
                    for (int n = 0; n < 2; ++n) { const f32x4 a = acc[ai][bj][m][n] + bv[bj][n]; f32x4 o;
                        const f32x2 s0 = sigmoid_pk((f32x2){a[0], a[1]}), s1 = sigmoid_pk((f32x2){a[2], a[3]});
                        const f32x2 h0 = {__uint_as_float(hh[2 * n] << 16), __uint_as_float(hh[2 * n] & 0xffff0000u)}, h1 = {__uint_as_float(hh[2 * n + 1] << 16), __uint_as_float(hh[2 * n + 1] & 0xffff0000u)};
                        const f32x2 p0 = {__uint_as_float(pp[2 * n] << 16), __uint_as_float(pp[2 * n] & 0xffff0000u)}, p1 = {__uint_as_float(pp[2 * n + 1] << 16), __uint_as_float(pp[2 * n + 1] & 0xffff0000u)};
                        const f32x2 o0 = h0 + s0 * p0, o1 = h1 + s1 * p1; o[0] = o0.x; o[1] = o0.y; o[2] = o1.x; o[3] = o1.y;
                        *(f32x4*)(O + o2 + 4 * n) = o; } } }
    }
};

template <class Epi, class Sched, bool ALIGN_EPI = false, bool SP2 = false>
__device__ __forceinline__ void gemm_phase(PG8_LAS unsigned char* lds, const Gemm g, const Sched& S, const Epi& E, const int wave_id) {
    const int wid = wave_id, lane = lane_id_asm(), tid = wid * 64 + lane, wr = wid >> 2, wc = wid & 3, fr = lane & 15, fq = lane >> 4;
    const int K = g.K, nt = K / BK;
    unsigned voffA[2], voffB[2];
#pragma unroll
    for (int i = 0; i < 2; ++i) { int R, C; stage_rc(tid * 16 + i * 8192, R, C); const int Rb = Epi::PERM ? ((R & ~31) + perm32(R & 31)) : R;
        voffA[i] = (unsigned)(R * K + C) * 2u; voffB[i] = (unsigned)(Rb * K + C) * 2u; }
    const size_t kstep = (size_t)(BK * 2);
    const size_t hstep = (size_t)HALF * K * 2;
    const size_t tstep = 2 * hstep;
    const unsigned ldsw = (unsigned)wid * 1024u;
    const int aoff = lds_byte(wr * 64 + fr, fq * 8), boff = lds_byte(wc * 32 + fr, fq * 8);
#define PG8_SA(b, h) (((b) * 2 + (h)) * HTB)
#define PG8_SB(b, h) ((4 + (b) * 2 + (h)) * HTB)
#define PG8_STAGE(bufoff, gbase, voff) do { _Pragma("unroll") for (int _i = 0; _i < 2; ++_i) \
        __builtin_amdgcn_global_load_lds((const unsigned*)((const char*)(gbase) + (voff)[_i]), (PG8_LAS unsigned*)(lds + (bufoff) + ldsw + _i * 8192), 16, 0, 0); } while (0)
#define PG8_LDA(dst, b, h) do { _Pragma("unroll") for (int m = 0; m < 4; ++m) _Pragma("unroll") for (int k = 0; k < 2; ++k) dst[m][k] = *(const PG8_LAS bf16x8*)(lds + PG8_SA(b, h) + aoff + m * 2048 + k * 1024); } while (0)
#define PG8_LDB(dst, b, h) do { _Pragma("unroll") for (int n = 0; n < 2; ++n) _Pragma("unroll") for (int k = 0; k < 2; ++k) dst[n][k] = *(const PG8_LAS bf16x8*)(lds + PG8_SB(b, h) + boff + n * 2048 + k * 1024); } while (0)
#define PG8_MMA(ai, bj, At, Bt) do { __builtin_amdgcn_s_setprio(1); _Pragma("unroll") for (int m = 0; m < 4; ++m) _Pragma("unroll") for (int n = 0; n < 2; ++n) _Pragma("unroll") for (int k = 0; k < 2; ++k) \
        acc[ai][bj][m][n] = __builtin_amdgcn_mfma_f32_16x16x32_bf16(Bt[n][k], At[m][k], acc[ai][bj][m][n], 0, 0, 0); __builtin_amdgcn_s_setprio(0); } while (0)
#define PG8_WAIT_V(n) asm volatile("s_waitcnt vmcnt(" #n ")" ::: "memory")
#define PG8_WAIT_L(n) asm volatile("s_waitcnt lgkmcnt(" #n ")" ::: "memory")
#define PG8_BAR __builtin_amdgcn_s_barrier()
#define PG8_SCHED __builtin_amdgcn_sched_barrier(0)
    Unit cur, nxt; int ui = 0;
    if (!S.next(0, cur)) return;
    f32x4 acc[2][2][4][2];
#pragma unroll
    for (int a = 0; a < 2; ++a)
#pragma unroll
        for (int b = 0; b < 2; ++b)
#pragma unroll
            for (int m = 0; m < 4; ++m)
#pragma unroll
                for (int n = 0; n < 2; ++n) acc[a][b][m][n] = (f32x4){0.f, 0.f, 0.f, 0.f};
    bf16x8 At[4][2], B0[2][2], B1[2][2];
    const char* cA = (const char*)g.A + (size_t)cur.pm * tstep; const char* cB = (const char*)g.Bt + (size_t)cur.pn * tstep;
    S.a_ready(cur);
    if constexpr (Epi::MIDSCALE) E.unit_begin(cur, lds, tid, 0);
    if constexpr (Epi::ROWTAB) { const float v0_ = E.row_prefetch(cur, tid); E.row_commit(v0_, lds, tid, 0); }
    if constexpr (SP2) {
        PG8_STAGE(PG8_SB(0, 0), cB, voffB); PG8_STAGE(PG8_SB(0, 1), cB + hstep, voffB); PG8_STAGE(PG8_SA(0, 0), cA, voffA); PG8_STAGE(PG8_SA(0, 1), cA + hstep, voffA);
        if (wr == 1) PG8_BAR;
        PG8_WAIT_V(2); PG8_BAR;
        PG8_STAGE(PG8_SB(1, 0), cB + kstep, voffB); PG8_STAGE(PG8_SA(1, 0), cA + kstep, voffA); PG8_STAGE(PG8_SB(1, 1), cB + hstep + kstep, voffB);
        PG8_WAIT_V(6); PG8_BAR;
    } else {
        PG8_STAGE(PG8_SB(0, 0), cB, voffB); PG8_STAGE(PG8_SA(0, 0), cA, voffA); PG8_STAGE(PG8_SB(0, 1), cB + hstep, voffB); PG8_STAGE(PG8_SA(0, 1), cA + hstep, voffA);
        if (wr == 1) PG8_BAR;
        PG8_WAIT_V(4); PG8_BAR;
        PG8_STAGE(PG8_SB(1, 0), cB + kstep, voffB); PG8_STAGE(PG8_SA(1, 0), cA + kstep, voffA); PG8_STAGE(PG8_SB(1, 1), cB + hstep + kstep, voffB);
        PG8_WAIT_V(6); PG8_BAR;
    }
    for (;;) {
        const bool has_next = S.next(ui + 1, nxt);
        const char* nA = has_next ? (const char*)g.A + (size_t)nxt.pm * tstep : cA; const char* nB = has_next ? (const char*)g.Bt + (size_t)nxt.pn * tstep : cB;
        for (int t = 0; t < nt; t += 2) {
            if constexpr (Epi::MIDSCALE) { if (t == (nt >> 1)) E.midscale(acc, lds, wr, fr, ui); }
            const bool last = (t == nt - 2);
            const char* a1 = cA + (size_t)(t + 1) * kstep;
            const char* a2 = last ? nA : cA + (size_t)(t + 2) * kstep; const char* b2 = last ? nB : cB + (size_t)(t + 2) * kstep;
            const char* a3 = a2 + kstep; const char* b3 = b2 + kstep;
            if (last && has_next) S.a_ready(nxt);
            if constexpr (SP2) {
            PG8_LDB(B0, 0, 0); PG8_LDB(B1, 0, 1); PG8_SCHED; PG8_LDA(At, 0, 0); PG8_STAGE(PG8_SA(1, 1), a1 + hstep, voffA);
            PG8_WAIT_V(8); PG8_WAIT_L(0); PG8_BAR; PG8_MMA(0, 0, At, B0); PG8_MMA(0, 1, At, B1); PG8_BAR; PG8_SCHED;
            PG8_LDA(At, 0, 1); PG8_STAGE(PG8_SB(0, 0), b2, voffB); PG8_STAGE(PG8_SB(0, 1), b2 + hstep, voffB); PG8_STAGE(PG8_SA(0, 0), a2, voffA);
            PG8_WAIT_V(8); PG8_WAIT_L(0); PG8_BAR; PG8_MMA(1, 0, At, B0); PG8_MMA(1, 1, At, B1); PG8_BAR; PG8_SCHED;
            PG8_LDB(B0, 1, 0); PG8_LDB(B1, 1, 1); PG8_SCHED; PG8_LDA(At, 1, 0); PG8_STAGE(PG8_SA(0, 1), a2 + hstep, voffA);
            PG8_WAIT_V(8); PG8_WAIT_L(0); PG8_BAR; PG8_MMA(0, 0, At, B0); PG8_MMA(0, 1, At, B1); PG8_BAR; PG8_SCHED;
            PG8_LDA(At, 1, 1); PG8_STAGE(PG8_SB(1, 0), b3, voffB); PG8_STAGE(PG8_SB(1, 1), b3 + hstep, voffB); PG8_STAGE(PG8_SA(1, 0), a3, voffA);
            PG8_WAIT_V(8); PG8_WAIT_L(0); PG8_BAR; PG8_MMA(1, 0, At, B0); PG8_MMA(1, 1, At, B1); PG8_BAR; PG8_SCHED;
            } else {
            PG8_LDB(B0, 0, 0); PG8_SCHED; PG8_LDA(At, 0, 0); PG8_STAGE(PG8_SA(1, 1), a1 + hstep, voffA);
            PG8_WAIT_L(8); PG8_BAR; PG8_WAIT_L(0); PG8_MMA(0, 0, At, B0); PG8_BAR; PG8_SCHED;
            PG8_LDB(B1, 0, 1); PG8_STAGE(PG8_SB(0, 0), b2, voffB);
            PG8_BAR; PG8_WAIT_L(0); PG8_MMA(0, 1, At, B1); PG8_BAR;
            PG8_LDA(At, 0, 1); PG8_STAGE(PG8_SA(0, 0), a2, voffA);
            PG8_BAR; PG8_WAIT_L(0); PG8_MMA(1, 0, At, B0); PG8_BAR; PG8_SCHED;
            PG8_STAGE(PG8_SB(0, 1), b2 + hstep, voffB);
            PG8_WAIT_V(6); PG8_BAR; PG8_MMA(1, 1, At, B1); PG8_BAR;
            PG8_LDB(B0, 1, 0); PG8_SCHED; PG8_LDA(At, 1, 0); PG8_STAGE(PG8_SA(0, 1), a2 + hstep, voffA);
            PG8_WAIT_L(8); PG8_BAR; PG8_WAIT_L(0); PG8_MMA(0, 0, At, B0); PG8_BAR; PG8_SCHED;
            PG8_LDB(B1, 1, 1); PG8_STAGE(PG8_SB(1, 0), b3, voffB);
            PG8_BAR; PG8_WAIT_L(0); PG8_MMA(0, 1, At, B1); PG8_BAR;
            PG8_LDA(At, 1, 1); PG8_STAGE(PG8_SA(1, 0), a3, voffA);
            PG8_BAR; PG8_WAIT_L(0); PG8_MMA(1, 0, At, B0); PG8_BAR; PG8_SCHED;
            PG8_STAGE(PG8_SB(1, 1), b3 + hstep, voffB);
            PG8_WAIT_V(6); PG8_BAR; PG8_MMA(1, 1, At, B1); PG8_BAR;
            }
        }
        if constexpr (ALIGN_EPI) { if (wr == 0) PG8_BAR; }
        float rowtab_next_ = 0.f;
        if constexpr (Epi::ROWTAB) { if (has_next) rowtab_next_ = E.row_prefetch(nxt, tid); }
        if constexpr (!Epi::AFTER_DRAIN) { if constexpr (Epi::ROWTAB) E.epi(acc, cur, wr, wc, fr, fq, lds, ui); else E(acc, cur, wr, wc, fr, fq); S.done(cur); }
        if (!has_next) break;
#pragma unroll
        for (int a = 0; a < 2; ++a)
#pragma unroll
            for (int b = 0; b < 2; ++b)
#pragma unroll
                for (int m = 0; m < 4; ++m)
#pragma unroll
                    for (int n = 0; n < 2; ++n) acc[a][b][m][n] = (f32x4){0.f, 0.f, 0.f, 0.f};
        cur = nxt; cA = nA; cB = nB; ++ui;
        if constexpr (Epi::ROWTAB) E.row_commit(rowtab_next_, lds, tid, ui);
        if constexpr (Epi::MIDSCALE) E.unit_begin(cur, lds, tid, ui);
        if constexpr (ALIGN_EPI) { if (wr == 1) PG8_BAR; }
    }
    PG8_WAIT_V(0);
    if constexpr (!ALIGN_EPI) { if (wr == 0) PG8_BAR; }
    PG8_BAR;
    if constexpr (Epi::AFTER_DRAIN) { E.fused(acc, cur, wr, wc, fr, fq, lds, wid, lane); S.done(cur); }
#undef PG8_SA
#undef PG8_SB
#undef PG8_STAGE
#undef PG8_LDA
#undef PG8_LDB
#undef PG8_MMA
#undef PG8_WAIT_V
#undef PG8_WAIT_L
#undef PG8_BAR
#undef PG8_SCHED
}
}

constexpr int NWAVES = 8;
constexpr int BATCH = 4, SEQ = 8192, DM = 1024, MTOK = BATCH * SEQ, PLE = 256, AW = 512, SW = 512, HD = 64, NH = 8, NG = 4, GD = 128, CHUNK = 128, DFF = 2816, PC = 2560;
constexpr float EPS = 1e-6f;
#ifndef MK_N_LAUNCHES
#define MK_N_LAUNCHES 1
#endif
constexpr int N_PHASES = 10;

constexpr size_t MiB = 1u << 20;
constexpr size_t WS_W1 = 2 * MiB, WS_W2 = 8 * MiB, WS_W3 = 10 * MiB, WS_W4 = 22 * MiB, WS_W5 = 28 * MiB, WS_W6 = 30 * MiB;
constexpr size_t WS_XN = 32 * MiB;
constexpr size_t WS_PE = 96 * MiB;
constexpr size_t WS_PB = 160 * MiB;
constexpr size_t WS_PROJ = 176 * MiB;
constexpr size_t WS_UZ = WS_PROJ + 96 * MiB;
constexpr size_t WS_AO = 336 * MiB;
constexpr size_t WS_LSE = 432 * MiB;
constexpr size_t WS_SG = 436 * MiB;
constexpr size_t WS_GROUPS = 436 * MiB;
constexpr size_t WS_ACT = 176 * MiB;
constexpr size_t WS_END = 500 * MiB;
static_assert(WS_ACT + (size_t)MTOK * DFF * 2 <= WS_LSE && WS_GROUPS + (size_t)MTOK * DM * 2 <= WS_END && WS_LSE + 3 * (size_t)MTOK * NH * 4 <= WS_GROUPS, "ws map");
static_assert(WS_PROJ + (size_t)MTOK * PC * 2 <= WS_AO && WS_AO + 3 * (size_t)MTOK * AW * 2 <= WS_LSE, "ws map 2");
constexpr size_t CT_ZERO_LO = 4096, CT_SS1 = 4096, CT_SS2 = CT_SS1 + 131072, CT_SS3 = CT_SS2 + 131072, CT_CNT1 = 524288, CT_CNT3 = CT_CNT1 + 32768, CT_SSA = CT_CNT3 + 32768, CT_SSS = CT_SSA + 131072, CT_ZERO_HI = CT_SSS + 131072, CT_SS0 = 1048576;
static_assert(CT_SS3 + 131072 <= CT_CNT1 && CT_ZERO_HI <= CT_SS0 && CT_SS0 + 131072 <= 2 * MiB && (MTOK / 256) * 256 <= 32768, "control map");
constexpr int RING_BYTES = 131072;
constexpr int LDS_BYTES = 147456 + 256;
constexpr int LDS_BARST_OFF = 147456;
constexpr size_t CT_XBAR = 1048576 + 262144;

#define GAS __attribute__((address_space(1)))
#define LAS __attribute__((address_space(3)))
typedef unsigned short bf16;
typedef unsigned v4u __attribute__((ext_vector_type(4)));
typedef unsigned v2u __attribute__((ext_vector_type(2)));
typedef float f32x4 __attribute__((ext_vector_type(4)));
typedef short bf16x8 __attribute__((ext_vector_type(8)));
typedef short v4i16_t __attribute__((ext_vector_type(4)));
typedef float f32x2_t __attribute__((ext_vector_type(2)));
typedef __bf16 bf16x2_t __attribute__((ext_vector_type(2)));
#define LDS_WAIT() asm volatile("s_waitcnt lgkmcnt(0)" ::: "memory")
__device__ __forceinline__ unsigned pk2(float lo, float hi) { f32x2_t v = {lo, hi}; bf16x2_t b = __builtin_convertvector(v, bf16x2_t); return __builtin_bit_cast(unsigned, b); }
__device__ __forceinline__ float bflo(unsigned w) { return __uint_as_float(w << 16); }
__device__ __forceinline__ float bfhi(unsigned w) { return __uint_as_float(w & 0xffff0000u); }
__device__ __forceinline__ float wave_sum(float v) {
#pragma unroll
    for (int o = 1; o < 64; o <<= 1) v += __shfl_xor(v, o);
    return v;
}
__device__ __forceinline__ v4i16_t tr_read(LAS unsigned char* p) { return __builtin_amdgcn_ds_read_tr16_b64_v4i16((LAS v4i16_t*)p); }

struct Args { const float* in[19]; float* out; unsigned char* ws; int ph_lo, ph_hi; };
#define CAS __attribute__((address_space(4)))
__device__ __forceinline__ const float* arg_in(int i) {
    const CAS unsigned char* kp = (const CAS unsigned char*)__builtin_amdgcn_kernarg_segment_ptr();
    asm volatile("" : "+s"(kp));
    typedef const float* cfp_t;
    return *(const CAS cfp_t*)(kp + 8 * i);
}
struct Frame {
    LAS unsigned char* lds;
    int wave, vcu, G;
    float* out; unsigned char* ws;
};

__device__ __forceinline__ void p0_transpose_item(const float* W, int K, int N, bf16* WT, int mode, const float* ks0, const float* ks1, LAS float* scr, int item, int lane) {
    const int nblk = N / 32, kb = item / nblk, nb = item % nblk, k0 = 64 * kb, n0 = 32 * nb;
    constexpr int TP = 36;
    f32x4 v[8]; float sc[8];
#pragma unroll
    for (int i = 0; i < 8; ++i) { const int kk = 8 * i + (lane >> 3), kg = k0 + kk;
        v[i] = __builtin_nontemporal_load((const GAS f32x4*)(W + (size_t)kg * N + n0 + 4 * (lane & 7)));
        sc[i] = ks0 ? (kg < 512 ? ks0[kg] : ks1[kg - 512]) : 1.0f; }
#pragma unroll
    for (int i = 0; i < 8; ++i) { const int kk = 8 * i + (lane >> 3); *(LAS f32x4*)(scr + kk * TP + 4 * (lane & 7)) = v[i] * sc[i]; }
    LDS_WAIT(); asm volatile("" ::: "memory");
    int d0 = n0;
    if (mode == 1) { d0 = (n0 < DFF) ? ((n0 / 128) * 256 + (n0 % 128)) : (((n0 - DFF) / 128) * 256 + 128 + ((n0 - DFF) % 128)); }
    const int c = lane & 7;
#pragma unroll
    for (int j = 0; j < 4; ++j) { const int n = (lane >> 3) + 8 * j; const LAS float* s = scr + (8 * c) * TP + n;
        v4u o; o.x = pk2(s[0 * TP], s[1 * TP]); o.y = pk2(s[2 * TP], s[3 * TP]); o.z = pk2(s[4 * TP], s[5 * TP]); o.w = pk2(s[6 * TP], s[7 * TP]);
        *(GAS v4u*)(WT + (size_t)(d0 + n) * K + k0 + 8 * c) = o; }
    LDS_WAIT(); asm volatile("" ::: "memory");
}
constexpr int TI1 = (DM / 64) * (PC / 32), TI6 = (PLE / 64) * (DM / 32), TI2 = (DM / 64) * (DM / 32), TI3 = (DM / 64) * (2 * DFF / 32), TI4 = (DFF / 64) * (DM / 32), TI5 = TI2;
constexpr int T_EARLY = TI1 + TI6, T_ALL = TI1 + TI6 + TI2 + TI3 + TI4 + TI5;
__device__ __forceinline__ void weight_copies(Frame& F, const int it_lo, const int it_hi) {
    const int lane_ = pg8::lane_id_asm();
    LAS float* scr = (LAS float*)(F.lds + F.wave * 16384);
    const int gw = F.vcu * NWAVES + F.wave, NGW = F.G * NWAVES;
    bf16* W1t = (bf16*)(F.ws + WS_W1); bf16* W2t = (bf16*)(F.ws + WS_W2); bf16* W3t = (bf16*)(F.ws + WS_W3);
    bf16* W4t = (bf16*)(F.ws + WS_W4); bf16* W5t = (bf16*)(F.ws + WS_W5); bf16* W6t = (bf16*)(F.ws + WS_W6);
    for (int it = it_lo + gw; it < it_hi; it += NGW) {
        int r = it;
        if (r < TI1) { p0_transpose_item(arg_in(3), DM, PC, W1t, 0, arg_in(2), arg_in(2) + 512, scr, r, lane_); continue; } r -= TI1;
        if (r < TI6) { p0_transpose_item(arg_in(18), PLE, DM, W6t, 0, nullptr, nullptr, scr, r, lane_); continue; } r -= TI6;
        if (r < TI2) { p0_transpose_item(arg_in(10), DM, DM, W2t, 0, arg_in(8), arg_in(9), scr, r, lane_); continue; } r -= TI2;
        if (r < TI3) { p0_transpose_item(arg_in(13), DM, 2 * DFF, W3t, 1, arg_in(12), arg_in(12) + 512, scr, r, lane_); continue; } r -= TI3;
        if (r < TI4) { p0_transpose_item(arg_in(14), DFF, DM, W4t, 0, nullptr, nullptr, scr, r, lane_); continue; } r -= TI4;
        p0_transpose_item(arg_in(16), DM, DM, W5t, 0, nullptr, nullptr, scr, r, lane_);
    }
}
__device__ __forceinline__ void p0_prologue(Frame& F, const Args& A, const int parts) {
    const int lane_ = pg8::lane_id_asm();
    const int gw = F.vcu * NWAVES + F.wave, NGW = F.G * NWAVES;
    if (parts & 1) weight_copies(F, 0, T_EARLY);
    { const v4u z = {0u, 0u, 0u, 0u}; GAS v4u* zp = (GAS v4u*)(F.ws + CT_ZERO_LO);
      for (int i = gw * 64 + lane_; i < (int)((CT_ZERO_HI - CT_ZERO_LO) / 16); i += NGW * 64) zp[i] = z; }
    bf16* XN = (bf16*)(F.ws + WS_XN); bf16* PB = (bf16*)(F.ws + WS_PB);
    const float* xin = arg_in(0); const float* pin = arg_in(1); float* ss0 = (float*)(F.ws + CT_SS0);
    if (parts & 2)
    for (int m0 = gw; m0 < MTOK; m0 += 4 * NGW) {
        f32x4 v[4][4], pv[4];
#pragma unroll
        for (int r = 0; r < 4; ++r) { const int m = m0 + r * NGW; if (m < MTOK) {
            const GAS f32x4* xr = (const GAS f32x4*)(xin + (size_t)m * DM) + lane_;
#pragma unroll
            for (int j = 0; j < 4; ++j) v[r][j] = __builtin_nontemporal_load(xr + 64 * j);
            pv[r] = __builtin_nontemporal_load((const GAS f32x4*)(pin + (size_t)m * PLE) + lane_); } }
#pragma unroll
        for (int r = 0; r < 4; ++r) { const int m = m0 + r * NGW; if (m < MTOK) {
            float s = 0.f;
#pragma unroll
            for (int j = 0; j < 4; ++j) s += (v[r][j].x * v[r][j].x + v[r][j].y * v[r][j].y) + (v[r][j].z * v[r][j].z + v[r][j].w * v[r][j].w);
            const float ssum = wave_sum(s);
            if (lane_ == 0) ss0[m] = ssum;
            GAS v2u* o8 = (GAS v2u*)(XN + (size_t)m * DM) + lane_;
#pragma unroll
            for (int j = 0; j < 4; ++j) { v2u o; o.x = pk2(v[r][j].x, v[r][j].y); o.y = pk2(v[r][j].z, v[r][j].w); o8[64 * j] = o; }
            v2u po; po.x = pk2(pv[r].x, pv[r].y); po.y = pk2(pv[r].z, pv[r].w);
            *((GAS v2u*)(PB + (size_t)m * PLE) + lane_) = po; } }
    }
}

constexpr int KP = 144;
constexpr int ATT_HALF = 128 * KP, ATT_SLOT = 2 * ATT_HALF;
static_assert(4 * ATT_SLOT == LDS_BARST_OFF, "attention ring");
constexpr int ATT_ITEMS = 3 * BATCH * NH * 64;
struct AttItem { int br, b, h, d, tok_cur; bool first; };
__device__ __forceinline__ AttItem att_decode(int id) {
    AttItem I; I.br = id / 2048; int rem = id % 2048; I.b = rem / 512; rem %= 512; I.h = rem / 64; const int s = rem % 64;
    I.d = 1 << (2 * I.br); const int nb = 64 >> (2 * I.br); const int r = s / nb, n = s % nb;
    I.first = (n == 0);
    I.tok_cur = I.b * SEQ + r + I.d * (128 * n);
    return I;
}
__device__ __forceinline__ size_t qkv_off(int kind, int tok, int h) { const int b = tok >> 13, t = tok & (SEQ - 1); return ((size_t)(((kind * BATCH + b) * NH + h)) * SEQ + t) * HD; }
static_assert(SEQ == 8192, "qkv_off uses SEQ = 2^13");
__device__ __forceinline__ void att_load_blk(const bf16* PROJ, int tok0, int d, int h, int tid, v4u (&kr)[2], v4u (&vr)[2]) {
    const bf16* kb = PROJ + qkv_off(1, tok0, h); const bf16* vb = PROJ + qkv_off(2, tok0, h);
#pragma unroll
    for (int i = 0; i < 2; ++i) { const int c = tid + 512 * i, row = c >> 3, ch = c & 7;
        kr[i] = *(const GAS v4u*)(kb + (size_t)(d * row) * HD + ch * 8); vr[i] = *(const GAS v4u*)(vb + (size_t)(d * row) * HD + ch * 8); }
}
__device__ __forceinline__ void att_stage_blk(LAS unsigned char* slot, int tid, const v4u (&kr)[2], const v4u (&vr)[2]) {
#pragma unroll
    for (int i = 0; i < 2; ++i) { const int c = tid + 512 * i, row = c >> 3, ch = c & 7;
        *(LAS v4u*)(slot + row * KP + ch * 16) = kr[i]; *(LAS v4u*)(slot + ATT_HALF + row * KP + ch * 16) = vr[i]; }
}
#define LDS_BARRIER() do { asm volatile("s_waitcnt lgkmcnt(0)" ::: "memory"); __builtin_amdgcn_s_barrier(); asm volatile("" ::: "memory"); } while (0)
struct AttPref { v4u k[2], v[2]; bf16x8 q0, q1; };
__device__ __forceinline__ void att_prefetch(AttPref& R, const bf16* PROJ, int id, int tid, int w, int l15, int fq) {
    const AttItem I = att_decode(id);
    att_load_blk(PROJ, I.tok_cur, I.d, I.h, tid, R.k, R.v);
    const bf16* qp = PROJ + qkv_off(0, I.tok_cur, I.h) + (size_t)(I.d * (16 * w + l15)) * HD + 8 * fq; R.q0 = *(const GAS bf16x8*)qp; R.q1 = *(const GAS bf16x8*)(qp + 32);
}
template <bool MERGE, bool FIRST> __device__ __forceinline__ void att_item(const AttItem& C, const bf16x8 q0, const bf16x8 q1, const int pos, LAS unsigned char* lds, bf16* AO, float* LSE, bf16* GR, float* SSA,
                                                             const int w, const int l15, const int fq) {
        const int qtok = C.tok_cur + C.d * (16 * w + l15);
        v4u p1[2], p2[2]; float l1 = 0.f, l2 = 0.f;
        if (MERGE) { const bf16* a1 = AO + (size_t)MTOK * AW + (size_t)qtok * AW + C.h * HD + 8 * fq; const bf16* a2 = a1 + (size_t)MTOK * AW;
#pragma unroll
            for (int P = 0; P < 2; ++P) { p1[P] = *(const GAS v4u*)(a1 + 32 * P); p2[P] = *(const GAS v4u*)(a2 + 32 * P); }
            l1 = LSE[(size_t)MTOK * NH + (size_t)qtok * NH + C.h]; l2 = LSE[(size_t)2 * MTOK * NH + (size_t)qtok * NH + C.h]; }
        const int Pb = ((pos - 1) & 3) * ATT_SLOT, Cb = (pos & 3) * ATT_SLOT;
        int kbase[9];
#pragma unroll
        for (int kk = 0; kk < 9; ++kk) { const int kb = w + kk; kbase[kk] = (kb < 8) ? (Pb + kb * 16 * KP) : (Cb + (kb - 8) * 16 * KP); }
        f32x4 s[9];
        {
            bf16x8 ka[9][2];
#pragma unroll
            for (int kk = 0; kk < 9; ++kk) { LAS unsigned char* kp = lds + kbase[kk] + l15 * KP + 16 * fq; ka[kk][0] = *(const LAS bf16x8*)kp; ka[kk][1] = *(const LAS bf16x8*)(kp + 64); }
#pragma unroll
            for (int kk = 0; kk < 9; ++kk) s[kk] = __builtin_amdgcn_mfma_f32_16x16x32_bf16(ka[kk][0], q0, (f32x4){0.f, 0.f, 0.f, 0.f}, 0, 0, 0);
#pragma unroll
            for (int kk = 0; kk < 9; ++kk) s[kk] = __builtin_amdgcn_mfma_f32_16x16x32_bf16(ka[kk][1], q1, s[kk], 0, 0, 0);
        }
        const float LOG2E = 1.4426950408889634f, NEGBIG = -3.0e38f;
        const float nc2 = -LOG2E * (float)C.d * __builtin_amdgcn_exp2f(-(float)(C.h + 1));
        const int t = l15 - 4 * fq; const float bl = nc2 * (float)t;
#pragma unroll
        for (int kk = 0; kk < 9; ++kk)
#pragma unroll
            for (int j = 0; j < 4; ++j) {
                float v = __builtin_fmaf(nc2, (float)(128 - 16 * kk - j), s[kk][j] + bl);
                if (kk == 0) v = (t > j) ? NEGBIG : v;
                if (kk == 8) v = (t < j) ? NEGBIG : v;
                s[kk][j] = v; }
        if (FIRST) {
#pragma unroll
            for (int kk = 0; kk < 8; ++kk) if (w + kk < 8) s[kk] = (f32x4){NEGBIG, NEGBIG, NEGBIG, NEGBIG};
        }
        float mx = NEGBIG;
#pragma unroll
        for (int kk = 0; kk < 9; ++kk) { mx = __builtin_fmaxf(__builtin_fmaxf(mx, s[kk][0]), s[kk][1]); mx = __builtin_fmaxf(__builtin_fmaxf(mx, s[kk][2]), s[kk][3]); }
        mx = pg8::rows_max4(mx);
        float sum = 0.f;
#pragma unroll
        for (int kk = 0; kk < 9; ++kk)
#pragma unroll
            for (int j = 0; j < 4; ++j) { const float p = __builtin_amdgcn_exp2f(s[kk][j] - mx); s[kk][j] = p; sum += p; }
        sum = pg8::rows_sum4(sum);
        f32x4 o[4];
#pragma unroll
        for (int d0 = 0; d0 < 4; ++d0) o[d0] = (f32x4){0.f, 0.f, 0.f, 0.f};
#pragma unroll
        for (int pp = 0; pp < 5; ++pp) {
            const int kA = 2 * pp, kB = (pp < 4) ? 2 * pp + 1 : 2 * pp;
            const bool deadA = FIRST && (w + kA < 8), deadB = FIRST && (w + kB < 8);
            if (deadB) continue;
            v4u pw; pw.x = pk2(s[kA][0], s[kA][1]); pw.y = pk2(s[kA][2], s[kA][3]);
            if (pp < 4) { pw.z = pk2(s[kB][0], s[kB][1]); pw.w = pk2(s[kB][2], s[kB][3]); } else { pw.z = 0u; pw.w = 0u; }
            const bf16x8 pf = __builtin_bit_cast(bf16x8, pw);
            const int vrow = (4 * fq + (l15 >> 2)) * KP + 16 * (l15 & 3) + ATT_HALF;
            LAS unsigned char* vb = lds + kbase[kB] + vrow;
            LAS unsigned char* va = deadA ? vb : lds + kbase[kA] + vrow;
#pragma unroll
            for (int d0 = 0; d0 < 4; ++d0) {
                const v4i16_t lo = tr_read(va + 64 * (d0 >> 1) + 8 * (d0 & 1)), hi = tr_read(vb + 64 * (d0 >> 1) + 8 * (d0 & 1));
                const bf16x8 vf = {lo[0], lo[1], lo[2], lo[3], hi[0], hi[1], hi[2], hi[3]};
                o[d0] = __builtin_amdgcn_mfma_f32_16x16x32_bf16(vf, pf, o[d0], 0, 0, 0);
            }
        }
        const float inv = __builtin_amdgcn_rcpf(sum), l0 = mx + __builtin_amdgcn_logf(sum);
        if (!MERGE) {
            bf16* op = AO + (size_t)C.br * MTOK * AW + (size_t)qtok * AW + C.h * HD + 8 * fq;
#pragma unroll
            for (int P = 0; P < 2; ++P) { v4u ow; ow.x = pk2(o[2 * P][0] * inv, o[2 * P][1] * inv); ow.y = pk2(o[2 * P][2] * inv, o[2 * P][3] * inv);
                ow.z = pk2(o[2 * P + 1][0] * inv, o[2 * P + 1][1] * inv); ow.w = pk2(o[2 * P + 1][2] * inv, o[2 * P + 1][3] * inv); *(GAS v4u*)(op + 32 * P) = ow; }
            if (fq == 0) LSE[(size_t)C.br * MTOK * NH + (size_t)qtok * NH + C.h] = l0;
        } else {
            const float lm = fmaxf(l0, fmaxf(l1, l2));
            float w0 = __builtin_amdgcn_exp2f(l0 - lm), w1 = __builtin_amdgcn_exp2f(l1 - lm), w2 = __builtin_amdgcn_exp2f(l2 - lm);
            const float wi = __builtin_amdgcn_rcpf(w0 + w1 + w2); w0 *= wi * inv; w1 *= wi; w2 *= wi;
            bf16* op = GR + (size_t)qtok * DM + C.h * HD + 8 * fq; float sq = 0.f;
#pragma unroll
            for (int P = 0; P < 2; ++P) { const unsigned x1[4] = {p1[P].x, p1[P].y, p1[P].z, p1[P].w}, x2[4] = {p2[P].x, p2[P].y, p2[P].z, p2[P].w}; unsigned wv[4];
#pragma unroll
                for (int hh = 0; hh < 2; ++hh) { const int d0 = 2 * P + hh;
                    const float m0 = w0 * o[d0][0] + w1 * bflo(x1[2 * hh]) + w2 * bflo(x2[2 * hh]), m1 = w0 * o[d0][1] + w1 * bfhi(x1[2 * hh]) + w2 * bfhi(x2[2 * hh]);
                    const float m2 = w0 * o[d0][2] + w1 * bflo(x1[2 * hh + 1]) + w2 * bflo(x2[2 * hh + 1]), m3 = w0 * o[d0][3] + w1 * bfhi(x1[2 * hh + 1]) + w2 * bfhi(x2[2 * hh + 1]);
                    sq += (m0 * m0 + m1 * m1) + (m2 * m2 + m3 * m3);
                    wv[2 * hh] = pk2(m0, m1); wv[2 * hh + 1] = pk2(m2, m3); }
                v4u ow; ow.x = wv[0]; ow.y = wv[1]; ow.z = wv[2]; ow.w = wv[3]; *(GAS v4u*)(op + 32 * P) = ow; }
            sq = pg8::rows_sum4(sq);
            if (fq == 0) unsafeAtomicAdd(SSA + qtok, sq);
        }
}
template <bool MERGE> __device__ __forceinline__ void att_phase(Frame& F, const Args& A, int first_item, int n_items) {
    const bf16* PROJ = (const bf16*)(F.ws + WS_PROJ);
    bf16* AO = (bf16*)(F.ws + WS_AO); float* LSE = (float*)(F.ws + WS_LSE);
    bf16* GR = (bf16*)(F.ws + WS_GROUPS); float* SSA = (float*)(F.ws + CT_SSA);
    LAS unsigned char* lds = F.lds;
    const int lane = pg8::lane_id_asm(), w = F.wave, tid = w * 64 + lane, l15 = lane & 15, fq = lane >> 4;
    AttPref RA, RB; bf16x8 cq0, cq1;
    int pos = 1;
    { const AttItem I = att_decode(first_item);
      if (!I.first) { att_load_blk(PROJ, I.tok_cur - I.d * 128, I.d, I.h, tid, RA.k, RA.v); att_stage_blk(lds, tid, RA.k, RA.v); }
      att_prefetch(RA, PROJ, first_item, tid, w, l15, fq);
      att_stage_blk(lds + ATT_SLOT, tid, RA.k, RA.v); cq0 = RA.q0; cq1 = RA.q1; }
    if (1 < n_items) att_prefetch(RA, PROJ, first_item + 1, tid, w, l15, fq);
    if (2 < n_items) att_prefetch(RB, PROJ, first_item + 2, tid, w, l15, fq);
#define ATT_STEP(i, R) do { const AttItem C = att_decode(first_item + (i)); LDS_BARRIER(); \
        if (C.first) att_item<MERGE, true>(C, cq0, cq1, pos, lds, AO, LSE, GR, SSA, w, l15, fq); else att_item<MERGE, false>(C, cq0, cq1, pos, lds, AO, LSE, GR, SSA, w, l15, fq); \
        if ((i) + 1 < n_items) { ++pos; att_stage_blk(lds + (pos & 3) * ATT_SLOT, tid, R.k, R.v); cq0 = R.q0; cq1 = R.q1; \
            if ((i) + 3 < n_items) att_prefetch(R, PROJ, first_item + (i) + 3, tid, w, l15, fq); } } while (0)
    for (int it = 0; it < n_items; it += 2) {
        ATT_STEP(it, RA);
        if (it + 1 < n_items) ATT_STEP(it + 1, RB);
    }
#undef ATT_STEP
    LDS_BARRIER();
}

constexpr int ZP = 272;
constexpr int SGU_ITEMS = BATCH * (SEQ / CHUNK) * NG;
struct SguPref { v4u z[4]; f32x4 wa[4], wb[4]; v4u u[4]; float bs; };
__device__ __forceinline__ void sgu_prefetch(SguPref& R, const bf16* PROJ, const float* wsp, const float* bsp, int id, int tid, int w, int l15, int fq) {
    const int b = id / 256, n = (id % 256) / 4, g = id % 4, t0 = b * SEQ + n * CHUNK, c8 = tid & 15, i_loc = 16 * w + l15, nks = (w >> 1) + 1;
#pragma unroll
    for (int i = 0; i < 4; ++i) R.z[i] = *(const GAS v4u*)(PROJ + (size_t)(t0 + 32 * i + (tid >> 4)) * DM + SW + g * GD + c8 * 8);
    const float* wrow = wsp + ((size_t)g * CHUNK + i_loc) * CHUNK + 8 * fq;
#pragma unroll
    for (int ks = 0; ks < 4; ++ks) if (ks < nks) { R.wa[ks] = *(const GAS f32x4*)(wrow + 32 * ks); R.wb[ks] = *(const GAS f32x4*)(wrow + 32 * ks + 4); }
    const bf16* up = PROJ + (size_t)(t0 + i_loc) * DM + g * GD + 8 * fq;
#pragma unroll
    for (int P = 0; P < 4; ++P) R.u[P] = *(const GAS v4u*)(up + 32 * P);
    R.bs = bsp[g * CHUNK + i_loc];
}
__device__ __forceinline__ void sgu_item(const SguPref& R, int id, LAS unsigned char* lds, bf16* GR, float* SSS, const f32x4 g0, const f32x4 g1, const f32x4 b0, const f32x4 b1, int tid, int w, int l15, int fq) {
        const int b = id / 256, n = (id % 256) / 4, g = id % 4, t0 = b * SEQ + n * CHUNK, c8 = tid & 15, i_loc = 16 * w + l15, nks = (w >> 1) + 1;
#pragma unroll
        for (int i = 0; i < 4; ++i) { const int j = 32 * i + (tid >> 4);
            const v4u zw = R.z[i];
            float x[8] = {bflo(zw.x), bfhi(zw.x), bflo(zw.y), bfhi(zw.y), bflo(zw.z), bfhi(zw.z), bflo(zw.w), bfhi(zw.w)};
            float s = ((x[0] + x[1]) + (x[2] + x[3])) + ((x[4] + x[5]) + (x[6] + x[7]));
            s += __shfl_xor(s, 1); s += __shfl_xor(s, 2); s += __shfl_xor(s, 4); s += __shfl_xor(s, 8);
            const float mean = s * (1.0f / GD); float q = 0.f;
#pragma unroll
            for (int e = 0; e < 8; ++e) { x[e] -= mean; q += x[e] * x[e]; }
            q += __shfl_xor(q, 1); q += __shfl_xor(q, 2); q += __shfl_xor(q, 4); q += __shfl_xor(q, 8);
            const float rstd = __builtin_amdgcn_rsqf(q * (1.0f / GD) + EPS);
            v4u o; o.x = pk2(x[0] * rstd * g0.x + b0.x, x[1] * rstd * g0.y + b0.y); o.y = pk2(x[2] * rstd * g0.z + b0.z, x[3] * rstd * g0.w + b0.w);
            o.z = pk2(x[4] * rstd * g1.x + b1.x, x[5] * rstd * g1.y + b1.y); o.w = pk2(x[6] * rstd * g1.z + b1.z, x[7] * rstd * g1.w + b1.w);
            *(LAS v4u*)(lds + j * ZP + c8 * 16) = o; }
        LDS_BARRIER();
        f32x4 acc[8];
#pragma unroll
        for (int cb = 0; cb < 8; ++cb) acc[cb] = (f32x4){0.f, 0.f, 0.f, 0.f};
#pragma unroll
        for (int ks = 0; ks < 4; ++ks) if (ks < nks) {
            const int j0 = 32 * ks + 8 * fq;
            const f32x4 va = R.wa[ks], vb = R.wb[ks];
            v4u ww; ww.x = pk2(j0 + 0 <= i_loc ? va.x : 0.f, j0 + 1 <= i_loc ? va.y : 0.f); ww.y = pk2(j0 + 2 <= i_loc ? va.z : 0.f, j0 + 3 <= i_loc ? va.w : 0.f);
            ww.z = pk2(j0 + 4 <= i_loc ? vb.x : 0.f, j0 + 5 <= i_loc ? vb.y : 0.f); ww.w = pk2(j0 + 6 <= i_loc ? vb.z : 0.f, j0 + 7 <= i_loc ? vb.w : 0.f);
            const bf16x8 wf = __builtin_bit_cast(bf16x8, ww);
            LAS unsigned char* zp = lds + (32 * ks + 8 * fq + (l15 >> 2)) * ZP + 16 * (l15 & 3);
#pragma unroll
            for (int cb = 0; cb < 8; ++cb) {
                const v4i16_t lo = tr_read(zp + 64 * (cb >> 1) + 8 * (cb & 1)), hi = tr_read(zp + 4 * ZP + 64 * (cb >> 1) + 8 * (cb & 1));
                const bf16x8 zf = {lo[0], lo[1], lo[2], lo[3], hi[0], hi[1], hi[2], hi[3]};
                acc[cb] = __builtin_amdgcn_mfma_f32_16x16x32_bf16(zf, wf, acc[cb], 0, 0, 0);
            }
        }
        const float bs = R.bs;
        bf16* op = GR + (size_t)(t0 + i_loc) * DM + AW + g * GD + 8 * fq; float sq = 0.f;
#pragma unroll
        for (int P = 0; P < 4; ++P) { const unsigned ux[4] = {R.u[P].x, R.u[P].y, R.u[P].z, R.u[P].w}; unsigned wv[4];
#pragma unroll
            for (int hh = 0; hh < 2; ++hh) { const int cb = 2 * P + hh;
                const float r0 = bflo(ux[2 * hh]) * (acc[cb][0] + bs), r1 = bfhi(ux[2 * hh]) * (acc[cb][1] + bs), r2 = bflo(ux[2 * hh + 1]) * (acc[cb][2] + bs), r3 = bfhi(ux[2 * hh + 1]) * (acc[cb][3] + bs);
                sq += (r0 * r0 + r1 * r1) + (r2 * r2 + r3 * r3);
                wv[2 * hh] = pk2(r0, r1); wv[2 * hh + 1] = pk2(r2, r3); }
            v4u ow; ow.x = wv[0]; ow.y = wv[1]; ow.z = wv[2]; ow.w = wv[3]; *(GAS v4u*)(op + 32 * P) = ow; }
        sq = pg8::rows_sum4(sq);
        if (fq == 0) unsafeAtomicAdd(SSS + t0 + i_loc, sq);
        LDS_BARRIER();
}
__device__ __forceinline__ void sgu_phase(Frame& F, const Args& A, int first_item, int n_items) {
    const bf16* PROJ = (const bf16*)(F.ws + WS_UZ); bf16* GR = (bf16*)(F.ws + WS_GROUPS); float* SSS = (float*)(F.ws + CT_SSS);
    const float* lng = arg_in(4); const float* lnb = arg_in(5); const float* wsp = arg_in(6); const float* bsp = arg_in(7);
    LAS unsigned char* lds = F.lds;
    const int lane = pg8::lane_id_asm(), w = F.wave, tid = w * 64 + lane, l15 = lane & 15, fq = lane >> 4, c8 = tid & 15;
    const f32x4 g0 = *(const GAS f32x4*)(lng + c8 * 8), g1 = *(const GAS f32x4*)(lng + c8 * 8 + 4), b0 = *(const GAS f32x4*)(lnb + c8 * 8), b1 = *(const GAS f32x4*)(lnb + c8 * 8 + 4);
    SguPref RA, RB;
    sgu_prefetch(RA, PROJ, wsp, bsp, first_item, tid, w, l15, fq);
    for (int it = 0; it < n_items; it += 2) {
        if (it + 1 < n_items) sgu_prefetch(RB, PROJ, wsp, bsp, first_item + it + 1, tid, w, l15, fq);
        sgu_item(RA, first_item + it, lds, GR, SSS, g0, g1, b0, b1, tid, w, l15, fq);
        if (it + 1 < n_items) {
            if (it + 2 < n_items) sgu_prefetch(RA, PROJ, wsp, bsp, first_item + it + 2, tid, w, l15, fq);
            sgu_item(RB, first_item + it + 1, lds, GR, SSS, g0, g1, b0, b1, tid, w, l15, fq);
        }
    }
}

#define XB_TMO      128
#define XB_XCNT(j)  (256  + 64 * (j))
#define XB_XSUB(j)  (1280 + 64 * (j))
#define XB_XGEN(j)  (2304 + 64 * (j))
#define XB_TOP      3328
#define XB_TOPGEN   3392
#define XCD_BAR_WORDS 3456
#define XB_SPIN_CAP (1u << 18)

__device__ __forceinline__ unsigned xb_ld(unsigned* p)              { return __hip_atomic_load(p, __ATOMIC_RELAXED, __HIP_MEMORY_SCOPE_AGENT); }
__device__ __forceinline__ unsigned xb_add(unsigned* p, unsigned v) { return __hip_atomic_fetch_add(p, v, __ATOMIC_RELAXED, __HIP_MEMORY_SCOPE_AGENT); }
__device__ __forceinline__ unsigned xb_xcc_id() { return (unsigned)__builtin_amdgcn_s_getreg((3 << 11) | 20) & 0xFu; }
#define XB_SPIN(cond, bar) do { unsigned _sp = 0; while (cond) { __builtin_amdgcn_s_sleep(1); \
    if ((++_sp & 255u) == 0u) { if (xb_ld(&(bar)[XB_TMO])) break; if (_sp > XB_SPIN_CAP) { atomicAdd(&(bar)[XB_TMO], 1u); break; } } } } while (0)

struct XcdBarrier {
    unsigned* bar; unsigned x;
    volatile LAS unsigned* st;
};

__device__ __forceinline__ XcdBarrier xcd_barrier_post(unsigned* bar, volatile LAS unsigned* st, bool leader) {
    XcdBarrier b; b.bar = bar; b.x = xb_xcc_id(); b.st = st;
    if (leader) (void)xb_add(&bar[XB_XCNT(b.x)], 1u);
    return b;
}
__device__ __forceinline__ void xcd_barrier_complete(unsigned* bar, unsigned x, unsigned& nloc, unsigned& nx) {
    const unsigned G = gridDim.x * gridDim.y * gridDim.z;
    unsigned sum, cnt, mine, sp = 0u;
    for (;;) {
        sum = 0u; cnt = 0u; mine = 0u;
#pragma unroll
        for (unsigned j = 0; j < 16; ++j) { const unsigned c = xb_ld(&bar[XB_XCNT(j)]); sum += c; cnt += (c > 0u) ? 1u : 0u; mine = (j == x) ? c : mine; }
        if (sum == G) break;
        __builtin_amdgcn_s_sleep(1);
        if ((++sp & 255u) == 0u) { if (xb_ld(&bar[XB_TMO])) break; if (sp > XB_SPIN_CAP) { atomicAdd(&bar[XB_TMO], 1u); break; } }
    }
    nloc = mine > 0u ? mine : 1u; nx = cnt > 0u ? cnt : 1u;
}

__device__ __forceinline__ void xcd_barrier(const XcdBarrier& b, const int wave) {
    asm volatile("s_waitcnt vmcnt(0)" ::: "memory");
    __syncthreads();
    bool leader_ = false; if (wave == 0) leader_ = (pg8::lane_id_asm() == 0);
    if (leader_) {
        unsigned* bar = b.bar;
        __builtin_amdgcn_s_waitcnt(0);
        unsigned nloc = b.st[0], nx = b.st[1];
        if (nloc == 0u) { xcd_barrier_complete(bar, b.x, nloc, nx); b.st[0] = nloc; b.st[1] = nx; }
        const unsigned old = xb_add(&bar[XB_XSUB(b.x)], 1u);
        const unsigned gen = old / nloc;
        if (old + 1u == (gen + 1u) * nloc) {
            __builtin_amdgcn_fence(__ATOMIC_RELEASE, "agent");
            asm volatile("s_waitcnt vmcnt(0)" ::: "memory");
            const unsigned og = xb_add(&bar[XB_TOP], 1u);
            const unsigned tg = og / nx;
            if (og + 1u == (tg + 1u) * nx) xb_add(&bar[XB_TOPGEN], 1u);
            else XB_SPIN(xb_ld(&bar[XB_TOPGEN]) == tg, bar);
            __builtin_amdgcn_fence(__ATOMIC_ACQUIRE, "agent");
            xb_add(&bar[XB_XGEN(b.x)], 1u);
            asm volatile("s_waitcnt vmcnt(0)" ::: "memory");
        } else {
            XB_SPIN(xb_ld(&bar[XB_XGEN(b.x)]) == gen, bar);
            __builtin_amdgcn_fence(__ATOMIC_ACQUIRE, "agent");
            asm volatile("s_waitcnt vmcnt(0)" ::: "memory");
        }
    }
    __syncthreads();
}


struct RangeOrder {
    pg8::StaticOrder b; int lo, n;
    __device__ __forceinline__ bool next(int i, pg8::Unit& u) const { return i < n && b.next(i + lo, u); }
    __device__ __forceinline__ void a_ready(const pg8::Unit&) const {}
    __device__ __forceinline__ void done(const pg8::Unit&) const {}
};
__device__ __forceinline__ void grid_bar(unsigned* ctr, unsigned target, int wave) {
    asm volatile("s_waitcnt vmcnt(0)" ::: "memory");
    __syncthreads();
    if (wave == 0) {
        if (pg8::lane_id_asm() == 0) {
            __builtin_amdgcn_fence(__ATOMIC_RELEASE, "agent");
            asm volatile("s_waitcnt vmcnt(0)" ::: "memory");
            __hip_atomic_fetch_add(ctr, 1u, __ATOMIC_RELAXED, __HIP_MEMORY_SCOPE_AGENT);
            while (__hip_atomic_load(ctr, __ATOMIC_RELAXED, __HIP_MEMORY_SCOPE_AGENT) < target) __builtin_amdgcn_s_sleep(2);
            __builtin_amdgcn_fence(__ATOMIC_ACQUIRE, "agent");
            asm volatile("s_waitcnt vmcnt(0)" ::: "memory");
        }
    }
    __syncthreads();
}

__global__ void __launch_bounds__(NWAVES * 64, 2) mk_fwd(Args args) {
    extern __shared__ __attribute__((aligned(16))) unsigned char lds_raw[];
    cg::grid_group grid = cg::this_grid();
    Frame F;
    F.lds = (LAS unsigned char*)lds_raw;
    F.wave = __builtin_amdgcn_readfirstlane(threadIdx.x >> 6);
    F.G = gridDim.x; { const int bx = blockIdx.x; F.vcu = (F.G % 8 == 0) ? (bx % 8) * (F.G / 8) + bx / 8 : bx; }
    F.out = args.out; F.ws = args.ws;
#ifndef REPEAT_MASK
#define REPEAT_MASK 0
#endif
#define REPS(k) ((((REPEAT_MASK) >> (k)) & 1) ? 2 : 1)
    unsigned* const bar_ctr = (unsigned*)F.ws;
    unsigned epoch = 0;
    volatile LAS unsigned* barst = (volatile LAS unsigned*)(F.lds + LDS_BARST_OFF);
    if (threadIdx.x < 2) barst[threadIdx.x] = 0u;
    if (blockIdx.x == 0) { unsigned* xw = (unsigned*)(F.ws + CT_XBAR); for (int i = threadIdx.x; i < XCD_BAR_WORDS; i += NWAVES * 64) __hip_atomic_store(xw + i, 0u, __ATOMIC_RELAXED, __HIP_MEMORY_SCOPE_AGENT); }
    grid.sync();
    XcdBarrier xbar; { bool ld_ = false; if (F.wave == 0) ld_ = (pg8::lane_id_asm() == 0); xbar = xcd_barrier_post((unsigned*)(F.ws + CT_XBAR), barst, ld_); }
#ifndef PROBE_PHASE
#define PROBE_PHASE -1
#endif
#ifndef P0_SPLIT
#define P0_SPLIT 0
#endif
    unsigned long long tp0 = 0;
#define PROBE_MARK(k) do { if (PROBE_PHASE == (k)) tp0 = __builtin_amdgcn_s_memrealtime(); \
        if (PROBE_PHASE >= 0 && PROBE_PHASE + 1 == (k)) { const unsigned long long t1_ = __builtin_amdgcn_s_memrealtime(), d_ = (t1_ - tp0) * 4; while (__builtin_amdgcn_s_memrealtime() - t1_ < d_) __builtin_amdgcn_s_sleep(8); } } while (0)
#define SEAM() do { ++epoch; xcd_barrier(xbar, F.wave); } while (0)
    const pg8::bf16_t* XN = (const pg8::bf16_t*)(F.ws + WS_XN);

    PROBE_MARK(0);
    for (int rep_ = 0; rep_ < REPS(0); ++rep_) { if (blockIdx.x == 0 && threadIdx.x == 0) __hip_atomic_store(bar_ctr, 0u, __ATOMIC_RELAXED, __HIP_MEMORY_SCOPE_AGENT); p0_prologue(F, args, P0_SPLIT ? 1 : 3); }
    SEAM();
    if (P0_SPLIT) { PROBE_MARK(9); p0_prologue(F, args, 2); SEAM(); PROBE_MARK(10); }
    PROBE_MARK(1);
    {
        weight_copies(F, T_EARLY, T_EARLY + TI2); __syncthreads();
        const pg8::Gemm g1{XN, (const pg8::bf16_t*)(F.ws + WS_W1), MTOK, PC, DM}; pg8::StaticOrder S1; S1.init(MTOK, PC, F.G, (int)blockIdx.x);
        const pg8::EpiBf16M<1> E1{(pg8::bf16_t*)(F.ws + WS_PROJ), PC, (const float*)(F.ws + CT_SS0)};
        pg8::gemm_phase<pg8::EpiBf16M<1>, pg8::StaticOrder, true, true>(F.lds, g1, S1, E1, F.wave);
    }
    SEAM();
    PROBE_MARK(2);
    for (int rep_ = 0; rep_ < REPS(2); ++rep_) {
        constexpr int N2A = ATT_ITEMS - 2048; const int per = (N2A + F.G - 1) / F.G; const int f0 = F.vcu * per; int n = N2A - f0; n = n < 0 ? 0 : (n > per ? per : n);
        if (n > 0) att_phase<false>(F, args, 2048 + f0, n);
        __syncthreads();
        { const int per2 = (SGU_ITEMS + F.G - 1) / F.G; const int f0 = F.vcu * per2; int n2 = SGU_ITEMS - f0; n2 = n2 < 0 ? 0 : (n2 > per2 ? per2 : n2); if (n2 > 0) sgu_phase(F, args, f0, n2); }
    }
    SEAM();
    PROBE_MARK(3);
    {
        { const int per = (2048 + F.G - 1) / F.G; const int f0 = F.vcu * per; int n = 2048 - f0; n = n < 0 ? 0 : (n > per ? per : n); PROBE_MARK(13); if (n > 0) att_phase<true>(F, args, f0, n); }
    }
    SEAM();
    PROBE_MARK(4);
    {
        pg8::Gemm g{(const pg8::bf16_t*)(F.ws + WS_GROUPS), (const pg8::bf16_t*)(F.ws + WS_W2), MTOK, DM, DM}; pg8::StaticOrder S; S.init(MTOK, DM, F.G, (int)blockIdx.x);
        pg8::EpiResNorm<true> E{(pg8::bf16_t*)(F.ws + WS_XN), arg_in(11), (float*)(F.ws + CT_SS1), (unsigned*)(F.ws + CT_CNT1), (float*)(F.ws + CT_SS2), DM, (const float*)(F.ws + CT_SSA), (const float*)(F.ws + CT_SSS)};
        pg8::gemm_phase<pg8::EpiResNorm<true>, pg8::StaticOrder, true, true>(F.lds, g, S, E, F.wave);
        weight_copies(F, T_EARLY + TI2, T_ALL);
    }
    SEAM();
    PROBE_MARK(5);
    {
        const pg8::Gemm g3{XN, (const pg8::bf16_t*)(F.ws + WS_W3), MTOK, 2 * DFF, DM}; pg8::StaticOrder S3; S3.init(MTOK, 2 * DFF, F.G, (int)blockIdx.x);
        const pg8::EpiSwiglu E3{(pg8::bf16_t*)(F.ws + WS_ACT), DFF, (const float*)(F.ws + CT_SS2)};
        pg8::gemm_phase<pg8::EpiSwiglu, pg8::StaticOrder, true, true>(F.lds, g3, S3, E3, F.wave);
    }
    SEAM();
    PROBE_MARK(6);
    {
        pg8::Gemm g{(const pg8::bf16_t*)(F.ws + WS_ACT), (const pg8::bf16_t*)(F.ws + WS_W4), MTOK, DM, DFF}; pg8::StaticOrder S; S.init(MTOK, DM, F.G, (int)blockIdx.x);
        pg8::EpiResNorm<false> E{(pg8::bf16_t*)(F.ws + WS_XN), arg_in(15), (float*)(F.ws + CT_SS3), (unsigned*)(F.ws + CT_CNT3), nullptr, DM, nullptr, nullptr};
        pg8::gemm_phase<pg8::EpiResNorm<false>, pg8::StaticOrder, true, true>(F.lds, g, S, E, F.wave);
    }
    {
        const pg8::Gemm g2{(const pg8::bf16_t*)(F.ws + WS_PB), (const pg8::bf16_t*)(F.ws + WS_W6), MTOK, DM, PLE}; pg8::StaticOrder S2; S2.init(MTOK, DM, F.G, (int)blockIdx.x);
        const pg8::EpiBf16M<0> E2{(pg8::bf16_t*)(F.ws + WS_PE), DM, nullptr};
        pg8::gemm_phase<pg8::EpiBf16M<0>, pg8::StaticOrder, true, true>(F.lds, g2, S2, E2, F.wave);
    }
    SEAM();
    PROBE_MARK(7);
    for (int rep_ = 0; rep_ < REPS(9); ++rep_) {
        pg8::Gemm g{XN, (const pg8::bf16_t*)(F.ws + WS_W5), MTOK, DM, DM}; pg8::StaticOrder S; S.init(MTOK, DM, F.G, (int)blockIdx.x);
        pg8::EpiFinal E{XN, (const pg8::bf16_t*)(F.ws + WS_PE), arg_in(17), F.out, DM};
        pg8::gemm_phase<pg8::EpiFinal, pg8::StaticOrder, true, true>(F.lds, g, S, E, F.wave);
    }
    PROBE_MARK(8);
#undef SEAM
}

extern "C" void kernel_launch(void* const* d_in, const int* in_sizes, int n_in, void* d_out, int out_size, void* d_ws, size_t ws_size, hipStream_t stream) {
    static int grid = 0;
    if (grid == 0) {
        if (n_in != 19 || in_sizes[0] != MTOK * DM || out_size != MTOK * DM || ws_size < WS_END) { fprintf(stderr, "kernel_launch: unexpected shapes (n_in %d, in0 %d, out %d, ws %zu); nothing launched\n", n_in, n_in > 0 ? in_sizes[0] : -1, out_size, ws_size); grid = -1; return; }
        int dev = 0, cus = 0, per_cu = 0;
        if (hipGetDevice(&dev) != hipSuccess || hipDeviceGetAttribute(&cus, hipDeviceAttributeMultiprocessorCount, dev) != hipSuccess) { grid = -1; return; }
        if (hipFuncSetAttribute((const void*)mk_fwd, hipFuncAttributeMaxDynamicSharedMemorySize, LDS_BYTES) != hipSuccess) { fprintf(stderr, "kernel_launch: hipFuncSetAttribute failed\n"); grid = -1; return; }
        if (hipOccupancyMaxActiveBlocksPerMultiprocessor(&per_cu, (const void*)mk_fwd, NWAVES * 64, LDS_BYTES) != hipSuccess || per_cu < 1) { fprintf(stderr, "kernel_launch: occupancy query says %d\n", per_cu); per_cu = 1; }
        (void)hipGetLastError();
        grid = cus;
    }
    if (grid < 0) return;
    Args a{};
    for (int i = 0; i < 19; ++i) a.in[i] = (const float*)d_in[i];
    a.out = (float*)d_out; a.ws = (unsigned char*)d_ws;
    a.ph_lo = 0; a.ph_hi = N_PHASES;
    void* params[] = {&a};
    hipError_t e = hipLaunchCooperativeKernel((const void*)mk_fwd, dim3(grid), dim3(NWAVES * 64), params, LDS_BYTES, stream);
    if (e != hipSuccess) fprintf(stderr, "kernel_launch: cooperative launch failed: %s (grid %d)\n", hipGetErrorString(e), grid);
}
```
